# Optimizing an MI355X kernel written in HIP

```python
import jax, jax.numpy as jnp
from jax import lax
import numpy as np

D_MODEL = 1024
BATCH = 4
SEQ = 8192
DEPTH = 4

GRID_W = 64
CTX_LEN = 256
N_MIXERS = 2
HGRN_HEAD_DIM = 128
HGRN_HEADS = D_MODEL // HGRN_HEAD_DIM
CHUNK = 64
CONV_WIDTH = 3
D_FF = 4 * D_MODEL
N_REC_LAYERS = (DEPTH + N_MIXERS - 1) // N_MIXERS
N_CONV_LAYERS = DEPTH // N_MIXERS
EPS = 1e-6

kernel_name = 'hybrid_hgrn2_shortconv_dit'


def _rmsnorm(x, gain):
    x32 = x.astype(jnp.float32)
    y = x32 * lax.rsqrt(jnp.mean(x32 * x32, axis=-1, keepdims=True) + EPS)
    return (y * gain.astype(jnp.float32)).astype(x.dtype)


def _modulate(h, shift, scale):
    return h * (1 + scale) + shift


def _mlp(h, w1, w2):
    return jnp.square(jax.nn.relu(h @ w1)) @ w2


def _heads(t):
    return t.reshape(*t.shape[:-1], HGRN_HEADS, HGRN_HEAD_DIM).astype(jnp.float32)


def _to_chunks(t):
    b, l, h, e = t.shape
    return t.reshape(b, l // CHUNK, CHUNK, h, e).transpose(1, 0, 3, 2, 4)


def _gla_chunkwise(q, k, v, g, s0):
    bsz, l, h, _ = q.shape
    lower = jnp.tril(jnp.ones((CHUNK, CHUNK), dtype=bool))

    def step(s, blk):
        qb, kb, vb, gb = blk
        cum = jnp.cumsum(gb, axis=2)
        ref = cum[:, :, CHUNK // 2 - 1:CHUNK // 2]
        last = cum[:, :, -1:]
        o_inter = jnp.einsum('bhck,bhkv->bhcv', qb * jnp.exp(cum), s)
        scores = jnp.einsum('bhck,bhsk->bhcs', qb * jnp.exp(cum - ref), kb * jnp.exp(ref - cum))
        scores = jnp.where(lower, scores, 0.0)
        o_intra = jnp.einsum('bhcs,bhsv->bhcv', scores, vb)
        s_new = jnp.exp(last[:, :, 0, :, None]) * s + jnp.einsum(
            'bhsk,bhsv->bhkv', kb * jnp.exp(last - cum), vb)
        return s_new, o_inter + o_intra

    s_fin, o = lax.scan(step, s0, (_to_chunks(q), _to_chunks(k), _to_chunks(v), _to_chunks(g)))
    o = o.transpose(1, 0, 3, 2, 4).reshape(bsz, l, h, v.shape[-1])
    return o, s_fin


def _gla_final_state(k, v, g):
    cum = jnp.cumsum(g, axis=1)
    return jnp.einsum('blhk,blhv->bhkv', k * jnp.exp(cum[:, -1:] - cum), v)


def _flip(t, direction):
    return jnp.flip(t, axis=1) if direction == 1 else t


def _hgrn2_inputs(h, w_in, lb, with_query):
    n_parts = 5 if with_query else 3
    parts = jnp.split(h @ w_in[:, :n_parts * D_MODEL], n_parts, axis=-1)
    v = _heads(parts[2])
    dirs = []
    for d in range(2):
        lb_d = lb[d].reshape(HGRN_HEADS, HGRN_HEAD_DIM)
        f = lb_d + (1.0 - lb_d) * jax.nn.sigmoid(_heads(parts[d]))
        dirs.append((1.0 - f, jnp.log(f)))
    if with_query:
        return v, dirs, jax.nn.silu(_heads(parts[3])), parts[4]
    return v, dirs, None, None


def _hgrn2_readout(o, gate, gnorm, w_out, dtype):
    o = o * lax.rsqrt(jnp.mean(o * o, axis=-1, keepdims=True) + EPS)
    o = o * gnorm.astype(jnp.float32).reshape(HGRN_HEADS, HGRN_HEAD_DIM) * jax.nn.silu(_heads(gate))
    return o.reshape(*o.shape[:-2], D_MODEL).astype(dtype) @ w_out


def _hgrn2_mixer(h, hc, w_in, lb, gnorm, w_out, ctx_out):
    v, dirs, q, gate = _hgrn2_inputs(h, w_in, lb, True)
    vc, dirs_c, qc, gate_c = _hgrn2_inputs(hc, w_in, lb, ctx_out)
    bsz = h.shape[0]
    o_dirs, oc_dirs = [], []
    for d in range(2):
        k, g = dirs[d]
        kc, gc = dirs_c[d]
        if ctx_out:
            s0 = jnp.zeros((bsz, HGRN_HEADS, HGRN_HEAD_DIM, HGRN_HEAD_DIM), jnp.float32)
            oc_d, s_ctx = _gla_chunkwise(_flip(qc, d), _flip(kc, d), _flip(vc, d), _flip(gc, d), s0)
            oc_dirs.append(_flip(oc_d, d))
        else:
            s_ctx = _gla_final_state(_flip(kc, d), _flip(vc, d), _flip(gc, d))
        o_d, _ = _gla_chunkwise(_flip(q, d), _flip(k, d), _flip(v, d), _flip(g, d), s_ctx)
        o_dirs.append(_flip(o_d, d))
    y = _hgrn2_readout(o_dirs[0] + o_dirs[1], gate, gnorm, w_out, h.dtype)
    yc = _hgrn2_readout(oc_dirs[0] + oc_dirs[1], gate_c, gnorm, w_out, hc.dtype) if ctx_out else None
    return y, yc


def _dwconv(z, w, b, axis):
    n = z.shape[axis]
    half = CONV_WIDTH // 2
    pad = [(0, 0)] * z.ndim
    pad[axis] = (half, half)
    zp = jnp.pad(z, pad)
    y = b
    for tap in range(CONV_WIDTH):
        y = y + w[tap] * lax.slice_in_dim(zp, tap, tap + n, axis=axis)
    return y


def _shortconv_mixer(h, w_in, w, b, w_out, axis):
    gate_b, gate_c, xin = jnp.split(h @ w_in, 3, axis=-1)
    return (gate_b * _dwconv(gate_c * xin, w, b, axis)) @ w_out


def setup_inputs(seed: int = 0) -> dict:
    key = jax.random.key(seed)
    ks = jax.random.split(key, 19)
    nrm = jax.random.normal
    f32 = jnp.float32
    d = D_MODEL
    return {
        'x': nrm(ks[0], (BATCH, SEQ, d), f32),
        'c': nrm(ks[1], (BATCH, d), f32),
        'ctx': nrm(ks[2], (BATCH, CTX_LEN, d), f32),
        'c_ctx': nrm(ks[3], (d,), f32),
        'ada_w': nrm(ks[4], (DEPTH, d, 6 * d), f32) * (0.5 * d ** -0.5),
        'ada_b': 0.02 * nrm(ks[5], (DEPTH, 6 * d), f32),
        'norm1': 1.0 + 0.02 * nrm(ks[6], (DEPTH, d), f32),
        'norm2': 1.0 + 0.02 * nrm(ks[7], (DEPTH, d), f32),
        'norm_f': 1.0 + 0.02 * nrm(ks[8], (d,), f32),
        'mlp_w1': nrm(ks[9], (DEPTH, d, D_FF), f32) * d ** -0.5,
        'mlp_w2': nrm(ks[10], (DEPTH, D_FF, d), f32) * D_FF ** -0.5,
        'hgrn_w_in': nrm(ks[11], (N_REC_LAYERS, d, 5 * d), f32) * d ** -0.5,
        'hgrn_lb': nrm(ks[12], (2, N_REC_LAYERS, d), f32),
        'hgrn_gnorm': 1.0 + 0.02 * nrm(ks[13], (N_REC_LAYERS, d), f32),
        'hgrn_w_out': nrm(ks[14], (N_REC_LAYERS, d, d), f32) * d ** -0.5,
        'conv_w_in': nrm(ks[15], (N_CONV_LAYERS, d, 3 * d), f32) * d ** -0.5,
        'conv_w': nrm(ks[16], (N_CONV_LAYERS, CONV_WIDTH, d), f32) * CONV_WIDTH ** -0.5,
        'conv_b': 0.02 * nrm(ks[17], (N_CONV_LAYERS, d), f32),
        'conv_w_out': nrm(ks[18], (N_CONV_LAYERS, d, d), f32) * d ** -0.5,
    }


def reference(x, c, ctx, c_ctx, ada_w, ada_b, norm1, norm2, norm_f, mlp_w1, mlp_w2,
              hgrn_w_in, hgrn_lb, hgrn_gnorm, hgrn_w_out, conv_w_in, conv_w, conv_b, conv_w_out):
    bsz, seq, _ = x.shape
    rows = seq // GRID_W
    lb_p = jax.nn.softmax(hgrn_lb.astype(jnp.float32), axis=1)
    lower_bounds = jnp.cumsum(lb_p, axis=1) - lb_p[:, :1]
    silu_c = jax.nn.silu(c)
    silu_cc = jax.nn.silu(c_ctx)
    last_rec = ((DEPTH - 1) // N_MIXERS) * N_MIXERS
    x_ctx = ctx
    for i in range(DEPTH):
        j = i // N_MIXERS
        recurrent = i % N_MIXERS == 0
        ctx_live = i < last_rec
        sh1, sc1, g1, sh2, sc2, g2 = jnp.split((silu_c @ ada_w[i] + ada_b[i])[:, None, :], 6, axis=-1)
        h = _modulate(_rmsnorm(x, norm1[i]), sh1, sc1)
        if ctx_live or recurrent:
            csh1, csc1, cg1, csh2, csc2, cg2 = jnp.split(silu_cc @ ada_w[i] + ada_b[i], 6)
            hc = _modulate(_rmsnorm(x_ctx, norm1[i]), csh1, csc1)
        if recurrent:
            y, yc = _hgrn2_mixer(h, hc, hgrn_w_in[j], lower_bounds[:, j], hgrn_gnorm[j],
                                 hgrn_w_out[j], ctx_live)
        else:
            axis = 2 if j % 2 == 0 else 1
            y = _shortconv_mixer(h.reshape(bsz, rows, GRID_W, D_MODEL), conv_w_in[j], conv_w[j],
                                 conv_b[j], conv_w_out[j], axis).reshape(bsz, seq, D_MODEL)
            yc = _shortconv_mixer(hc, conv_w_in[j], conv_w[j], conv_b[j], conv_w_out[j], 1) if ctx_live else None
        x = x + g1 * y
        x = x + g2 * _mlp(_modulate(_rmsnorm(x, norm2[i]), sh2, sc2), mlp_w1[i], mlp_w2[i])
        if ctx_live:
            x_ctx = x_ctx + cg1 * yc
            x_ctx = x_ctx + cg2 * _mlp(_modulate(_rmsnorm(x_ctx, norm2[i]), csh2, csc2), mlp_w1[i], mlp_w2[i])
    return _rmsnorm(x, norm_f)
```

```cpp
#include <hip/hip_runtime.h>
#include <hip/hip_cooperative_groups.h>
#include <cstdio>
namespace cg = cooperative_groups;

#define LAS __attribute__((address_space(3)))
typedef unsigned short bf16_t;
typedef short bf16x8 __attribute__((ext_vector_type(8)));
typedef float f32x4 __attribute__((ext_vector_type(4)));
typedef unsigned u32x4 __attribute__((ext_vector_type(4)));
typedef unsigned u32x2 __attribute__((ext_vector_type(2)));

constexpr int DM = 1024, NB = 4, SEQ = 8192, CTXL = 256, DFF = 4096;
constexpr int ML = NB * SEQ;
constexpr int MC = NB * CTXL;
constexpr int MT = ML + MC;
constexpr float EPS = 1e-6f;

constexpr size_t WS_X = 0;
constexpr size_t WS_Z = WS_X + (size_t)MT * DM * 4;
constexpr size_t WS_WIN = WS_Z + (size_t)MT * 5120 * 2;
constexpr size_t WS_WOUT = WS_WIN + (size_t)5120 * 1024 * 2;
constexpr size_t WS_W1 = WS_WOUT + (size_t)1024 * 1024 * 2;
constexpr size_t WS_W2 = WS_W1 + (size_t)4096 * 1024 * 2;
constexpr size_t WS_DB = WS_W2 + (size_t)4096 * 1024 * 2;
constexpr size_t WS_MOD = WS_DB + (size_t)2048 * 128 * 4;
constexpr size_t WS_LB = WS_MOD + (size_t)4 * 5 * 6144 * 4;
constexpr size_t WS_END = WS_LB + (size_t)2 * 2 * 1024 * 4;

constexpr int LDS_BYTES = 131072;

struct Params { const float* in[19]; float* out; unsigned char* ws; };

__device__ __forceinline__ float bf2f(bf16_t b) { return __uint_as_float(((unsigned)b) << 16); }
__device__ __forceinline__ bf16_t f2bf(float f) { unsigned u = __float_as_uint(f); u += 0x7FFFu + ((u >> 16) & 1u); return (bf16_t)(u >> 16); }
__device__ __forceinline__ unsigned pk2(float lo, float hi) { return (unsigned)f2bf(lo) | ((unsigned)f2bf(hi) << 16); }
__device__ __forceinline__ float sigmoidf_(float z) { return 1.0f / (1.0f + __expf(-z)); }
__device__ __forceinline__ float siluf_(float z) { return z / (1.0f + __expf(-z)); }

namespace pg8 {
constexpr int BM = 256, BK = 64, HALF = 128, HTB = HALF * BK * 2, NXCD = 8, WGM = 8;
__device__ __forceinline__ int lds_byte(int r, int c) { const int st = (r >> 4) * 2 + (c >> 5), rr = r & 15, cc = c & 31, ob = rr * 64 + cc * 2; return st * 1024 + (ob ^ (((ob >> 9) & 1) << 5)); }
__device__ __forceinline__ void stage_rc(int b, int& R, int& C) { const int st = b / 1024, sb = b % 1024, swz = sb ^ (((sb >> 9) & 1) << 5); R = (st >> 1) * 16 + swz / 64; C = (st & 1) * 32 + (swz % 64) / 2; }
__device__ __forceinline__ int perm32(int rho) { const int n = rho >> 4, i = rho & 15; return 8 * (i >> 2) + 4 * n + (i & 3); }

struct Unit { int pm, pn; };
struct Gemm { const bf16_t* A; const bf16_t* Bt; int M, N, K, lda; };

struct StaticOrder {
    int nM, nN, nwg, G, c;
    __device__ void init(int M, int N, int G_, int c_) { nM = M / BM; nN = N / BM; nwg = nM * nN; G = G_; c = c_; }
    __device__ bool next(int i, Unit& u) const {
        const long L = (long)i * G + c; if (L >= nwg) return false;
        int wgid = (int)L; { const int q = nwg / NXCD, r = nwg % NXCD, xcd = wgid % NXCD, off = wgid / NXCD; wgid = (xcd < r ? xcd * (q + 1) : r * (q + 1) + (xcd - r) * q) + off; }
        const int nig = WGM * nN, gid = wgid / nig, fm = gid * WGM, gsz = (nM - fm) < WGM ? (nM - fm) : WGM;
        u.pm = fm + ((wgid % nig) % gsz); u.pn = (wgid % nig) / gsz; return true;
    }
};

template <class Epi>
__device__ __forceinline__ void gemm_phase(LAS unsigned char* lds, const Gemm g, const StaticOrder& S, const Epi& E) {
    int tid_ = threadIdx.x; asm volatile("" : "+v"(tid_));
    const int tid = tid_, wid = __builtin_amdgcn_readfirstlane(tid >> 6), lane = tid & 63, wr = wid >> 2, wc = wid & 3, fr = lane & 15, fq = lane >> 4;
    const int K = g.K, nt = K / BK, lda = g.lda;
    unsigned voffA[2], voffB[2];
#pragma unroll
    for (int i = 0; i < 2; ++i) { int R, C; stage_rc(tid * 16 + i * 8192, R, C); const int Rb = Epi::PERM ? ((R & ~31) + perm32(R & 31)) : R;
        voffA[i] = (unsigned)(R * lda + C) * 2u; voffB[i] = (unsigned)(Rb * K + C) * 2u; }
    const size_t kstep = (size_t)(BK * 2);
    const size_t hstepA = (size_t)HALF * lda * 2, hstepB = (size_t)HALF * K * 2;
    const size_t tstepA = 2 * hstepA, tstepB = 2 * hstepB;
    const unsigned ldsw = (unsigned)wid * 1024u;
    const int aoff = lds_byte(wr * 64 + fr, fq * 8), boff = lds_byte(wc * 32 + fr, fq * 8);
#define PG8_SA(b, h) (((b) * 2 + (h)) * HTB)
#define PG8_SB(b, h) ((4 + (b) * 2 + (h)) * HTB)
#define PG8_STAGE(bufoff, gbase, voff) do { _Pragma("unroll") for (int _i = 0; _i < 2; ++_i) \
        __builtin_amdgcn_global_load_lds((const unsigned*)((const char*)(gbase) + (voff)[_i]), (LAS unsigned*)(lds + (bufoff) + ldsw + _i * 8192), 16, 0, 0); } while (0)
#define PG8_LDA(dst, b, h) do { _Pragma("unroll") for (int m = 0; m < 4; ++m) _Pragma("unroll") for (int k = 0; k < 2; ++k) dst[m][k] = *(const LAS bf16x8*)(lds + PG8_SA(b, h) + aoff + m * 2048 + k * 1024); } while (0)
#define PG8_LDB(dst, b, h) do { _Pragma("unroll") for (int n = 0; n < 2; ++n) _Pragma("unroll") for (int k = 0; k < 2; ++k) dst[n][k] = *(const LAS bf16x8*)(lds + PG8_SB(b, h) + boff + n * 2048 + k * 1024); } while (0)
#define PG8_MMA(ai, bj, At, Bt) do { __builtin_amdgcn_s_setprio(1); _Pragma("unroll") for (int m = 0; m < 4; ++m) _Pragma("unroll") for (int n = 0; n < 2; ++n) _Pragma("unroll") for (int k = 0; k < 2; ++k) \
        acc[ai][bj][m][n] = __builtin_amdgcn_mfma_f32_16x16x32_bf16(Bt[n][k], At[m][k], acc[ai][bj][m][n], 0, 0, 0); __builtin_amdgcn_s_setprio(0); } while (0)
#define PG8_WAIT_V(n) asm volatile("s_waitcnt vmcnt(" #n ")" ::: "memory")
#define PG8_WAIT_L(n) asm volatile("s_waitcnt lgkmcnt(" #n ")" ::: "memory")
#define PG8_BAR __builtin_amdgcn_s_barrier()
#define PG8_SCHED __builtin_amdgcn_sched_barrier(0)
    Unit cur, nxt; int ui = 0;
    if (!S.next(0, cur)) return;
    f32x4 acc[2][2][4][2];
#pragma unroll
    for (int a = 0; a < 2; ++a)
#pragma unroll
        for (int b = 0; b < 2; ++b)
#pragma unroll
            for (int m = 0; m < 4; ++m)
#pragma unroll
                for (int n = 0; n < 2; ++n) acc[a][b][m][n] = (f32x4){0.f, 0.f, 0.f, 0.f};
    bf16x8 At[4][2], B0[2][2], B1[2][2];
    const char* cA = (const char*)g.A + (size_t)cur.pm * tstepA; const char* cB = (const char*)g.Bt + (size_t)cur.pn * tstepB;
    PG8_STAGE(PG8_SB(0, 0), cB, voffB); PG8_STAGE(PG8_SA(0, 0), cA, voffA); PG8_STAGE(PG8_SB(0, 1), cB + hstepB, voffB); PG8_STAGE(PG8_SA(0, 1), cA + hstepA, voffA);
    if (wr == 1) PG8_BAR;
    PG8_WAIT_V(4); PG8_BAR;
    PG8_STAGE(PG8_SB(1, 0), cB + kstep, voffB); PG8_STAGE(PG8_SA(1, 0), cA + kstep, voffA); PG8_STAGE(PG8_SB(1, 1), cB + hstepB + kstep, voffB);
    PG8_WAIT_V(6); PG8_BAR;
    for (;;) {
        const bool has_next = S.next(ui + 1, nxt);
        const char* nA = has_next ? (const char*)g.A + (size_t)nxt.pm * tstepA : cA; const char* nB = has_next ? (const char*)g.Bt + (size_t)nxt.pn * tstepB : cB;
        for (int t = 0; t < nt; t += 2) {
            const bool last = (t == nt - 2);
            const char* a1 = cA + (size_t)(t + 1) * kstep;
            const char* a2 = last ? nA : cA + (size_t)(t + 2) * kstep; const char* b2 = last ? nB : cB + (size_t)(t + 2) * kstep;
            const char* a3 = a2 + kstep; const char* b3 = b2 + kstep;
            PG8_LDB(B0, 0, 0); PG8_SCHED; PG8_LDA(At, 0, 0); PG8_STAGE(PG8_SA(1, 1), a1 + hstepA, voffA);
            PG8_WAIT_L(8); PG8_BAR; PG8_WAIT_L(0); PG8_MMA(0, 0, At, B0); PG8_BAR; PG8_SCHED;
            PG8_LDB(B1, 0, 1); PG8_STAGE(PG8_SB(0, 0), b2, voffB);
            PG8_BAR; PG8_WAIT_L(0); PG8_MMA(0, 1, At, B1); PG8_BAR;
            PG8_LDA(At, 0, 1); PG8_STAGE(PG8_SA(0, 0), a2, voffA);
            PG8_BAR; PG8_WAIT_L(0); PG8_MMA(1, 0, At, B0); PG8_BAR; PG8_SCHED;
            PG8_STAGE(PG8_SB(0, 1), b2 + hstepB, voffB);
            PG8_WAIT_V(6); PG8_BAR; PG8_MMA(1, 1, At, B1); PG8_BAR;
            PG8_LDB(B0, 1, 0); PG8_SCHED; PG8_LDA(At, 1, 0); PG8_STAGE(PG8_SA(0, 1), a2 + hstepA, voffA);
            PG8_WAIT_L(8); PG8_BAR; PG8_WAIT_L(0); PG8_MMA(0, 0, At, B0); PG8_BAR; PG8_SCHED;
            PG8_LDB(B1, 1, 1); PG8_STAGE(PG8_SB(1, 0), b3, voffB);
            PG8_BAR; PG8_WAIT_L(0); PG8_MMA(0, 1, At, B1); PG8_BAR;
            PG8_LDA(At, 1, 1); PG8_STAGE(PG8_SA(1, 0), a3, voffA);
            PG8_BAR; PG8_WAIT_L(0); PG8_MMA(1, 0, At, B0); PG8_BAR; PG8_SCHED;
            PG8_STAGE(PG8_SB(1, 1), b3 + hstepB, voffB);
            PG8_WAIT_V(6); PG8_BAR; PG8_MMA(1, 1, At, B1); PG8_BAR;
        }
        E(acc, cur, wr, wc, fr, fq);
        if (!has_next) break;
#pragma unroll
        for (int a = 0; a < 2; ++a)
#pragma unroll
            for (int b = 0; b < 2; ++b)
#pragma unroll
                for (int m = 0; m < 4; ++m)
#pragma unroll
                    for (int n = 0; n < 2; ++n) acc[a][b][m][n] = (f32x4){0.f, 0.f, 0.f, 0.f};
        cur = nxt; cA = nA; cB = nB; ++ui;
    }
    PG8_WAIT_V(0);
    if (wr == 0) PG8_BAR;
    PG8_BAR;
#undef PG8_SA
#undef PG8_SB
#undef PG8_STAGE
#undef PG8_LDA
#undef PG8_LDB
#undef PG8_MMA
#undef PG8_WAIT_V
#undef PG8_WAIT_L
#undef PG8_BAR
#undef PG8_SCHED
}
}

struct EpiHgrnIn {
    static constexpr bool PERM = true;
    bf16_t* Z; const float* lbv;
    __device__ __forceinline__ void operator()(const f32x4 (&acc)[2][2][4][2], const pg8::Unit& u, int wr, int wc, int fr, int fq) const {
        const int part = u.pn >> 2;
        const int row0 = u.pm * 256 + wr * 64 + fr, col0 = u.pn * 256 + wc * 32 + 8 * fq;
        f32x4 lb[2][2];
#pragma unroll
        for (int bj = 0; bj < 2; ++bj)
#pragma unroll
            for (int n = 0; n < 2; ++n) lb[bj][n] = (part < 2) ? *(const f32x4*)(lbv + col0 + bj * 128 + 4 * n) : (f32x4){0.f, 0.f, 0.f, 0.f};
#pragma unroll
        for (int ai = 0; ai < 2; ++ai)
#pragma unroll
            for (int m = 0; m < 4; ++m) {
                bf16_t* rowp = Z + (size_t)(row0 + ai * 128 + m * 16) * 5120 + col0;
#pragma unroll
                for (int bj = 0; bj < 2; ++bj) {
                    float o[8];
#pragma unroll
                    for (int n = 0; n < 2; ++n)
#pragma unroll
                        for (int j = 0; j < 4; ++j) {
                            const float z = acc[ai][bj][m][n][j]; float r;
                            if (part < 2) { const float l = lb[bj][n][j]; const float f = l + (1.0f - l) * sigmoidf_(z); r = __logf(fmaxf(f, 1e-30f)); }
                            else if (part == 2) r = z;
                            else r = siluf_(z);
                            o[n * 4 + j] = r;
                        }
                    u32x4 w; w.x = pk2(o[0], o[1]); w.y = pk2(o[2], o[3]); w.z = pk2(o[4], o[5]); w.w = pk2(o[6], o[7]);
                    *(u32x4*)(rowp + bj * 128) = w;
                }
            }
    }
};
struct EpiConvIn {
    static constexpr bool PERM = true;
    bf16_t* Z;
    __device__ __forceinline__ void operator()(const f32x4 (&acc)[2][2][4][2], const pg8::Unit& u, int wr, int wc, int fr, int fq) const {
        const int row0 = u.pm * 256 + wr * 64 + fr;
        if (u.pn < 4) {
            const int col0 = u.pn * 256 + wc * 32 + 8 * fq;
#pragma unroll
            for (int ai = 0; ai < 2; ++ai)
#pragma unroll
                for (int m = 0; m < 4; ++m) {
                    bf16_t* rowp = Z + (size_t)(row0 + ai * 128 + m * 16) * 2048 + col0;
#pragma unroll
                    for (int bj = 0; bj < 2; ++bj) {
                        const f32x4 v0 = acc[ai][bj][m][0], v1 = acc[ai][bj][m][1];
                        u32x4 w; w.x = pk2(v0[0], v0[1]); w.y = pk2(v0[2], v0[3]); w.z = pk2(v1[0], v1[1]); w.w = pk2(v1[2], v1[3]);
                        *(u32x4*)(rowp + bj * 128) = w;
                    }
                }
        } else {
            const int col0 = 1024 + (u.pn - 4) * 128 + wc * 32 + 8 * fq;
#pragma unroll
            for (int ai = 0; ai < 2; ++ai)
#pragma unroll
                for (int m = 0; m < 4; ++m) {
                    bf16_t* rowp = Z + (size_t)(row0 + ai * 128 + m * 16) * 2048 + col0;
                    const f32x4 v0 = acc[ai][0][m][0] * acc[ai][1][m][0], v1 = acc[ai][0][m][1] * acc[ai][1][m][1];
                    u32x4 w; w.x = pk2(v0[0], v0[1]); w.y = pk2(v0[2], v0[3]); w.z = pk2(v1[0], v1[1]); w.w = pk2(v1[2], v1[3]);
                    *(u32x4*)rowp = w;
                }
        }
    }
};
struct EpiRelu2 {
    static constexpr bool PERM = true;
    bf16_t* Z;
    __device__ __forceinline__ void operator()(const f32x4 (&acc)[2][2][4][2], const pg8::Unit& u, int wr, int wc, int fr, int fq) const {
        const int row0 = u.pm * 256 + wr * 64 + fr, col0 = u.pn * 256 + wc * 32 + 8 * fq;
#pragma unroll
        for (int ai = 0; ai < 2; ++ai)
#pragma unroll
            for (int m = 0; m < 4; ++m) {
                bf16_t* rowp = Z + (size_t)(row0 + ai * 128 + m * 16) * 4096 + col0;
#pragma unroll
                for (int bj = 0; bj < 2; ++bj) {
                    float o[8];
#pragma unroll
                    for (int n = 0; n < 2; ++n)
#pragma unroll
                        for (int j = 0; j < 4; ++j) { const float z = fmaxf(acc[ai][bj][m][n][j], 0.f); o[n * 4 + j] = z * z; }
                    u32x4 w; w.x = pk2(o[0], o[1]); w.y = pk2(o[2], o[3]); w.z = pk2(o[4], o[5]); w.w = pk2(o[6], o[7]);
                    *(u32x4*)(rowp + bj * 128) = w;
                }
            }
    }
};
struct EpiResid {
    static constexpr bool PERM = false;
    float* X; const float* resL; const float* resC; const float* gate;
    __device__ __forceinline__ void operator()(const f32x4 (&acc)[2][2][4][2], const pg8::Unit& u, int wr, int wc, int fr, int fq) const {
        const int row0 = u.pm * 256 + wr * 64 + fr, col0 = u.pn * 256 + wc * 32 + 4 * fq;
        const int bb = u.pm < 128 ? (u.pm >> 5) : 4;
        const float* gp = gate + (size_t)bb * 6144 + col0;
        f32x4 gv[2][2];
#pragma unroll
        for (int bj = 0; bj < 2; ++bj)
#pragma unroll
            for (int n = 0; n < 2; ++n) gv[bj][n] = *(const f32x4*)(gp + bj * 128 + n * 16);
#pragma unroll
        for (int ai = 0; ai < 2; ++ai)
#pragma unroll
            for (int m = 0; m < 4; ++m) {
                const int row = row0 + ai * 128 + m * 16;
                const float* rp = (row < ML ? resL + (size_t)row * DM : resC + (size_t)(row - ML) * DM) + col0;
                float* xp = X + (size_t)row * DM + col0;
#pragma unroll
                for (int bj = 0; bj < 2; ++bj)
#pragma unroll
                    for (int n = 0; n < 2; ++n) {
                        const f32x4 r = *(const f32x4*)(rp + bj * 128 + n * 16);
                        *(f32x4*)(xp + bj * 128 + n * 16) = r + gv[bj][n] * acc[ai][bj][m][n];
                    }
            }
    }
};

__device__ __forceinline__ void phase_ada(const Params& p, LAS unsigned char* lds, float* mods, float* lbv) {
    int tid_ = threadIdx.x; asm volatile("" : "+v"(tid_)); const int tid = tid_;
    LAS float* s = (LAS float*)lds;
    LAS float* red = s + 5 * 1024;
    const float* c = p.in[1]; const float* cc = p.in[3];
    for (int i = tid; i < 5 * 1024; i += 512) { const int bb = i >> 10, k = i & 1023; const float v = bb < 4 ? c[bb * 1024 + k] : cc[k]; s[i] = siluf_(v); }
    __syncthreads();
    const int col = tid & 63, ks = tid >> 6;
    for (int item = blockIdx.x; item < 4 * 96; item += gridDim.x) {
        const int l = item / 96, n0 = (item % 96) * 64;
        const float* W = p.in[4] + (size_t)l * 1024 * 6144 + n0 + col;
        float a0 = 0.f, a1 = 0.f, a2 = 0.f, a3 = 0.f, a4 = 0.f;
#pragma unroll 8
        for (int k = ks * 128; k < ks * 128 + 128; ++k) {
            const float w = W[(size_t)k * 6144];
            a0 += s[k] * w; a1 += s[1024 + k] * w; a2 += s[2048 + k] * w; a3 += s[3072 + k] * w; a4 += s[4096 + k] * w;
        }
        red[(ks * 5 + 0) * 64 + col] = a0; red[(ks * 5 + 1) * 64 + col] = a1; red[(ks * 5 + 2) * 64 + col] = a2; red[(ks * 5 + 3) * 64 + col] = a3; red[(ks * 5 + 4) * 64 + col] = a4;
        __syncthreads();
        if (tid < 320) {
            const int bb = tid >> 6; float t = 0.f;
#pragma unroll
            for (int q = 0; q < 8; ++q) t += red[(q * 5 + bb) * 64 + col];
            mods[(size_t)(l * 5 + bb) * 6144 + n0 + col] = t + p.in[5][l * 6144 + n0 + col];
        }
        __syncthreads();
    }
    if (blockIdx.x == 0) {
        const float* hl = p.in[12];
        for (int i = tid; i < 2 * 1024; i += 512) {
            const int d = i >> 10, ch = i & 1023;
            const float a = hl[(d * 2 + 0) * 1024 + ch], b = hl[(d * 2 + 1) * 1024 + ch];
            const float m = fmaxf(a, b), ea = __expf(a - m), eb = __expf(b - m);
            lbv[(0 * 2 + d) * 1024 + ch] = 0.f;
            lbv[(1 * 2 + d) * 1024 + ch] = eb / (ea + eb);
        }
    }
}

__device__ __forceinline__ void cvt_tile(const float* src, int ld, int Kdim, bf16_t* dst, int ntile, int ktile, int mapmode, LAS float* T) {
    int tid_ = threadIdx.x; asm volatile("" : "+v"(tid_)); const int tid = tid_;
    const int n0 = ntile * 64, k0 = ktile * 64;
    int sc0 = n0;
    if (mapmode && n0 >= 1024) { const int t = (n0 - 1024) >> 8, w = (n0 - 1024) & 255; sc0 = (w < 128) ? 1024 + 128 * t + w : 2048 + 128 * t + (w - 128); }
    {
        const int kk = tid >> 3, n8 = (tid & 7) * 8;
        const float* sp = src + (size_t)(k0 + kk) * ld + sc0 + n8;
        const f32x4 a = *(const f32x4*)sp, b = *(const f32x4*)(sp + 4);
        LAS float* tp = T + kk * 65 + n8;
        tp[0] = a[0]; tp[1] = a[1]; tp[2] = a[2]; tp[3] = a[3]; tp[4] = b[0]; tp[5] = b[1]; tp[6] = b[2]; tp[7] = b[3];
    }
    __syncthreads();
    {
        const int nn = tid >> 3, k8 = (tid & 7) * 8;
        float v[8];
#pragma unroll
        for (int i = 0; i < 8; ++i) v[i] = T[(k8 + i) * 65 + nn];
        u32x4 w; w.x = pk2(v[0], v[1]); w.y = pk2(v[2], v[3]); w.z = pk2(v[4], v[5]); w.w = pk2(v[6], v[7]);
        *(u32x4*)(dst + (size_t)(n0 + nn) * Kdim + k0 + k8) = w;
    }
    __syncthreads();
}
__device__ __forceinline__ void phase_cvt(const Params& p, LAS unsigned char* lds, int L) {
    const int j = L >> 1; const bool rec = (L & 1) == 0;
    const int Nin = rec ? 5120 : 3072;
    const float* win = rec ? p.in[11] + (size_t)j * 1024 * 5120 : p.in[15] + (size_t)j * 1024 * 3072;
    const float* wout = rec ? p.in[14] + (size_t)j * 1024 * 1024 : p.in[18] + (size_t)j * 1024 * 1024;
    const float* w1 = p.in[9] + (size_t)L * 1024 * 4096;
    const float* w2 = p.in[10] + (size_t)L * 4096 * 1024;
    bf16_t* Win_t = (bf16_t*)(p.ws + WS_WIN); bf16_t* Wout_t = (bf16_t*)(p.ws + WS_WOUT); bf16_t* W1_t = (bf16_t*)(p.ws + WS_W1); bf16_t* W2_t = (bf16_t*)(p.ws + WS_W2);
    const int t0 = (Nin / 64) * 16, t1 = t0 + 256, t2 = t1 + 1024, t3 = t2 + 1024;
    LAS float* T = (LAS float*)lds;
    for (int it = blockIdx.x; it < t3; it += gridDim.x) {
        if (it < t0) cvt_tile(win, Nin, 1024, Win_t, it >> 4, it & 15, rec ? 0 : 1, T);
        else if (it < t1) { const int q = it - t0; cvt_tile(wout, 1024, 1024, Wout_t, q >> 4, q & 15, 0, T); }
        else if (it < t2) { const int q = it - t1; cvt_tile(w1, 4096, 1024, W1_t, q >> 4, q & 15, 0, T); }
        else { const int q = it - t2; cvt_tile(w2, 1024, 4096, W2_t, q >> 6, q & 63, 0, T); }
    }
}

__device__ __forceinline__ void phase_norm(const float* srcL, const float* srcC, int M, const float* gain, const float* mod, int shoff, int scoff, bf16_t* HA) {
    int tid_ = threadIdx.x; asm volatile("" : "+v"(tid_));
    const int lane = tid_ & 63, gw = blockIdx.x * 8 + (tid_ >> 6), nw = gridDim.x * 8;
    for (int r = gw; r < M; r += nw) {
        const float* xr = r < ML ? srcL + (size_t)r * DM : srcC + (size_t)(r - ML) * DM;
        const int bb = r < ML ? (r >> 13) : 4;
        const float* mp = mod + (size_t)bb * 6144;
        f32x4 v[4]; float ss = 0.f;
#pragma unroll
        for (int i = 0; i < 4; ++i) { v[i] = *(const f32x4*)(xr + i * 256 + lane * 4); ss += v[i][0] * v[i][0] + v[i][1] * v[i][1] + v[i][2] * v[i][2] + v[i][3] * v[i][3]; }
#pragma unroll
        for (int o = 32; o >= 1; o >>= 1) ss += __shfl_xor(ss, o);
        const float rstd = rsqrtf(ss * (1.0f / DM) + EPS);
#pragma unroll
        for (int i = 0; i < 4; ++i) {
            const int col = i * 256 + lane * 4;
            const f32x4 g = *(const f32x4*)(gain + col), sc = *(const f32x4*)(mp + scoff + col), sh = *(const f32x4*)(mp + shoff + col);
            float h[4];
#pragma unroll
            for (int q = 0; q < 4; ++q) h[q] = (v[i][q] * rstd * g[q]) * (1.0f + sc[q]) + sh[q];
            u32x2 w; w.x = pk2(h[0], h[1]); w.y = pk2(h[2], h[3]);
            *(u32x2*)(HA + (size_t)r * DM + col) = w;
        }
    }
}
__device__ __forceinline__ void phase_final(const float* X, const float* gain, float* out) {
    int tid_ = threadIdx.x; asm volatile("" : "+v"(tid_));
    const int lane = tid_ & 63, gw = blockIdx.x * 8 + (tid_ >> 6), nw = gridDim.x * 8;
    for (int r = gw; r < ML; r += nw) {
        const float* xr = X + (size_t)r * DM;
        f32x4 v[4]; float ss = 0.f;
#pragma unroll
        for (int i = 0; i < 4; ++i) { v[i] = *(const f32x4*)(xr + i * 256 + lane * 4); ss += v[i][0] * v[i][0] + v[i][1] * v[i][1] + v[i][2] * v[i][2] + v[i][3] * v[i][3]; }
#pragma unroll
        for (int o = 32; o >= 1; o >>= 1) ss += __shfl_xor(ss, o);
        const float rstd = rsqrtf(ss * (1.0f / DM) + EPS);
#pragma unroll
        for (int i = 0; i < 4; ++i) {
            const int col = i * 256 + lane * 4;
            const f32x4 g = *(const f32x4*)(gain + col);
            *(f32x4*)(out + (size_t)r * DM + col) = v[i] * rstd * g;
        }
    }
}

__device__ __forceinline__ void phase_conv(const bf16_t* Z, const float* cw, const float* cb, int axis_rows, int M, bf16_t* HA) {
    int tid_ = threadIdx.x; asm volatile("" : "+v"(tid_));
    const int gt = blockIdx.x * 512 + tid_, nth = gridDim.x * 512;
    for (int it = gt; it < M * 128; it += nth) {
        const int r = it >> 7, c8 = (it & 127) * 8;
        int dlt; bool hasp, hasn;
        if (r < ML) {
            const int t = r & (SEQ - 1);
            if (axis_rows) { dlt = 64; const int gr = t >> 6; hasp = gr > 0; hasn = gr < 127; }
            else { dlt = 1; const int gc = t & 63; hasp = gc > 0; hasn = gc < 63; }
        } else { dlt = 1; const int t = (r - ML) & (CTXL - 1); hasp = t > 0; hasn = t < CTXL - 1; }
        const bf16_t* up = Z + (size_t)r * 2048 + 1024 + c8;
        const u32x4 uc = *(const u32x4*)up;
        u32x4 upv = (u32x4){0u, 0u, 0u, 0u}, unv = (u32x4){0u, 0u, 0u, 0u};
        if (hasp) upv = *(const u32x4*)(up - (size_t)dlt * 2048);
        if (hasn) unv = *(const u32x4*)(up + (size_t)dlt * 2048);
        const u32x4 gb = *(const u32x4*)(Z + (size_t)r * 2048 + c8);
        float o[8];
#pragma unroll
        for (int q = 0; q < 8; ++q) {
            const unsigned sh = (q & 1) * 16;
            const float u0 = __uint_as_float(((upv[q >> 1] >> sh) & 0xFFFFu) << 16), u1 = __uint_as_float(((uc[q >> 1] >> sh) & 0xFFFFu) << 16), u2 = __uint_as_float(((unv[q >> 1] >> sh) & 0xFFFFu) << 16);
            const float g = __uint_as_float(((gb[q >> 1] >> sh) & 0xFFFFu) << 16);
            const int ch = c8 + q;
            o[q] = g * (cb[ch] + cw[ch] * u0 + cw[1024 + ch] * u1 + cw[2048 + ch] * u2);
        }
        u32x4 w; w.x = pk2(o[0], o[1]); w.y = pk2(o[2], o[3]); w.z = pk2(o[4], o[5]); w.w = pk2(o[6], o[7]);
        *(u32x4*)(HA + (size_t)r * DM + c8) = w;
    }
}

constexpr int G_QT = 0, G_KT = 17408, G_KTT = 34816, G_VTT = 53248, G_PP = 71680, G_STT = 80896, G_TOT = 115712, G_SSQ = 117760;
constexpr int PQ = 136, PT = 72;

__device__ __forceinline__ f32x4 mfma16(bf16x8 a, bf16x8 b, f32x4 c) { return __builtin_amdgcn_mfma_f32_16x16x32_bf16(a, b, c, 0, 0, 0); }

template <bool OUT, int D>
__device__ __forceinline__ void gla_chunk(LAS unsigned char* lds, bf16_t* Z, int row0  , int h, f32x4 (&S)[8], float& lastsum, const float* gnorm) {
    int tid_ = threadIdx.x; asm volatile("" : "+v"(tid_));
    const int tid = tid_, lane = tid & 63, w = __builtin_amdgcn_readfirstlane(tid >> 6);
    const int col = tid & 127, tq = tid >> 7;
    const int l15 = lane & 15, lq = lane >> 4;
    LAS bf16_t* QT = (LAS bf16_t*)(lds + G_QT); LAS bf16_t* KT = (LAS bf16_t*)(lds + G_KT); LAS bf16_t* KTT = (LAS bf16_t*)(lds + G_KTT);
    LAS bf16_t* VTT = (LAS bf16_t*)(lds + G_VTT); LAS bf16_t* PP = (LAS bf16_t*)(lds + G_PP); LAS bf16_t* STT = (LAS bf16_t*)(lds + G_STT);
    LAS float* TOT = (LAS float*)(lds + G_TOT); LAS float* SSQ = (LAS float*)(lds + G_SSQ);
    float g[16], q[16], v[16], c[16];
    {
        const bf16_t* zr = Z + (size_t)(row0 + tq * 16) * 5120 + h * 128 + col;
#pragma unroll
        for (int i = 0; i < 16; ++i) {
            g[i] = bf2f(zr[(size_t)i * 5120 + D * 1024]);
            v[i] = bf2f(zr[(size_t)i * 5120 + 2048]);
            if (OUT) q[i] = bf2f(zr[(size_t)i * 5120 + 3072]); else q[i] = 0.f;
        }
    }
    if (D == 0) { c[0] = g[0];
#pragma unroll
        for (int i = 1; i < 16; ++i) c[i] = c[i - 1] + g[i];
        TOT[tq * 128 + col] = c[15];
    } else { c[15] = g[15];
#pragma unroll
        for (int i = 14; i >= 0; --i) c[i] = c[i + 1] + g[i];
        TOT[tq * 128 + col] = c[0];
    }
    __syncthreads();
    {
        const float t0 = TOT[col], t1 = TOT[128 + col], t2 = TOT[256 + col], t3 = TOT[384 + col];
        float ref, pre;
        if (D == 0) { ref = t0 + t1; pre = (tq > 0 ? t0 : 0.f) + (tq > 1 ? t1 : 0.f) + (tq > 2 ? t2 : 0.f); }
        else { ref = t2 + t3; pre = (tq < 3 ? t3 : 0.f) + (tq < 2 ? t2 : 0.f) + (tq < 1 ? t1 : 0.f); }
        if (tq == 0) lastsum += (t0 + t1) + (t2 + t3);
        float kt[16];
#pragma unroll
        for (int i = 0; i < 16; ++i) {
            const float cum = pre + c[i];
            const float kk = 1.0f - __expf(g[i]);
            kt[i] = kk * __expf(ref - cum);
            const int t = tq * 16 + i;
            if (OUT) { QT[t * PQ + col] = f2bf(q[i] * __expf(cum - ref)); KT[t * PQ + col] = f2bf(kt[i]); }
        }
        u32x4 a, b;
        a.x = pk2(kt[0], kt[1]); a.y = pk2(kt[2], kt[3]); a.z = pk2(kt[4], kt[5]); a.w = pk2(kt[6], kt[7]);
        b.x = pk2(kt[8], kt[9]); b.y = pk2(kt[10], kt[11]); b.z = pk2(kt[12], kt[13]); b.w = pk2(kt[14], kt[15]);
        *(LAS u32x4*)(KTT + col * PT + tq * 16) = a; *(LAS u32x4*)(KTT + col * PT + tq * 16 + 8) = b;
        a.x = pk2(v[0], v[1]); a.y = pk2(v[2], v[3]); a.z = pk2(v[4], v[5]); a.w = pk2(v[6], v[7]);
        b.x = pk2(v[8], v[9]); b.y = pk2(v[10], v[11]); b.z = pk2(v[12], v[13]); b.w = pk2(v[14], v[15]);
        *(LAS u32x4*)(VTT + col * PT + tq * 16) = a; *(LAS u32x4*)(VTT + col * PT + tq * 16 + 8) = b;
    }
    float el[4];
    {
        float er[4];
#pragma unroll
        for (int j = 0; j < 4; ++j) {
            const int kidx = 16 * w + lq * 4 + j;
            const float a0 = TOT[kidx], a1 = TOT[128 + kidx], a2 = TOT[256 + kidx], a3 = TOT[384 + kidx];
            const float refk = (D == 0) ? (a0 + a1) : (a2 + a3), lrk = (D == 0) ? (a2 + a3) : (a0 + a1);
            er[j] = __expf(refk); el[j] = __expf(lrk);
        }
#pragma unroll
        for (int vt = 0; vt < 8; ++vt) {
#pragma unroll
            for (int j = 0; j < 4; ++j) S[vt][j] *= er[j];
            if (OUT) { u32x2 wv; wv.x = pk2(S[vt][0], S[vt][1]); wv.y = pk2(S[vt][2], S[vt][3]);
                *(LAS u32x2*)(STT + (16 * vt + l15) * PQ + 16 * w + lq * 4) = wv; }
        }
    }
    __syncthreads();
    if (OUT) {
        const int st = w >> 1, ct0 = (w & 1) * 2;
#pragma unroll
        for (int i = 0; i < 2; ++i) {
            const int ct = ct0 + i;
            f32x4 a = (f32x4){0.f, 0.f, 0.f, 0.f};
            const bool zero = (D == 0) ? (st > ct) : (st < ct);
            if (!zero) {
#pragma unroll
                for (int ks = 0; ks < 4; ++ks) {
                    const bf16x8 fa = *(const LAS bf16x8*)(KT + (16 * st + l15) * PQ + ks * 32 + lq * 8);
                    const bf16x8 fb = *(const LAS bf16x8*)(QT + (16 * ct + l15) * PQ + ks * 32 + lq * 8);
                    a = mfma16(fa, fb, a);
                }
                const int cc = 16 * ct + l15;
#pragma unroll
                for (int j = 0; j < 4; ++j) { const int ss = 16 * st + lq * 4 + j; const bool keep = (D == 0) ? (ss <= cc) : (ss >= cc); a[j] = keep ? a[j] : 0.f; }
            }
            u32x2 wv; wv.x = pk2(a[0], a[1]); wv.y = pk2(a[2], a[3]);
            *(LAS u32x2*)(PP + (16 * ct + l15) * PT + 16 * st + lq * 4) = wv;
        }
    }
    {
        bf16x8 fa[2];
#pragma unroll
        for (int ks = 0; ks < 2; ++ks) fa[ks] = *(const LAS bf16x8*)(KTT + (16 * w + l15) * PT + ks * 32 + lq * 8);
#pragma unroll
        for (int vt = 0; vt < 8; ++vt) {
#pragma unroll
            for (int ks = 0; ks < 2; ++ks) {
                const bf16x8 fb = *(const LAS bf16x8*)(VTT + (16 * vt + l15) * PT + ks * 32 + lq * 8);
                S[vt] = mfma16(fa[ks], fb, S[vt]);
            }
#pragma unroll
            for (int j = 0; j < 4; ++j) S[vt][j] *= el[j];
        }
    }
    if (OUT) {
        __syncthreads();
        const int rt = w & 3, vh = (w >> 2) * 4;
        f32x4 o[4];
#pragma unroll
        for (int i = 0; i < 4; ++i) o[i] = (f32x4){0.f, 0.f, 0.f, 0.f};
#pragma unroll
        for (int ks = 0; ks < 2; ++ks) {
            const bf16x8 fa = *(const LAS bf16x8*)(PP + (16 * rt + l15) * PT + ks * 32 + lq * 8);
#pragma unroll
            for (int i = 0; i < 4; ++i) { const bf16x8 fb = *(const LAS bf16x8*)(VTT + (16 * (vh + i) + l15) * PT + ks * 32 + lq * 8); o[i] = mfma16(fa, fb, o[i]); }
        }
#pragma unroll
        for (int ks = 0; ks < 4; ++ks) {
            const bf16x8 fa = *(const LAS bf16x8*)(QT + (16 * rt + l15) * PQ + ks * 32 + lq * 8);
#pragma unroll
            for (int i = 0; i < 4; ++i) { const bf16x8 fb = *(const LAS bf16x8*)(STT + (16 * (vh + i) + l15) * PQ + ks * 32 + lq * 8); o[i] = mfma16(fa, fb, o[i]); }
        }
        bf16_t* zo = Z + (size_t)(row0 + 16 * rt + lq * 4) * 5120 + h * 128 + 16 * vh + l15;
        if (D == 0) {
#pragma unroll
            for (int j = 0; j < 4; ++j)
#pragma unroll
                for (int i = 0; i < 4; ++i) zo[(size_t)j * 5120 + 16 * i] = f2bf(o[i][j]);
        } else {
            __builtin_amdgcn_fence(__ATOMIC_ACQUIRE, "agent");
            float sq[4];
#pragma unroll
            for (int j = 0; j < 4; ++j) { sq[j] = 0.f;
#pragma unroll
                for (int i = 0; i < 4; ++i) { o[i][j] += bf2f(zo[(size_t)j * 5120 + 16 * i]); sq[j] += o[i][j] * o[i][j]; } }
#pragma unroll
            for (int j = 0; j < 4; ++j) { sq[j] += __shfl_xor(sq[j], 1); sq[j] += __shfl_xor(sq[j], 2); sq[j] += __shfl_xor(sq[j], 4); sq[j] += __shfl_xor(sq[j], 8); }
            if (l15 == 0) {
#pragma unroll
                for (int j = 0; j < 4; ++j) SSQ[(w >> 2) * 64 + 16 * rt + lq * 4 + j] = sq[j];
            }
            __syncthreads();
#pragma unroll
            for (int j = 0; j < 4; ++j) {
                const int cidx = 16 * rt + lq * 4 + j;
                const float rstd = rsqrtf((SSQ[cidx] + SSQ[64 + cidx]) * (1.0f / 128.0f) + EPS);
#pragma unroll
                for (int i = 0; i < 4; ++i) {
                    const float gt = bf2f(zo[(size_t)j * 5120 + 4096 + 16 * i]);
                    const float gn = gnorm[h * 128 + 16 * (vh + i) + l15];
                    zo[(size_t)j * 5120 + 1024 + 16 * i] = f2bf(o[i][j] * rstd * gn * gt);
                }
            }
        }
    }
}

__device__ __forceinline__ int sc_rowbase(int b, int jsc) { return jsc == 0 ? ML + b * CTXL : b * SEQ + (jsc - 1) * 256; }

__device__ __forceinline__ void phase_gla1(LAS unsigned char* lds, bf16_t* Z, float* Sbuf, float* Dbuf) {
    int tid_ = threadIdx.x; asm volatile("" : "+v"(tid_));
    const int tid = tid_, lane = tid & 63, w = __builtin_amdgcn_readfirstlane(tid >> 6);
    for (int task = blockIdx.x; task < 2048; task += gridDim.x) {
        const int bhd = task >> 5, p = task & 31, b = bhd >> 4, h = (bhd >> 1) & 7, d = bhd & 1;
        const int jsc = (p == 0) ? 0 : (d == 0 ? p : 33 - p);
        const int rb = sc_rowbase(b, jsc);
        f32x4 S[8];
#pragma unroll
        for (int vt = 0; vt < 8; ++vt) S[vt] = (f32x4){0.f, 0.f, 0.f, 0.f};
        float lastsum = 0.f;
        if (d == 0) { for (int ci = 0; ci < 4; ++ci) gla_chunk<false, 0>(lds, Z, rb + ci * 64, h, S, lastsum, nullptr); }
        else { for (int ci = 3; ci >= 0; --ci) gla_chunk<false, 1>(lds, Z, rb + ci * 64, h, S, lastsum, nullptr); }
        float* sp = Sbuf + (size_t)task * 16384;
#pragma unroll
        for (int vt = 0; vt < 8; ++vt)
#pragma unroll
            for (int j = 0; j < 4; ++j) sp[((w * 8 + vt) * 4 + j) * 64 + lane] = S[vt][j];
        if (tid < 128) Dbuf[(size_t)task * 128 + tid] = __expf(lastsum);
        __syncthreads();
    }
}
__device__ __forceinline__ void phase_gla2(float* Sbuf, const float* Dbuf) {
    int tid_ = threadIdx.x; asm volatile("" : "+v"(tid_));
    const int gt = blockIdx.x * 512 + tid_, nth = gridDim.x * 512;
    for (int idx = gt; idx < 64 * 4096; idx += nth) {
        const int bhd = idx >> 12, e4 = idx & 4095, e = e4 * 4;
        const int k = 16 * (e >> 11) + ((e & 63) >> 4) * 4 + ((e >> 6) & 3);
        f32x4 s = (f32x4){0.f, 0.f, 0.f, 0.f};
        f32x4* sp = (f32x4*)(Sbuf + (size_t)bhd * 32 * 16384) + e4;
        const float* dp = Dbuf + (size_t)bhd * 32 * 128 + k;
#pragma unroll 8
        for (int p = 0; p < 32; ++p) { const float dd = dp[p * 128]; const f32x4 a = sp[(size_t)p * 4096]; s = s * dd + a; sp[(size_t)p * 4096] = s; }
    }
}
__device__ __forceinline__ void phase_gla3(LAS unsigned char* lds, bf16_t* Z, const float* Sbuf, const float* gnorm, int with_ctx) {
    int tid_ = threadIdx.x; asm volatile("" : "+v"(tid_));
    const int tid = tid_, lane = tid & 63, w = __builtin_amdgcn_readfirstlane(tid >> 6);
    const int jlo = with_ctx ? 0 : 1, nj = 33 - jlo;
    for (int task = blockIdx.x; task < 32 * nj; task += gridDim.x) {
        const int bh = task / nj, jsc = jlo + task % nj, b = bh >> 3, h = bh & 7;
        const int rb = sc_rowbase(b, jsc);
        float dummy = 0.f;
#pragma unroll 1
        for (int d = 0; d < 2; ++d) {
            const int p = (jsc == 0) ? 0 : (d == 0 ? jsc : 33 - jsc);
            f32x4 S[8];
            if (p == 0) {
#pragma unroll
                for (int vt = 0; vt < 8; ++vt) S[vt] = (f32x4){0.f, 0.f, 0.f, 0.f};
            } else {
                const float* sp = Sbuf + ((size_t)((bh * 2 + d) * 32 + (p - 1))) * 16384;
#pragma unroll
                for (int vt = 0; vt < 8; ++vt)
#pragma unroll
                    for (int j = 0; j < 4; ++j) S[vt][j] = sp[((w * 8 + vt) * 4 + j) * 64 + lane];
            }
            if (d == 0) { for (int ci = 0; ci < 4; ++ci) gla_chunk<true, 0>(lds, Z, rb + ci * 64, h, S, dummy, gnorm); }
            else { for (int ci = 3; ci >= 0; --ci) gla_chunk<true, 1>(lds, Z, rb + ci * 64, h, S, dummy, gnorm); }
            __syncthreads();
        }
    }
}

__global__ void __launch_bounds__(512, 2) mega_fwd(Params p) {
    extern __shared__ __attribute__((aligned(16))) unsigned char lds_raw[];
    LAS unsigned char* lds = (LAS unsigned char*)lds_raw;
    cg::grid_group grid = cg::this_grid();
    unsigned char* ws = p.ws;
    float* X = (float*)(ws + WS_X); bf16_t* Z = (bf16_t*)(ws + WS_Z);
    bf16_t* Win_t = (bf16_t*)(ws + WS_WIN); bf16_t* Wout_t = (bf16_t*)(ws + WS_WOUT); bf16_t* W1_t = (bf16_t*)(ws + WS_W1); bf16_t* W2_t = (bf16_t*)(ws + WS_W2);
    float* Dbuf = (float*)(ws + WS_DB); float* mods = (float*)(ws + WS_MOD); float* lbv = (float*)(ws + WS_LB);
    bf16_t* HA = (bf16_t*)p.out;
    float* Sbuf = p.out;
    const int G = gridDim.x, bx = blockIdx.x;

    phase_ada(p, lds, mods, lbv);
    grid.sync();

#pragma unroll 1
    for (int L = 0; L < 4; ++L) {
        const bool rec = (L & 1) == 0; const int j = L >> 1;
        const float* modL = mods + (size_t)L * 5 * 6144;
        const int Mmix_in = (L < 3) ? MT : ML;
        const int Mlive = (L < 2) ? MT : ML;
#pragma unroll 1
        for (int s = 0; s < 2; ++s) {
            if (s == 0) phase_cvt(p, lds, L);
            {
                const float* srcL = (L == 0 && s == 0) ? p.in[0] : X;
                const float* srcC = (L == 0 && s == 0) ? p.in[2] : X + (size_t)ML * DM;
                const float* gain = (s == 0 ? p.in[6] : p.in[7]) + L * 1024;
                phase_norm(srcL, srcC, s == 0 ? Mmix_in : Mlive, gain, modL, s == 0 ? 0 : 3 * 1024, s == 0 ? 1024 : 4 * 1024, HA);
            }
            grid.sync();
            pg8::Gemm g; const float* gate; const float* resL; const float* resC;
            if (s == 0) {
                if (rec) {
                    { pg8::Gemm gi{HA, Win_t, Mmix_in, 5120, 1024, 1024}; pg8::StaticOrder S; S.init(gi.M, gi.N, G, bx);
                      EpiHgrnIn E{Z, lbv + (size_t)j * 2048}; pg8::gemm_phase<EpiHgrnIn>(lds, gi, S, E); }
                    grid.sync();
                    phase_gla1(lds, Z, Sbuf, Dbuf);
                    grid.sync();
                    phase_gla2(Sbuf, Dbuf);
                    grid.sync();
                    phase_gla3(lds, Z, Sbuf, p.in[13] + j * 1024, L < 2 ? 1 : 0);
                    grid.sync();
                    g = pg8::Gemm{Z + 1024, Wout_t, Mlive, 1024, 1024, 5120};
                } else {
                    { pg8::Gemm gi{HA, Win_t, Mmix_in, 3072, 1024, 1024}; pg8::StaticOrder S; S.init(gi.M, gi.N, G, bx);
                      EpiConvIn E{Z}; pg8::gemm_phase<EpiConvIn>(lds, gi, S, E); }
                    grid.sync();
                    phase_conv(Z, p.in[16] + (size_t)j * 3 * 1024, p.in[17] + j * 1024, j & 1, Mlive, HA);
                    grid.sync();
                    g = pg8::Gemm{HA, Wout_t, Mlive, 1024, 1024, 1024};
                }
                gate = modL + 2 * 1024;
                resL = (L == 0) ? p.in[0] : X; resC = (L == 0) ? p.in[2] : X + (size_t)ML * DM;
            } else {
                { pg8::Gemm gi{HA, W1_t, Mlive, 4096, 1024, 1024}; pg8::StaticOrder S; S.init(gi.M, gi.N, G, bx);
                  EpiRelu2 E{Z}; pg8::gemm_phase<EpiRelu2>(lds, gi, S, E); }
                grid.sync();
                g = pg8::Gemm{Z, W2_t, Mlive, 1024, 4096, 4096};
                gate = modL + 5 * 1024;
                resL = X; resC = X + (size_t)ML * DM;
            }
            { pg8::StaticOrder S; S.init(g.M, g.N, G, bx); EpiResid E{X, resL, resC, gate}; pg8::gemm_phase<EpiResid>(lds, g, S, E); }
            grid.sync();
        }
    }
    phase_final(X, p.in[8], p.out);
}

extern "C" void kernel_launch(void* const* d_in, const int* in_sizes, int n_in, void* d_out, int out_size, void* d_ws, size_t ws_size, hipStream_t stream) {
    static int grid = 0;
    if (grid == 0) {
        if (n_in != 19 || out_size != ML * DM || ws_size < WS_END) { fprintf(stderr, "kernel_launch: unexpected shapes / workspace (n_in %d out %d ws %zu need %zu)\n", n_in, out_size, ws_size, (size_t)WS_END); grid = -1; return; }
        int dev = 0, cus = 0, per_cu = 0;
        if (hipGetDevice(&dev) != hipSuccess || hipDeviceGetAttribute(&cus, hipDeviceAttributeMultiprocessorCount, dev) != hipSuccess) { grid = -1; return; }
        if (hipFuncSetAttribute((const void*)mega_fwd, hipFuncAttributeMaxDynamicSharedMemorySize, LDS_BYTES) != hipSuccess) { fprintf(stderr, "kernel_launch: hipFuncSetAttribute failed\n"); grid = -1; return; }
        if (hipOccupancyMaxActiveBlocksPerMultiprocessor(&per_cu, (const void*)mega_fwd, 512, LDS_BYTES) != hipSuccess || per_cu < 1) { fprintf(stderr, "kernel_launch: occupancy query failed (%d)\n", per_cu); per_cu = 1; (void)hipGetLastError(); }
        grid = cus * per_cu;
    }
    if (grid < 0) return;
    Params p{};
    for (int i = 0; i < 19; ++i) p.in[i] = (const float*)d_in[i];
    p.out = (float*)d_out; p.ws = (unsigned char*)d_ws;
    void* args[] = {&p};
    hipError_t e = hipLaunchCooperativeKernel((const void*)mega_fwd, dim3(grid), dim3(512), args, LDS_BYTES, stream);
    if (e != hipSuccess) fprintf(stderr, "cooperative launch failed: %s (grid %d)\n", hipGetErrorString(e), grid);
}
```

```cpp
#include <hip/hip_runtime.h>
#include <hip/hip_cooperative_groups.h>
#include <cstdio>
namespace cg = cooperative_groups;

#define LAS __attribute__((address_space(3)))
typedef unsigned short bf16_t;
typedef short bf16x8 __attribute__((ext_vector_type(8)));
typedef float f32x4 __attribute__((ext_vector_type(4)));
typedef unsigned u32x4 __attribute__((ext_vector_type(4)));
typedef unsigned u32x2 __attribute__((ext_vector_type(2)));

constexpr int DM = 1024, NB = 4, SEQ = 8192, CTXL = 256, DFF = 4096;
constexpr int ML = NB * SEQ;
constexpr int MC = NB * CTXL;
constexpr int MT = ML + MC;
constexpr float EPS = 1e-6f;

constexpr size_t WS_X = 0;
constexpr size_t WS_Z = WS_X + (size_t)MT * DM * 4;
constexpr size_t WS_WIN = WS_Z + (size_t)MT * 5120 * 2;
constexpr size_t WS_WOUT = WS_WIN + (size_t)5120 * 1024 * 2;
constexpr size_t WS_W1 = WS_WOUT + (size_t)1024 * 1024 * 2;
constexpr size_t WS_W2 = WS_W1 + (size_t)4096 * 1024 * 2;
constexpr size_t WS_DB = WS_W2 + (size_t)4096 * 1024 * 2;
constexpr size_t WS_MOD = WS_DB + (size_t)2048 * 128 * 4;
constexpr size_t WS_LB = WS_MOD + (size_t)4 * 5 * 6144 * 4;
constexpr size_t WS_BAR = WS_LB + (size_t)2 * 2 * 1024 * 4;
constexpr size_t WS_END = WS_BAR + (size_t)3456 * 4;

constexpr int LDS_MAIN = 131072;
constexpr int LDS_BYTES = LDS_MAIN + 16;

struct Params { const float* in[19]; float* out; unsigned char* ws; };

__device__ __forceinline__ float bf2f(bf16_t b) { return __uint_as_float(((unsigned)b) << 16); }
__device__ __forceinline__ bf16_t f2bf(float f) { unsigned u = __float_as_uint(f); u += 0x7FFFu + ((u >> 16) & 1u); return (bf16_t)(u >> 16); }
__device__ __forceinline__ unsigned pk2(float lo, float hi) { return (unsigned)f2bf(lo) | ((unsigned)f2bf(hi) << 16); }
__device__ __forceinline__ float sigmoidf_(float z) { return 1.0f / (1.0f + __expf(-z)); }
__device__ __forceinline__ float siluf_(float z) { return z / (1.0f + __expf(-z)); }

namespace pg8 {
constexpr int BM = 256, BK = 64, HALF = 128, HTB = HALF * BK * 2, NXCD = 8, WGM = 8;
__device__ __forceinline__ int lds_byte(int r, int c) { const int st = (r >> 4) * 2 + (c >> 5), rr = r & 15, cc = c & 31, ob = rr * 64 + cc * 2; return st * 1024 + (ob ^ (((ob >> 9) & 1) << 5)); }
__device__ __forceinline__ void stage_rc(int b, int& R, int& C) { const int st = b / 1024, sb = b % 1024, swz = sb ^ (((sb >> 9) & 1) << 5); R = (st >> 1) * 16 + swz / 64; C = (st & 1) * 32 + (swz % 64) / 2; }
__device__ __forceinline__ int perm32(int rho) { const int n = rho >> 4, i = rho & 15; return 8 * (i >> 2) + 4 * n + (i & 3); }

struct Unit { int pm, pn; };
struct Gemm { const bf16_t* A; const bf16_t* Bt; int M, N, K, lda; };

struct StaticOrder {
    int nM, nN, nwg, G, c;
    __device__ void init(int M, int N, int G_, int c_) { nM = M / BM; nN = N / BM; nwg = nM * nN; G = G_; c = c_; }
    __device__ bool next(int i, Unit& u) const {
        const long L = (long)i * G + c; if (L >= nwg) return false;
        int wgid = (int)L; { const int q = nwg / NXCD, r = nwg % NXCD, xcd = wgid % NXCD, off = wgid / NXCD; wgid = (xcd < r ? xcd * (q + 1) : r * (q + 1) + (xcd - r) * q) + off; }
        const int nig = WGM * nN, gid = wgid / nig, fm = gid * WGM, gsz = (nM - fm) < WGM ? (nM - fm) : WGM;
        u.pm = fm + ((wgid % nig) % gsz); u.pn = (wgid % nig) / gsz; return true;
    }
};

template <class Epi>
__device__ __forceinline__ void gemm_phase(LAS unsigned char* lds, const Gemm g, const StaticOrder& S, const Epi& E) {
    int tid_ = threadIdx.x; asm volatile("" : "+v"(tid_));
    const int tid = tid_, wid = __builtin_amdgcn_readfirstlane(tid >> 6), lane = tid & 63, wr = wid >> 2, wc = wid & 3, fr = lane & 15, fq = lane >> 4;
    const int K = g.K, nt = K / BK, lda = g.lda;
    unsigned voffA[2], voffB[2];
#pragma unroll
    for (int i = 0; i < 2; ++i) { int R, C; stage_rc(tid * 16 + i * 8192, R, C); const int Rb = Epi::PERM ? ((R & ~31) + perm32(R & 31)) : R;
        voffA[i] = (unsigned)(R * lda + C) * 2u; voffB[i] = (unsigned)(Rb * K + C) * 2u; }
    const size_t kstep = (size_t)(BK * 2);
    const size_t hstepA = (size_t)HALF * lda * 2, hstepB = (size_t)HALF * K * 2;
    const size_t tstepA = 2 * hstepA, tstepB = 2 * hstepB;
    const unsigned ldsw = (unsigned)wid * 1024u;
    const int aoff = lds_byte(wr * 64 + fr, fq * 8), boff = lds_byte(wc * 32 + fr, fq * 8);
#define PG8_SA(b, h) (((b) * 2 + (h)) * HTB)
#define PG8_SB(b, h) ((4 + (b) * 2 + (h)) * HTB)
#define PG8_STAGE(bufoff, gbase, voff) do { _Pragma("unroll") for (int _i = 0; _i < 2; ++_i) \
        __builtin_amdgcn_global_load_lds((const unsigned*)((const char*)(gbase) + (voff)[_i]), (LAS unsigned*)(lds + (bufoff) + ldsw + _i * 8192), 16, 0, 0); } while (0)
#define PG8_LDA(dst, b, h) do { _Pragma("unroll") for (int m = 0; m < 4; ++m) _Pragma("unroll") for (int k = 0; k < 2; ++k) dst[m][k] = *(const LAS bf16x8*)(lds + PG8_SA(b, h) + aoff + m * 2048 + k * 1024); } while (0)
#define PG8_LDB(dst, b, h) do { _Pragma("unroll") for (int n = 0; n < 2; ++n) _Pragma("unroll") for (int k = 0; k < 2; ++k) dst[n][k] = *(const LAS bf16x8*)(lds + PG8_SB(b, h) + boff + n * 2048 + k * 1024); } while (0)
#define PG8_MMA(ai, bj, At, Bt) do { __builtin_amdgcn_s_setprio(1); _Pragma("unroll") for (int m = 0; m < 4; ++m) _Pragma("unroll") for (int n = 0; n < 2; ++n) _Pragma("unroll") for (int k = 0; k < 2; ++k) \
        acc[ai][bj][m][n] = __builtin_amdgcn_mfma_f32_16x16x32_bf16(Bt[n][k], At[m][k], acc[ai][bj][m][n], 0, 0, 0); __builtin_amdgcn_s_setprio(0); } while (0)
#define PG8_WAIT_V(n) asm volatile("s_waitcnt vmcnt(" #n ")" ::: "memory")
#define PG8_WAIT_L(n) asm volatile("s_waitcnt lgkmcnt(" #n ")" ::: "memory")
#define PG8_BAR __builtin_amdgcn_s_barrier()
#define PG8_SCHED __builtin_amdgcn_sched_barrier(0)
    Unit cur, nxt; int ui = 0;
    if (!S.next(0, cur)) return;
    f32x4 acc[2][2][4][2];
#pragma unroll
    for (int a = 0; a < 2; ++a)
#pragma unroll
        for (int b = 0; b < 2; ++b)
#pragma unroll
            for (int m = 0; m < 4; ++m)
#pragma unroll
                for (int n = 0; n < 2; ++n) acc[a][b][m][n] = (f32x4){0.f, 0.f, 0.f, 0.f};
    bf16x8 At[4][2], B0[2][2], B1[2][2];
    const char* cA = (const char*)g.A + (size_t)cur.pm * tstepA; const char* cB = (const char*)g.Bt + (size_t)cur.pn * tstepB;
    PG8_STAGE(PG8_SB(0, 0), cB, voffB); PG8_STAGE(PG8_SA(0, 0), cA, voffA); PG8_STAGE(PG8_SB(0, 1), cB + hstepB, voffB); PG8_STAGE(PG8_SA(0, 1), cA + hstepA, voffA);
    if (wr == 1) PG8_BAR;
    PG8_WAIT_V(4); PG8_BAR;
    PG8_STAGE(PG8_SB(1, 0), cB + kstep, voffB); PG8_STAGE(PG8_SA(1, 0), cA + kstep, voffA); PG8_STAGE(PG8_SB(1, 1), cB + hstepB + kstep, voffB);
    PG8_WAIT_V(6); PG8_BAR;
    for (;;) {
        const bool has_next = S.next(ui + 1, nxt);
        const char* nA = has_next ? (const char*)g.A + (size_t)nxt.pm * tstepA : cA; const char* nB = has_next ? (const char*)g.Bt + (size_t)nxt.pn * tstepB : cB;
        for (int t = 0; t < nt; t += 2) {
            const bool last = (t == nt - 2);
            const char* a1 = cA + (size_t)(t + 1) * kstep;
            const char* a2 = last ? nA : cA + (size_t)(t + 2) * kstep; const char* b2 = last ? nB : cB + (size_t)(t + 2) * kstep;
            const char* a3 = a2 + kstep; const char* b3 = b2 + kstep;
            PG8_LDB(B0, 0, 0); PG8_SCHED; PG8_LDA(At, 0, 0); PG8_STAGE(PG8_SA(1, 1), a1 + hstepA, voffA);
            PG8_WAIT_L(8); PG8_BAR; PG8_WAIT_L(0); PG8_MMA(0, 0, At, B0); PG8_BAR; PG8_SCHED;
            PG8_LDB(B1, 0, 1); PG8_STAGE(PG8_SB(0, 0), b2, voffB);
            PG8_BAR; PG8_WAIT_L(0); PG8_MMA(0, 1, At, B1); PG8_BAR;
            PG8_LDA(At, 0, 1); PG8_STAGE(PG8_SA(0, 0), a2, voffA);
            PG8_BAR; PG8_WAIT_L(0); PG8_MMA(1, 0, At, B0); PG8_BAR; PG8_SCHED;
            PG8_STAGE(PG8_SB(0, 1), b2 + hstepB, voffB);
            PG8_WAIT_V(6); PG8_BAR; PG8_MMA(1, 1, At, B1); PG8_BAR;
            PG8_LDB(B0, 1, 0); PG8_SCHED; PG8_LDA(At, 1, 0); PG8_STAGE(PG8_SA(0, 1), a2 + hstepA, voffA);
            PG8_WAIT_L(8); PG8_BAR; PG8_WAIT_L(0); PG8_MMA(0, 0, At, B0); PG8_BAR; PG8_SCHED;
            PG8_LDB(B1, 1, 1); PG8_STAGE(PG8_SB(1, 0), b3, voffB);
            PG8_BAR; PG8_WAIT_L(0); PG8_MMA(0, 1, At, B1); PG8_BAR;
            PG8_LDA(At, 1, 1); PG8_STAGE(PG8_SA(1, 0), a3, voffA);
            PG8_BAR; PG8_WAIT_L(0); PG8_MMA(1, 0, At, B0); PG8_BAR; PG8_SCHED;
            PG8_STAGE(PG8_SB(1, 1), b3 + hstepB, voffB);
            PG8_WAIT_V(6); PG8_BAR; PG8_MMA(1, 1, At, B1); PG8_BAR;
        }
        E(acc, cur, wr, wc, fr, fq);
        if (!has_next) break;
#pragma unroll
        for (int a = 0; a < 2; ++a)
#pragma unroll
            for (int b = 0; b < 2; ++b)
#pragma unroll
                for (int m = 0; m < 4; ++m)
#pragma unroll
                    for (int n = 0; n < 2; ++n) acc[a][b][m][n] = (f32x4){0.f, 0.f, 0.f, 0.f};
        cur = nxt; cA = nA; cB = nB; ++ui;
    }
    PG8_WAIT_V(0);
    if (wr == 0) PG8_BAR;
    PG8_BAR;
#undef PG8_SA
#undef PG8_SB
#undef PG8_STAGE
#undef PG8_LDA
#undef PG8_LDB
#undef PG8_MMA
#undef PG8_WAIT_V
#undef PG8_WAIT_L
#undef PG8_BAR
#undef PG8_SCHED
}
}

struct EpiHgrnIn {
    static constexpr bool PERM = true;
    bf16_t* Z; const float* lbv;
    __device__ __forceinline__ void operator()(const f32x4 (&acc)[2][2][4][2], const pg8::Unit& u, int wr, int wc, int fr, int fq) const {
        const int part = u.pn >> 2;
        const int row0 = u.pm * 256 + wr * 64 + fr, col0 = u.pn * 256 + wc * 32 + 8 * fq;
        f32x4 lb[2][2];
#pragma unroll
        for (int bj = 0; bj < 2; ++bj)
#pragma unroll
            for (int n = 0; n < 2; ++n) lb[bj][n] = (part < 2) ? *(const f32x4*)(lbv + col0 + bj * 128 + 4 * n) : (f32x4){0.f, 0.f, 0.f, 0.f};
#pragma unroll
        for (int ai = 0; ai < 2; ++ai)
#pragma unroll
            for (int m = 0; m < 4; ++m) {
                bf16_t* rowp = Z + (size_t)(row0 + ai * 128 + m * 16) * 5120 + col0;
#pragma unroll
                for (int bj = 0; bj < 2; ++bj) {
                    float o[8];
#pragma unroll
                    for (int n = 0; n < 2; ++n)
#pragma unroll
                        for (int j = 0; j < 4; ++j) {
                            const float z = acc[ai][bj][m][n][j]; float r;
                            if (part < 2) { const float l = lb[bj][n][j]; const float f = l + (1.0f - l) * sigmoidf_(z); r = __logf(fmaxf(f, 1e-30f)); }
                            else if (part == 2) r = z;
                            else r = siluf_(z);
                            o[n * 4 + j] = r;
                        }
                    u32x4 w; w.x = pk2(o[0], o[1]); w.y = pk2(o[2], o[3]); w.z = pk2(o[4], o[5]); w.w = pk2(o[6], o[7]);
                    *(u32x4*)(rowp + bj * 128) = w;
                }
            }
    }
};
struct EpiConvIn {
    static constexpr bool PERM = true;
    bf16_t* Z;
    __device__ __forceinline__ void operator()(const f32x4 (&acc)[2][2][4][2], const pg8::Unit& u, int wr, int wc, int fr, int fq) const {
        const int row0 = u.pm * 256 + wr * 64 + fr;
        if (u.pn < 4) {
            const int col0 = u.pn * 256 + wc * 32 + 8 * fq;
#pragma unroll
            for (int ai = 0; ai < 2; ++ai)
#pragma unroll
                for (int m = 0; m < 4; ++m) {
                    bf16_t* rowp = Z + (size_t)(row0 + ai * 128 + m * 16) * 2048 + col0;
#pragma unroll
                    for (int bj = 0; bj < 2; ++bj) {
                        const f32x4 v0 = acc[ai][bj][m][0], v1 = acc[ai][bj][m][1];
                        u32x4 w; w.x = pk2(v0[0], v0[1]); w.y = pk2(v0[2], v0[3]); w.z = pk2(v1[0], v1[1]); w.w = pk2(v1[2], v1[3]);
                        *(u32x4*)(rowp + bj * 128) = w;
                    }
                }
        } else {
            const int col0 = 1024 + (u.pn - 4) * 128 + wc * 32 + 8 * fq;
#pragma unroll
            for (int ai = 0; ai < 2; ++ai)
#pragma unroll
                for (int m = 0; m < 4; ++m) {
                    bf16_t* rowp = Z + (size_t)(row0 + ai * 128 + m * 16) * 2048 + col0;
                    const f32x4 v0 = acc[ai][0][m][0] * acc[ai][1][m][0], v1 = acc[ai][0][m][1] * acc[ai][1][m][1];
                    u32x4 w; w.x = pk2(v0[0], v0[1]); w.y = pk2(v0[2], v0[3]); w.z = pk2(v1[0], v1[1]); w.w = pk2(v1[2], v1[3]);
                    *(u32x4*)rowp = w;
                }
        }
    }
};
struct EpiRelu2 {
    static constexpr bool PERM = true;
    bf16_t* Z;
    __device__ __forceinline__ void operator()(const f32x4 (&acc)[2][2][4][2], const pg8::Unit& u, int wr, int wc, int fr, int fq) const {
        const int row0 = u.pm * 256 + wr * 64 + fr, col0 = u.pn * 256 + wc * 32 + 8 * fq;
#pragma unroll
        for (int ai = 0; ai < 2; ++ai)
#pragma unroll
            for (int m = 0; m < 4; ++m) {
                bf16_t* rowp = Z + (size_t)(row0 + ai * 128 + m * 16) * 4096 + col0;
#pragma unroll
                for (int bj = 0; bj < 2; ++bj) {
                    float o[8];
#pragma unroll
                    for (int n = 0; n < 2; ++n)
#pragma unroll
                        for (int j = 0; j < 4; ++j) { const float z = fmaxf(acc[ai][bj][m][n][j], 0.f); o[n * 4 + j] = z * z; }
                    u32x4 w; w.x = pk2(o[0], o[1]); w.y = pk2(o[2], o[3]); w.z = pk2(o[4], o[5]); w.w = pk2(o[6], o[7]);
                    *(u32x4*)(rowp + bj * 128) = w;
                }
            }
    }
};
struct EpiResid {
    static constexpr bool PERM = false;
    float* X; const float* resL; const float* resC; const float* gate;
    __device__ __forceinline__ void operator()(const f32x4 (&acc)[2][2][4][2], const pg8::Unit& u, int wr, int wc, int fr, int fq) const {
        const int row0 = u.pm * 256 + wr * 64 + fr, col0 = u.pn * 256 + wc * 32 + 4 * fq;
        const int bb = u.pm < 128 ? (u.pm >> 5) : 4;
        const float* gp = gate + (size_t)bb * 6144 + col0;
        f32x4 gv[2][2];
#pragma unroll
        for (int bj = 0; bj < 2; ++bj)
#pragma unroll
            for (int n = 0; n < 2; ++n) gv[bj][n] = *(const f32x4*)(gp + bj * 128 + n * 16);
#pragma unroll
        for (int ai = 0; ai < 2; ++ai)
#pragma unroll
            for (int m = 0; m < 4; ++m) {
                const int row = row0 + ai * 128 + m * 16;
                const float* rp = (row < ML ? resL + (size_t)row * DM : resC + (size_t)(row - ML) * DM) + col0;
                float* xp = X + (size_t)row * DM + col0;
#pragma unroll
                for (int bj = 0; bj < 2; ++bj)
#pragma unroll
                    for (int n = 0; n < 2; ++n) {
                        const f32x4 r = *(const f32x4*)(rp + bj * 128 + n * 16);
                        *(f32x4*)(xp + bj * 128 + n * 16) = r + gv[bj][n] * acc[ai][bj][m][n];
                    }
            }
    }
};

__device__ __forceinline__ void phase_ada(const Params& p, LAS unsigned char* lds, float* mods, float* lbv) {
    int tid_ = threadIdx.x; asm volatile("" : "+v"(tid_)); const int tid = tid_;
    LAS float* s = (LAS float*)lds;
    LAS float* red = s + 5 * 1024;
    const float* c = p.in[1]; const float* cc = p.in[3];
    for (int i = tid; i < 5 * 1024; i += 512) { const int bb = i >> 10, k = i & 1023; const float v = bb < 4 ? c[bb * 1024 + k] : cc[k]; s[i] = siluf_(v); }
    __syncthreads();
    const int col = tid & 63, ks = tid >> 6;
    for (int item = blockIdx.x; item < 4 * 96; item += gridDim.x) {
        const int l = item / 96, n0 = (item % 96) * 64;
        const float* W = p.in[4] + (size_t)l * 1024 * 6144 + n0 + col;
        float a0 = 0.f, a1 = 0.f, a2 = 0.f, a3 = 0.f, a4 = 0.f;
#pragma unroll 8
        for (int k = ks * 128; k < ks * 128 + 128; ++k) {
            const float w = W[(size_t)k * 6144];
            a0 += s[k] * w; a1 += s[1024 + k] * w; a2 += s[2048 + k] * w; a3 += s[3072 + k] * w; a4 += s[4096 + k] * w;
        }
        red[(ks * 5 + 0) * 64 + col] = a0; red[(ks * 5 + 1) * 64 + col] = a1; red[(ks * 5 + 2) * 64 + col] = a2; red[(ks * 5 + 3) * 64 + col] = a3; red[(ks * 5 + 4) * 64 + col] = a4;
        __syncthreads();
        if (tid < 320) {
            const int bb = tid >> 6; float t = 0.f;
#pragma unroll
            for (int q = 0; q < 8; ++q) t += red[(q * 5 + bb) * 64 + col];
            mods[(size_t)(l * 5 + bb) * 6144 + n0 + col] = t + p.in[5][l * 6144 + n0 + col];
        }
        __syncthreads();
    }
    if (blockIdx.x == 0) {
        const float* hl = p.in[12];
        for (int i = tid; i < 2 * 1024; i += 512) {
            const int d = i >> 10, ch = i & 1023;
            const float a = hl[(d * 2 + 0) * 1024 + ch], b = hl[(d * 2 + 1) * 1024 + ch];
            const float m = fmaxf(a, b), ea = __expf(a - m), eb = __expf(b - m);
            lbv[(0 * 2 + d) * 1024 + ch] = 0.f;
            lbv[(1 * 2 + d) * 1024 + ch] = eb / (ea + eb);
        }
    }
}

__device__ __forceinline__ void cvt_tile(const float* src, int ld, int Kdim, bf16_t* dst, int ntile, int ktile, int mapmode, LAS float* T) {
    int tid_ = threadIdx.x; asm volatile("" : "+v"(tid_)); const int tid = tid_;
    const int n0 = ntile * 64, k0 = ktile * 64;
    int sc0 = n0;
    if (mapmode && n0 >= 1024) { const int t = (n0 - 1024) >> 8, w = (n0 - 1024) & 255; sc0 = (w < 128) ? 1024 + 128 * t + w : 2048 + 128 * t + (w - 128); }
    {
        const int kk = tid >> 3, n8 = (tid & 7) * 8;
        const float* sp = src + (size_t)(k0 + kk) * ld + sc0 + n8;
        const f32x4 a = *(const f32x4*)sp, b = *(const f32x4*)(sp + 4);
        LAS float* tp = T + kk * 65 + n8;
        tp[0] = a[0]; tp[1] = a[1]; tp[2] = a[2]; tp[3] = a[3]; tp[4] = b[0]; tp[5] = b[1]; tp[6] = b[2]; tp[7] = b[3];
    }
    __syncthreads();
    {
        const int nn = tid >> 3, k8 = (tid & 7) * 8;
        float v[8];
#pragma unroll
        for (int i = 0; i < 8; ++i) v[i] = T[(k8 + i) * 65 + nn];
        u32x4 w; w.x = pk2(v[0], v[1]); w.y = pk2(v[2], v[3]); w.z = pk2(v[4], v[5]); w.w = pk2(v[6], v[7]);
        *(u32x4*)(dst + (size_t)(n0 + nn) * Kdim + k0 + k8) = w;
    }
    __syncthreads();
}
__device__ __forceinline__ void phase_cvt(const Params& p, LAS unsigned char* lds, int L) {
    const int j = L >> 1; const bool rec = (L & 1) == 0;
    const int Nin = rec ? 5120 : 3072;
    const float* win = rec ? p.in[11] + (size_t)j * 1024 * 5120 : p.in[15] + (size_t)j * 1024 * 3072;
    const float* wout = rec ? p.in[14] + (size_t)j * 1024 * 1024 : p.in[18] + (size_t)j * 1024 * 1024;
    const float* w1 = p.in[9] + (size_t)L * 1024 * 4096;
    const float* w2 = p.in[10] + (size_t)L * 4096 * 1024;
    bf16_t* Win_t = (bf16_t*)(p.ws + WS_WIN); bf16_t* Wout_t = (bf16_t*)(p.ws + WS_WOUT); bf16_t* W1_t = (bf16_t*)(p.ws + WS_W1); bf16_t* W2_t = (bf16_t*)(p.ws + WS_W2);
    const int t0 = (Nin / 64) * 16, t1 = t0 + 256, t2 = t1 + 1024, t3 = t2 + 1024;
    LAS float* T = (LAS float*)lds;
    for (int it = blockIdx.x; it < t3; it += gridDim.x) {
        if (it < t0) cvt_tile(win, Nin, 1024, Win_t, it >> 4, it & 15, rec ? 0 : 1, T);
        else if (it < t1) { const int q = it - t0; cvt_tile(wout, 1024, 1024, Wout_t, q >> 4, q & 15, 0, T); }
        else if (it < t2) { const int q = it - t1; cvt_tile(w1, 4096, 1024, W1_t, q >> 4, q & 15, 0, T); }
        else { const int q = it - t2; cvt_tile(w2, 1024, 4096, W2_t, q >> 6, q & 63, 0, T); }
    }
}

__device__ __forceinline__ void phase_norm(const float* srcL, const float* srcC, int M, const float* gain, const float* mod, int shoff, int scoff, bf16_t* HA) {
    int tid_ = threadIdx.x; asm volatile("" : "+v"(tid_));
    const int lane = tid_ & 63, gw = blockIdx.x * 8 + (tid_ >> 6), nw = gridDim.x * 8;
    for (int r = gw; r < M; r += nw) {
        const float* xr = r < ML ? srcL + (size_t)r * DM : srcC + (size_t)(r - ML) * DM;
        const int bb = r < ML ? (r >> 13) : 4;
        const float* mp = mod + (size_t)bb * 6144;
        f32x4 v[4]; float ss = 0.f;
#pragma unroll
        for (int i = 0; i < 4; ++i) { v[i] = *(const f32x4*)(xr + i * 256 + lane * 4); ss += v[i][0] * v[i][0] + v[i][1] * v[i][1] + v[i][2] * v[i][2] + v[i][3] * v[i][3]; }
#pragma unroll
        for (int o = 32; o >= 1; o >>= 1) ss += __shfl_xor(ss, o);
        const float rstd = rsqrtf(ss * (1.0f / DM) + EPS);
#pragma unroll
        for (int i = 0; i < 4; ++i) {
            const int col = i * 256 + lane * 4;
            const f32x4 g = *(const f32x4*)(gain + col), sc = *(const f32x4*)(mp + scoff + col), sh = *(const f32x4*)(mp + shoff + col);
            float h[4];
#pragma unroll
            for (int q = 0; q < 4; ++q) h[q] = (v[i][q] * rstd * g[q]) * (1.0f + sc[q]) + sh[q];
            u32x2 w; w.x = pk2(h[0], h[1]); w.y = pk2(h[2], h[3]);
            *(u32x2*)(HA + (size_t)r * DM + col) = w;
        }
    }
}
__device__ __forceinline__ void phase_final(const float* X, const float* gain, float* out) {
    int tid_ = threadIdx.x; asm volatile("" : "+v"(tid_));
    const int lane = tid_ & 63, gw = blockIdx.x * 8 + (tid_ >> 6), nw = gridDim.x * 8;
    for (int r = gw; r < ML; r += nw) {
        const float* xr = X + (size_t)r * DM;
        f32x4 v[4]; float ss = 0.f;
#pragma unroll
        for (int i = 0; i < 4; ++i) { v[i] = *(const f32x4*)(xr + i * 256 + lane * 4); ss += v[i][0] * v[i][0] + v[i][1] * v[i][1] + v[i][2] * v[i][2] + v[i][3] * v[i][3]; }
#pragma unroll
        for (int o = 32; o >= 1; o >>= 1) ss += __shfl_xor(ss, o);
        const float rstd = rsqrtf(ss * (1.0f / DM) + EPS);
#pragma unroll
        for (int i = 0; i < 4; ++i) {
            const int col = i * 256 + lane * 4;
            const f32x4 g = *(const f32x4*)(gain + col);
            *(f32x4*)(out + (size_t)r * DM + col) = v[i] * rstd * g;
        }
    }
}

__device__ __forceinline__ void phase_conv(const bf16_t* Z, const float* cw, const float* cb, int axis_rows, int M, bf16_t* HA) {
    int tid_ = threadIdx.x; asm volatile("" : "+v"(tid_));
    const int gt = blockIdx.x * 512 + tid_, nth = gridDim.x * 512;
    for (int it = gt; it < M * 128; it += nth) {
        const int r = it >> 7, c8 = (it & 127) * 8;
        int dlt; bool hasp, hasn;
        if (r < ML) {
            const int t = r & (SEQ - 1);
            if (axis_rows) { dlt = 64; const int gr = t >> 6; hasp = gr > 0; hasn = gr < 127; }
            else { dlt = 1; const int gc = t & 63; hasp = gc > 0; hasn = gc < 63; }
        } else { dlt = 1; const int t = (r - ML) & (CTXL - 1); hasp = t > 0; hasn = t < CTXL - 1; }
        const bf16_t* up = Z + (size_t)r * 2048 + 1024 + c8;
        const u32x4 uc = *(const u32x4*)up;
        u32x4 upv = (u32x4){0u, 0u, 0u, 0u}, unv = (u32x4){0u, 0u, 0u, 0u};
        if (hasp) upv = *(const u32x4*)(up - (size_t)dlt * 2048);
        if (hasn) unv = *(const u32x4*)(up + (size_t)dlt * 2048);
        const u32x4 gb = *(const u32x4*)(Z + (size_t)r * 2048 + c8);
        float o[8];
#pragma unroll
        for (int q = 0; q < 8; ++q) {
            const unsigned sh = (q & 1) * 16;
            const float u0 = __uint_as_float(((upv[q >> 1] >> sh) & 0xFFFFu) << 16), u1 = __uint_as_float(((uc[q >> 1] >> sh) & 0xFFFFu) << 16), u2 = __uint_as_float(((unv[q >> 1] >> sh) & 0xFFFFu) << 16);
            const float g = __uint_as_float(((gb[q >> 1] >> sh) & 0xFFFFu) << 16);
            const int ch = c8 + q;
            o[q] = g * (cb[ch] + cw[ch] * u0 + cw[1024 + ch] * u1 + cw[2048 + ch] * u2);
        }
        u32x4 w; w.x = pk2(o[0], o[1]); w.y = pk2(o[2], o[3]); w.z = pk2(o[4], o[5]); w.w = pk2(o[6], o[7]);
        *(u32x4*)(HA + (size_t)r * DM + c8) = w;
    }
}

constexpr int G_QT = 0, G_KT = 17408, G_KTT = 34816, G_VTT = 53248, G_PP = 71680, G_STT = 80896, G_TOT = 115712, G_SSQ = 117760;
constexpr int PQ = 136, PT = 72;

__device__ __forceinline__ f32x4 mfma16(bf16x8 a, bf16x8 b, f32x4 c) { return __builtin_amdgcn_mfma_f32_16x16x32_bf16(a, b, c, 0, 0, 0); }

template <bool OUT, int D>
__device__ __forceinline__ void gla_chunk(LAS unsigned char* lds, bf16_t* Z, int row0  , int h, f32x4 (&S)[8], float& lastsum, const float* gnorm) {
    int tid_ = threadIdx.x; asm volatile("" : "+v"(tid_));
    const int tid = tid_, lane = tid & 63, w = __builtin_amdgcn_readfirstlane(tid >> 6);
    const int col = tid & 127, tq = tid >> 7;
    const int l15 = lane & 15, lq = lane >> 4;
    LAS bf16_t* QT = (LAS bf16_t*)(lds + G_QT); LAS bf16_t* KT = (LAS bf16_t*)(lds + G_KT); LAS bf16_t* KTT = (LAS bf16_t*)(lds + G_KTT);
    LAS bf16_t* VTT = (LAS bf16_t*)(lds + G_VTT); LAS bf16_t* PP = (LAS bf16_t*)(lds + G_PP); LAS bf16_t* STT = (LAS bf16_t*)(lds + G_STT);
    LAS float* TOT = (LAS float*)(lds + G_TOT); LAS float* SSQ = (LAS float*)(lds + G_SSQ);
    float g[16], q[16], v[16], c[16];
    {
        const bf16_t* zr = Z + (size_t)(row0 + tq * 16) * 5120 + h * 128 + col;
#pragma unroll
        for (int i = 0; i < 16; ++i) {
            g[i] = bf2f(zr[(size_t)i * 5120 + D * 1024]);
            v[i] = bf2f(zr[(size_t)i * 5120 + 2048]);
            if (OUT) q[i] = bf2f(zr[(size_t)i * 5120 + 3072]); else q[i] = 0.f;
        }
    }
    if (D == 0) { c[0] = g[0];
#pragma unroll
        for (int i = 1; i < 16; ++i) c[i] = c[i - 1] + g[i];
        TOT[tq * 128 + col] = c[15];
    } else { c[15] = g[15];
#pragma unroll
        for (int i = 14; i >= 0; --i) c[i] = c[i + 1] + g[i];
        TOT[tq * 128 + col] = c[0];
    }
    __syncthreads();
    {
        const float t0 = TOT[col], t1 = TOT[128 + col], t2 = TOT[256 + col], t3 = TOT[384 + col];
        float ref, pre;
        if (D == 0) { ref = t0 + t1; pre = (tq > 0 ? t0 : 0.f) + (tq > 1 ? t1 : 0.f) + (tq > 2 ? t2 : 0.f); }
        else { ref = t2 + t3; pre = (tq < 3 ? t3 : 0.f) + (tq < 2 ? t2 : 0.f) + (tq < 1 ? t1 : 0.f); }
        if (tq == 0) lastsum += (t0 + t1) + (t2 + t3);
        float kt[16];
#pragma unroll
        for (int i = 0; i < 16; ++i) {
            const float cum = pre + c[i];
            const float kk = 1.0f - __expf(g[i]);
            kt[i] = kk * __expf(ref - cum);
            const int t = tq * 16 + i;
            if (OUT) { QT[t * PQ + col] = f2bf(q[i] * __expf(cum - ref)); KT[t * PQ + col] = f2bf(kt[i]); }
        }
        u32x4 a, b;
        a.x = pk2(kt[0], kt[1]); a.y = pk2(kt[2], kt[3]); a.z = pk2(kt[4], kt[5]); a.w = pk2(kt[6], kt[7]);
        b.x = pk2(kt[8], kt[9]); b.y = pk2(kt[10], kt[11]); b.z = pk2(kt[12], kt[13]); b.w = pk2(kt[14], kt[15]);
        *(LAS u32x4*)(KTT + col * PT + tq * 16) = a; *(LAS u32x4*)(KTT + col * PT + tq * 16 + 8) = b;
        a.x = pk2(v[0], v[1]); a.y = pk2(v[2], v[3]); a.z = pk2(v[4], v[5]); a.w = pk2(v[6], v[7]);
        b.x = pk2(v[8], v[9]); b.y = pk2(v[10], v[11]); b.z = pk2(v[12], v[13]); b.w = pk2(v[14], v[15]);
        *(LAS u32x4*)(VTT + col * PT + tq * 16) = a; *(LAS u32x4*)(VTT + col * PT + tq * 16 + 8) = b;
    }
    float el[4];
    {
        float er[4];
#pragma unroll
        for (int j = 0; j < 4; ++j) {
            const int kidx = 16 * w + lq * 4 + j;
            const float a0 = TOT[kidx], a1 = TOT[128 + kidx], a2 = TOT[256 + kidx], a3 = TOT[384 + kidx];
            const float refk = (D == 0) ? (a0 + a1) : (a2 + a3), lrk = (D == 0) ? (a2 + a3) : (a0 + a1);
            er[j] = __expf(refk); el[j] = __expf(lrk);
        }
#pragma unroll
        for (int vt = 0; vt < 8; ++vt) {
#pragma unroll
            for (int j = 0; j < 4; ++j) S[vt][j] *= er[j];
            if (OUT) { u32x2 wv; wv.x = pk2(S[vt][0], S[vt][1]); wv.y = pk2(S[vt][2], S[vt][3]);
                *(LAS u32x2*)(STT + (16 * vt + l15) * PQ + 16 * w + lq * 4) = wv; }
        }
    }
    __syncthreads();
    if (OUT) {
        const int st = w >> 1, ct0 = (w & 1) * 2;
#pragma unroll
        for (int i = 0; i < 2; ++i) {
            const int ct = ct0 + i;
            f32x4 a = (f32x4){0.f, 0.f, 0.f, 0.f};
            const bool zero = (D == 0) ? (st > ct) : (st < ct);
            if (!zero) {
#pragma unroll
                for (int ks = 0; ks < 4; ++ks) {
                    const bf16x8 fa = *(const LAS bf16x8*)(KT + (16 * st + l15) * PQ + ks * 32 + lq * 8);
                    const bf16x8 fb = *(const LAS bf16x8*)(QT + (16 * ct + l15) * PQ + ks * 32 + lq * 8);
                    a = mfma16(fa, fb, a);
                }
                const int cc = 16 * ct + l15;
#pragma unroll
                for (int j = 0; j < 4; ++j) { const int ss = 16 * st + lq * 4 + j; const bool keep = (D == 0) ? (ss <= cc) : (ss >= cc); a[j] = keep ? a[j] : 0.f; }
            }
            u32x2 wv; wv.x = pk2(a[0], a[1]); wv.y = pk2(a[2], a[3]);
            *(LAS u32x2*)(PP + (16 * ct + l15) * PT + 16 * st + lq * 4) = wv;
        }
    }
    {
        bf16x8 fa[2];
#pragma unroll
        for (int ks = 0; ks < 2; ++ks) fa[ks] = *(const LAS bf16x8*)(KTT + (16 * w + l15) * PT + ks * 32 + lq * 8);
#pragma unroll
        for (int vt = 0; vt < 8; ++vt) {
#pragma unroll
            for (int ks = 0; ks < 2; ++ks) {
                const bf16x8 fb = *(const LAS bf16x8*)(VTT + (16 * vt + l15) * PT + ks * 32 + lq * 8);
                S[vt] = mfma16(fa[ks], fb, S[vt]);
            }
#pragma unroll
            for (int j = 0; j < 4; ++j) S[vt][j] *= el[j];
        }
    }
    if (OUT) {
        __syncthreads();
        const int rt = w & 3, vh = (w >> 2) * 4;
        f32x4 o[4];
#pragma unroll
        for (int i = 0; i < 4; ++i) o[i] = (f32x4){0.f, 0.f, 0.f, 0.f};
#pragma unroll
        for (int ks = 0; ks < 2; ++ks) {
            const bf16x8 fa = *(const LAS bf16x8*)(PP + (16 * rt + l15) * PT + ks * 32 + lq * 8);
#pragma unroll
            for (int i = 0; i < 4; ++i) { const bf16x8 fb = *(const LAS bf16x8*)(VTT + (16 * (vh + i) + l15) * PT + ks * 32 + lq * 8); o[i] = mfma16(fa, fb, o[i]); }
        }
#pragma unroll
        for (int ks = 0; ks < 4; ++ks) {
            const bf16x8 fa = *(const LAS bf16x8*)(QT + (16 * rt + l15) * PQ + ks * 32 + lq * 8);
#pragma unroll
            for (int i = 0; i < 4; ++i) { const bf16x8 fb = *(const LAS bf16x8*)(STT + (16 * (vh + i) + l15) * PQ + ks * 32 + lq * 8); o[i] = mfma16(fa, fb, o[i]); }
        }
        bf16_t* zo = Z + (size_t)(row0 + 16 * rt + lq * 4) * 5120 + h * 128 + 16 * vh + l15;
        if (D == 0) {
#pragma unroll
            for (int j = 0; j < 4; ++j)
#pragma unroll
                for (int i = 0; i < 4; ++i) zo[(size_t)j * 5120 + 16 * i] = f2bf(o[i][j]);
        } else {
            __builtin_amdgcn_fence(__ATOMIC_ACQUIRE, "agent");
            float sq[4];
#pragma unroll
            for (int j = 0; j < 4; ++j) { sq[j] = 0.f;
#pragma unroll
                for (int i = 0; i < 4; ++i) { o[i][j] += bf2f(zo[(size_t)j * 5120 + 16 * i]); sq[j] += o[i][j] * o[i][j]; } }
#pragma unroll
            for (int j = 0; j < 4; ++j) { sq[j] += __shfl_xor(sq[j], 1); sq[j] += __shfl_xor(sq[j], 2); sq[j] += __shfl_xor(sq[j], 4); sq[j] += __shfl_xor(sq[j], 8); }
            if (l15 == 0) {
#pragma unroll
                for (int j = 0; j < 4; ++j) SSQ[(w >> 2) * 64 + 16 * rt + lq * 4 + j] = sq[j];
            }
            __syncthreads();
#pragma unroll
            for (int j = 0; j < 4; ++j) {
                const int cidx = 16 * rt + lq * 4 + j;
                const float rstd = rsqrtf((SSQ[cidx] + SSQ[64 + cidx]) * (1.0f / 128.0f) + EPS);
#pragma unroll
                for (int i = 0; i < 4; ++i) {
                    const float gt = bf2f(zo[(size_t)j * 5120 + 4096 + 16 * i]);
                    const float gn = gnorm[h * 128 + 16 * (vh + i) + l15];
                    zo[(size_t)j * 5120 + 1024 + 16 * i] = f2bf(o[i][j] * rstd * gn * gt);
                }
            }
        }
    }
}

__device__ __forceinline__ int sc_rowbase(int b, int jsc) { return jsc == 0 ? ML + b * CTXL : b * SEQ + (jsc - 1) * 256; }

__device__ __forceinline__ void phase_gla1(LAS unsigned char* lds, bf16_t* Z, float* Sbuf, float* Dbuf) {
    int tid_ = threadIdx.x; asm volatile("" : "+v"(tid_));
    const int tid = tid_, lane = tid & 63, w = __builtin_amdgcn_readfirstlane(tid >> 6);
    for (int task = blockIdx.x; task < 2048; task += gridDim.x) {
        const int bhd = task >> 5, p = task & 31, b = bhd >> 4, h = (bhd >> 1) & 7, d = bhd & 1;
        const int jsc = (p == 0) ? 0 : (d == 0 ? p : 33 - p);
        const int rb = sc_rowbase(b, jsc);
        f32x4 S[8];
#pragma unroll
        for (int vt = 0; vt < 8; ++vt) S[vt] = (f32x4){0.f, 0.f, 0.f, 0.f};
        float lastsum = 0.f;
        if (d == 0) { for (int ci = 0; ci < 4; ++ci) gla_chunk<false, 0>(lds, Z, rb + ci * 64, h, S, lastsum, nullptr); }
        else { for (int ci = 3; ci >= 0; --ci) gla_chunk<false, 1>(lds, Z, rb + ci * 64, h, S, lastsum, nullptr); }
        float* sp = Sbuf + (size_t)task * 16384;
#pragma unroll
        for (int vt = 0; vt < 8; ++vt)
#pragma unroll
            for (int j = 0; j < 4; ++j) sp[((w * 8 + vt) * 4 + j) * 64 + lane] = S[vt][j];
        if (tid < 128) Dbuf[(size_t)task * 128 + tid] = __expf(lastsum);
        __syncthreads();
    }
}
__device__ __forceinline__ void phase_gla2(float* Sbuf, const float* Dbuf) {
    int tid_ = threadIdx.x; asm volatile("" : "+v"(tid_));
    const int gt = blockIdx.x * 512 + tid_, nth = gridDim.x * 512;
    for (int idx = gt; idx < 64 * 4096; idx += nth) {
        const int bhd = idx >> 12, e4 = idx & 4095, e = e4 * 4;
        const int k = 16 * (e >> 11) + ((e & 63) >> 4) * 4 + ((e >> 6) & 3);
        f32x4 s = (f32x4){0.f, 0.f, 0.f, 0.f};
        f32x4* sp = (f32x4*)(Sbuf + (size_t)bhd * 32 * 16384) + e4;
        const float* dp = Dbuf + (size_t)bhd * 32 * 128 + k;
#pragma unroll 8
        for (int p = 0; p < 32; ++p) { const float dd = dp[p * 128]; const f32x4 a = sp[(size_t)p * 4096]; s = s * dd + a; sp[(size_t)p * 4096] = s; }
    }
}
__device__ __forceinline__ void phase_gla3(LAS unsigned char* lds, bf16_t* Z, const float* Sbuf, const float* gnorm, int with_ctx) {
    int tid_ = threadIdx.x; asm volatile("" : "+v"(tid_));
    const int tid = tid_, lane = tid & 63, w = __builtin_amdgcn_readfirstlane(tid >> 6);
    const int jlo = with_ctx ? 0 : 1, nj = 33 - jlo;
    for (int task = blockIdx.x; task < 32 * nj; task += gridDim.x) {
        const int bh = task / nj, jsc = jlo + task % nj, b = bh >> 3, h = bh & 7;
        const int rb = sc_rowbase(b, jsc);
        float dummy = 0.f;
#pragma unroll 1
        for (int d = 0; d < 2; ++d) {
            const int p = (jsc == 0) ? 0 : (d == 0 ? jsc : 33 - jsc);
            f32x4 S[8];
            if (p == 0) {
#pragma unroll
                for (int vt = 0; vt < 8; ++vt) S[vt] = (f32x4){0.f, 0.f, 0.f, 0.f};
            } else {
                const float* sp = Sbuf + ((size_t)((bh * 2 + d) * 32 + (p - 1))) * 16384;
#pragma unroll
                for (int vt = 0; vt < 8; ++vt)
#pragma unroll
                    for (int j = 0; j < 4; ++j) S[vt][j] = sp[((w * 8 + vt) * 4 + j) * 64 + lane];
            }
            if (d == 0) { for (int ci = 0; ci < 4; ++ci) gla_chunk<true, 0>(lds, Z, rb + ci * 64, h, S, dummy, gnorm); }
            else { for (int ci = 3; ci >= 0; --ci) gla_chunk<true, 1>(lds, Z, rb + ci * 64, h, S, dummy, gnorm); }
            __syncthreads();
        }
    }
}


#define XB_TMO      128
#define XB_XCNT(j)  (256  + 64 * (j))
#define XB_XSUB(j)  (1280 + 64 * (j))
#define XB_XGEN(j)  (2304 + 64 * (j))
#define XB_TOP      3328
#define XB_TOPGEN   3392
#define XCD_BAR_WORDS 3456
#define XB_SPIN_CAP (1u << 22)
__device__ __forceinline__ unsigned xb_ld(unsigned* p)              { return __hip_atomic_load(p, __ATOMIC_RELAXED, __HIP_MEMORY_SCOPE_AGENT); }
__device__ __forceinline__ unsigned xb_add(unsigned* p, unsigned v) { return __hip_atomic_fetch_add(p, v, __ATOMIC_RELAXED, __HIP_MEMORY_SCOPE_AGENT); }
__device__ __forceinline__ unsigned xb_xcc_id() { return (unsigned)__builtin_amdgcn_s_getreg((3 << 11) | 20) & 0xFu; }
#define XB_SPIN(cond, bar) do { unsigned _sp = 0; while (cond) { __builtin_amdgcn_s_sleep(1); \
    if ((++_sp & 255u) == 0u) { if (xb_ld(&(bar)[XB_TMO])) break; if (_sp > XB_SPIN_CAP) { atomicAdd(&(bar)[XB_TMO], 1u); break; } } } } while (0)
struct XcdBarrier { unsigned* bar; unsigned x; volatile LAS unsigned* st; };
__device__ __forceinline__ XcdBarrier xcd_barrier_post(unsigned* bar, volatile LAS unsigned* st) {
    XcdBarrier b; b.bar = bar; b.x = xb_xcc_id(); b.st = st;
    if (threadIdx.x == 0) (void)xb_add(&bar[XB_XCNT(b.x)], 1u);
    return b;
}
__device__ __forceinline__ void xcd_barrier_complete(unsigned* bar, unsigned x, unsigned& nloc, unsigned& nx) {
    const unsigned G = gridDim.x * gridDim.y * gridDim.z;
    unsigned sum, cnt, mine, sp = 0u;
    for (;;) {
        sum = 0u; cnt = 0u; mine = 0u;
#pragma unroll
        for (unsigned j = 0; j < 16; ++j) { const unsigned c = xb_ld(&bar[XB_XCNT(j)]); sum += c; cnt += (c > 0u) ? 1u : 0u; mine = (j == x) ? c : mine; }
        if (sum == G) break;
        __builtin_amdgcn_s_sleep(1);
        if ((++sp & 255u) == 0u) { if (xb_ld(&bar[XB_TMO])) break; if (sp > XB_SPIN_CAP) { atomicAdd(&bar[XB_TMO], 1u); break; } }
    }
    nloc = mine > 0u ? mine : 1u; nx = cnt > 0u ? cnt : 1u;
}
__device__ __forceinline__ void xcd_barrier(const XcdBarrier& b) {
    asm volatile("s_waitcnt vmcnt(0)" ::: "memory");
    __syncthreads();
    if (threadIdx.x == 0) {
        unsigned* bar = b.bar;
        __builtin_amdgcn_s_waitcnt(0);
        unsigned nloc = b.st[0], nx = b.st[1];
        if (nloc == 0u) { xcd_barrier_complete(bar, b.x, nloc, nx); b.st[0] = nloc; b.st[1] = nx; }
        const unsigned old = xb_add(&bar[XB_XSUB(b.x)], 1u);
        const unsigned gen = old / nloc;
        if (old + 1u == (gen + 1u) * nloc) {
            __builtin_amdgcn_fence(__ATOMIC_RELEASE, "agent");
            asm volatile("s_waitcnt vmcnt(0)" ::: "memory");
            const unsigned og = xb_add(&bar[XB_TOP], 1u);
            const unsigned tg = og / nx;
            if (og + 1u == (tg + 1u) * nx) xb_add(&bar[XB_TOPGEN], 1u);
            else XB_SPIN(xb_ld(&bar[XB_TOPGEN]) == tg, bar);
            __builtin_amdgcn_fence(__ATOMIC_ACQUIRE, "agent");
            xb_add(&bar[XB_XGEN(b.x)], 1u);
            asm volatile("s_waitcnt vmcnt(0)" ::: "memory");
        } else {
            XB_SPIN(xb_ld(&bar[XB_XGEN(b.x)]) == gen, bar);
            __builtin_amdgcn_fence(__ATOMIC_ACQUIRE, "agent");
            asm volatile("s_waitcnt vmcnt(0)" ::: "memory");
        }
    }
    __syncthreads();
}

__global__ void __launch_bounds__(512, 2) mega_fwd(Params p) {
    extern __shared__ __attribute__((aligned(16))) unsigned char lds_raw[];
    LAS unsigned char* lds = (LAS unsigned char*)lds_raw;
    cg::grid_group grid = cg::this_grid();
    unsigned char* ws = p.ws;
    float* X = (float*)(ws + WS_X); bf16_t* Z = (bf16_t*)(ws + WS_Z);
    bf16_t* Win_t = (bf16_t*)(ws + WS_WIN); bf16_t* Wout_t = (bf16_t*)(ws + WS_WOUT); bf16_t* W1_t = (bf16_t*)(ws + WS_W1); bf16_t* W2_t = (bf16_t*)(ws + WS_W2);
    float* Dbuf = (float*)(ws + WS_DB); float* mods = (float*)(ws + WS_MOD); float* lbv = (float*)(ws + WS_LB);
    bf16_t* HA = (bf16_t*)p.out;
    float* Sbuf = p.out;
    const int G = gridDim.x, bx = blockIdx.x;

    volatile LAS unsigned* xst = (volatile LAS unsigned*)(lds + LDS_MAIN);
    if (threadIdx.x == 0) { xst[0] = 0u; xst[1] = 0u; }
    __syncthreads();
    const XcdBarrier xbar = xcd_barrier_post((unsigned*)(ws + WS_BAR), xst);
    phase_ada(p, lds, mods, lbv);
    grid.sync();

#pragma unroll 1
    for (int L = 0; L < 4; ++L) {
        const bool rec = (L & 1) == 0; const int j = L >> 1;
        const float* modL = mods + (size_t)L * 5 * 6144;
        const int Mmix_in = (L < 3) ? MT : ML;
        const int Mlive = (L < 2) ? MT : ML;
#pragma unroll 1
        for (int s = 0; s < 2; ++s) {
            if (s == 0) phase_cvt(p, lds, L);
            {
                const float* srcL = (L == 0 && s == 0) ? p.in[0] : X;
                const float* srcC = (L == 0 && s == 0) ? p.in[2] : X + (size_t)ML * DM;
                const float* gain = (s == 0 ? p.in[6] : p.in[7]) + L * 1024;
                phase_norm(srcL, srcC, s == 0 ? Mmix_in : Mlive, gain, modL, s == 0 ? 0 : 3 * 1024, s == 0 ? 1024 : 4 * 1024, HA);
            }
            xcd_barrier(xbar);
            pg8::Gemm g; const float* gate; const float* resL; const float* resC;
            if (s == 0) {
                if (rec) {
                    { pg8::Gemm gi{HA, Win_t, Mmix_in, 5120, 1024, 1024}; pg8::StaticOrder S; S.init(gi.M, gi.N, G, bx);
                      EpiHgrnIn E{Z, lbv + (size_t)j * 2048}; pg8::gemm_phase<EpiHgrnIn>(lds, gi, S, E); }
                    xcd_barrier(xbar);
                    phase_gla1(lds, Z, Sbuf, Dbuf);
                    xcd_barrier(xbar);
                    phase_gla2(Sbuf, Dbuf);
                    xcd_barrier(xbar);
                    phase_gla3(lds, Z, Sbuf, p.in[13] + j * 1024, L < 2 ? 1 : 0);
                    xcd_barrier(xbar);
                    g = pg8::Gemm{Z + 1024, Wout_t, Mlive, 1024, 1024, 5120};
                } else {
                    { pg8::Gemm gi{HA, Win_t, Mmix_in, 3072, 1024, 1024}; pg8::StaticOrder S; S.init(gi.M, gi.N, G, bx);
                      EpiConvIn E{Z}; pg8::gemm_phase<EpiConvIn>(lds, gi, S, E); }
                    xcd_barrier(xbar);
                    phase_conv(Z, p.in[16] + (size_t)j * 3 * 1024, p.in[17] + j * 1024, j & 1, Mlive, HA);
                    xcd_barrier(xbar);
                    g = pg8::Gemm{HA, Wout_t, Mlive, 1024, 1024, 1024};
                }
                gate = modL + 2 * 1024;
                resL = (L == 0) ? p.in[0] : X; resC = (L == 0) ? p.in[2] : X + (size_t)ML * DM;
            } else {
                { pg8::Gemm gi{HA, W1_t, Mlive, 4096, 1024, 1024}; pg8::StaticOrder S; S.init(gi.M, gi.N, G, bx);
                  EpiRelu2 E{Z}; pg8::gemm_phase<EpiRelu2>(lds, gi, S, E); }
                xcd_barrier(xbar);
                g = pg8::Gemm{Z, W2_t, Mlive, 1024, 4096, 4096};
                gate = modL + 5 * 1024;
                resL = X; resC = X + (size_t)ML * DM;
            }
            { pg8::StaticOrder S; S.init(g.M, g.N, G, bx); EpiResid E{X, resL, resC, gate}; pg8::gemm_phase<EpiResid>(lds, g, S, E); }
            xcd_barrier(xbar);
        }
    }
    phase_final(X, p.in[8], p.out);
}

extern "C" void kernel_launch(void* const* d_in, const int* in_sizes, int n_in, void* d_out, int out_size, void* d_ws, size_t ws_size, hipStream_t stream) {
    static int grid = 0;
    if (grid == 0) {
        if (n_in != 19 || out_size != ML * DM || ws_size < WS_END) { fprintf(stderr, "kernel_launch: unexpected shapes / workspace (n_in %d out %d ws %zu need %zu)\n", n_in, out_size, ws_size, (size_t)WS_END); grid = -1; return; }
        int dev = 0, cus = 0, per_cu = 0;
        if (hipGetDevice(&dev) != hipSuccess || hipDeviceGetAttribute(&cus, hipDeviceAttributeMultiprocessorCount, dev) != hipSuccess) { grid = -1; return; }
        if (hipFuncSetAttribute((const void*)mega_fwd, hipFuncAttributeMaxDynamicSharedMemorySize, LDS_BYTES) != hipSuccess) { fprintf(stderr, "kernel_launch: hipFuncSetAttribute failed\n"); grid = -1; return; }
        if (hipOccupancyMaxActiveBlocksPerMultiprocessor(&per_cu, (const void*)mega_fwd, 512, LDS_BYTES) != hipSuccess || per_cu < 1) { fprintf(stderr, "kernel_launch: occupancy query failed (%d)\n", per_cu); per_cu = 1; (void)hipGetLastError(); }
        grid = cus * per_cu;
    }
    if (grid < 0) return;
    if (hipMemsetAsync((char*)d_ws + WS_BAR, 0, XCD_BAR_WORDS * 4, stream) != hipSuccess) { fprintf(stderr, "kernel_launch: memset failed\n"); return; }
    Params p{};
    for (int i = 0; i < 19; ++i) p.in[i] = (const float*)d_in[i];
    p.out = (float*)d_out; p.ws = (unsigned char*)d_ws;
    void* args[] = {&p};
    hipError_t e = hipLaunchCooperativeKernel((const void*)mega_fwd, dim3(grid), dim3(512), args, LDS_BYTES, stream);
    if (e != hipSuccess) fprintf(stderr, "cooperative launch failed: %s (grid %d)\n", hipGetErrorString(e), grid);
}
```

```cpp
#include <hip/hip_runtime.h>
#include <hip/hip_cooperative_groups.h>
#include <cstdio>
namespace cg = cooperative_groups;

#define LAS __attribute__((address_space(3)))
typedef unsigned short bf16_t;
typedef short bf16x8 __attribute__((ext_vector_type(8)));
typedef float f32x4 __attribute__((ext_vector_type(4)));
typedef unsigned u32x4 __attribute__((ext_vector_type(4)));
typedef unsigned u32x2 __attribute__((ext_vector_type(2)));
typedef float f32x2 __attribute__((ext_vector_type(2)));

constexpr int DM = 1024, NB = 4, SEQ = 8192, CTXL = 256, DFF = 4096;
constexpr int ML = NB * SEQ;
constexpr int MC = NB * CTXL;
constexpr int MT = ML + MC;
constexpr float EPS = 1e-6f;

constexpr size_t WS_X = 0;
constexpr size_t WS_Z = WS_X + (size_t)MT * DM * 4;
constexpr size_t WS_WIN = WS_Z + (size_t)MT * 5120 * 2;
constexpr size_t WS_WOUT = WS_WIN + (size_t)5120 * 1024 * 2;
constexpr size_t WS_W1 = WS_WOUT + (size_t)1024 * 1024 * 2;
constexpr size_t WS_W2 = WS_W1 + (size_t)4096 * 1024 * 2;
constexpr size_t WS_DB = WS_W2 + (size_t)4096 * 1024 * 2;
constexpr size_t WS_MOD = WS_DB + (size_t)2048 * 128 * 4;
constexpr size_t WS_LB = WS_MOD + (size_t)4 * 5 * 6144 * 4;
constexpr size_t WS_BAR = WS_LB + (size_t)2 * 2 * 1024 * 4;
constexpr size_t WS_END = WS_BAR + (size_t)3456 * 4;

constexpr int LDS_MAIN = 131072;
constexpr int LDS_BYTES = LDS_MAIN + 16;

struct Params { const float* in[19]; float* out; unsigned char* ws; };

__device__ __forceinline__ float bf2f(bf16_t b) { return __uint_as_float(((unsigned)b) << 16); }
__device__ __forceinline__ bf16_t f2bf(float f) { unsigned u = __float_as_uint(f); u += 0x7FFFu + ((u >> 16) & 1u); return (bf16_t)(u >> 16); }
__device__ __forceinline__ unsigned pk2(float lo, float hi) { return (unsigned)f2bf(lo) | ((unsigned)f2bf(hi) << 16); }
__device__ __forceinline__ float sigmoidf_(float z) { return 1.0f / (1.0f + __expf(-z)); }
__device__ __forceinline__ float siluf_(float z) { return z / (1.0f + __expf(-z)); }

namespace pg8 {
constexpr int BM = 256, BK = 64, HALF = 128, HTB = HALF * BK * 2, NXCD = 8, WGM = 8;
__device__ __forceinline__ int lds_byte(int r, int c) { const int st = (r >> 4) * 2 + (c >> 5), rr = r & 15, cc = c & 31, ob = rr * 64 + cc * 2; return st * 1024 + (ob ^ (((ob >> 9) & 1) << 5)); }
__device__ __forceinline__ void stage_rc(int b, int& R, int& C) { const int st = b / 1024, sb = b % 1024, swz = sb ^ (((sb >> 9) & 1) << 5); R = (st >> 1) * 16 + swz / 64; C = (st & 1) * 32 + (swz % 64) / 2; }
__device__ __forceinline__ int perm32(int rho) { const int n = rho >> 4, i = rho & 15; return 8 * (i >> 2) + 4 * n + (i & 3); }

struct Unit { int pm, pn; };
struct Gemm { const bf16_t* A; const bf16_t* Bt; int M, N, K, lda; };

struct StaticOrder {
    int nM, nN, nwg, G, c;
    __device__ void init(int M, int N, int G_, int c_) { nM = M / BM; nN = N / BM; nwg = nM * nN; G = G_; c = c_; }
    __device__ bool next(int i, Unit& u) const {
        const long L = (long)i * G + c; if (L >= nwg) return false;
        int wgid = (int)L; { const int q = nwg / NXCD, r = nwg % NXCD, xcd = wgid % NXCD, off = wgid / NXCD; wgid = (xcd < r ? xcd * (q + 1) : r * (q + 1) + (xcd - r) * q) + off; }
        const int nig = WGM * nN, gid = wgid / nig, fm = gid * WGM, gsz = (nM - fm) < WGM ? (nM - fm) : WGM;
        u.pm = fm + ((wgid % nig) % gsz); u.pn = (wgid % nig) / gsz; return true;
    }
};

template <class Epi>
__device__ __forceinline__ void gemm_phase(LAS unsigned char* lds, const Gemm g, const StaticOrder& S, const Epi& E) {
    int tid_ = threadIdx.x; asm volatile("" : "+v"(tid_));
    const int tid = tid_, wid = __builtin_amdgcn_readfirstlane(tid >> 6), lane = tid & 63, wr = wid >> 2, wc = wid & 3, fr = lane & 15, fq = lane >> 4;
    const int K = g.K, nt = K / BK, lda = g.lda;
    unsigned voffA[2], voffB[2];
#pragma unroll
    for (int i = 0; i < 2; ++i) { int R, C; stage_rc(tid * 16 + i * 8192, R, C); const int Rb = Epi::PERM ? ((R & ~31) + perm32(R & 31)) : R;
        voffA[i] = (unsigned)(R * lda + C) * 2u; voffB[i] = (unsigned)(Rb * K + C) * 2u; }
    const size_t kstep = (size_t)(BK * 2);
    const size_t hstepA = (size_t)HALF * lda * 2, hstepB = (size_t)HALF * K * 2;
    const size_t tstepA = 2 * hstepA, tstepB = 2 * hstepB;
    const unsigned ldsw = (unsigned)wid * 1024u;
    const int aoff = lds_byte(wr * 64 + fr, fq * 8), boff = lds_byte(wc * 32 + fr, fq * 8);
#define PG8_SA(b, h) (((b) * 2 + (h)) * HTB)
#define PG8_SB(b, h) ((4 + (b) * 2 + (h)) * HTB)
#define PG8_STAGE(bufoff, gbase, voff) do { _Pragma("unroll") for (int _i = 0; _i < 2; ++_i) \
        __builtin_amdgcn_global_load_lds((const unsigned*)((const char*)(gbase) + (voff)[_i]), (LAS unsigned*)(lds + (bufoff) + ldsw + _i * 8192), 16, 0, 0); } while (0)
#define PG8_LDA(dst, b, h) do { _Pragma("unroll") for (int m = 0; m < 4; ++m) _Pragma("unroll") for (int k = 0; k < 2; ++k) dst[m][k] = *(const LAS bf16x8*)(lds + PG8_SA(b, h) + aoff + m * 2048 + k * 1024); } while (0)
#define PG8_LDB(dst, b, h) do { _Pragma("unroll") for (int n = 0; n < 2; ++n) _Pragma("unroll") for (int k = 0; k < 2; ++k) dst[n][k] = *(const LAS bf16x8*)(lds + PG8_SB(b, h) + boff + n * 2048 + k * 1024); } while (0)
#define PG8_MMA(ai, bj, At, Bt) do { __builtin_amdgcn_s_setprio(1); _Pragma("unroll") for (int m = 0; m < 4; ++m) _Pragma("unroll") for (int n = 0; n < 2; ++n) _Pragma("unroll") for (int k = 0; k < 2; ++k) \
        acc[ai][bj][m][n] = __builtin_amdgcn_mfma_f32_16x16x32_bf16(Bt[n][k], At[m][k], acc[ai][bj][m][n], 0, 0, 0); __builtin_amdgcn_s_setprio(0); } while (0)
#define PG8_WAIT_V(n) asm volatile("s_waitcnt vmcnt(" #n ")" ::: "memory")
#define PG8_WAIT_L(n) asm volatile("s_waitcnt lgkmcnt(" #n ")" ::: "memory")
#define PG8_BAR __builtin_amdgcn_s_barrier()
#define PG8_SCHED __builtin_amdgcn_sched_barrier(0)
    Unit cur, nxt; int ui = 0;
    if (!S.next(0, cur)) return;
    f32x4 acc[2][2][4][2];
#pragma unroll
    for (int a = 0; a < 2; ++a)
#pragma unroll
        for (int b = 0; b < 2; ++b)
#pragma unroll
            for (int m = 0; m < 4; ++m)
#pragma unroll
                for (int n = 0; n < 2; ++n) acc[a][b][m][n] = (f32x4){0.f, 0.f, 0.f, 0.f};
    bf16x8 At[4][2], B0[2][2], B1[2][2];
    const char* cA = (const char*)g.A + (size_t)cur.pm * tstepA; const char* cB = (const char*)g.Bt + (size_t)cur.pn * tstepB;
    PG8_STAGE(PG8_SB(0, 0), cB, voffB); PG8_STAGE(PG8_SA(0, 0), cA, voffA); PG8_STAGE(PG8_SB(0, 1), cB + hstepB, voffB); PG8_STAGE(PG8_SA(0, 1), cA + hstepA, voffA);
    if (wr == 1) PG8_BAR;
    PG8_WAIT_V(4); PG8_BAR;
    PG8_STAGE(PG8_SB(1, 0), cB + kstep, voffB); PG8_STAGE(PG8_SA(1, 0), cA + kstep, voffA); PG8_STAGE(PG8_SB(1, 1), cB + hstepB + kstep, voffB);
    PG8_WAIT_V(6); PG8_BAR;
    for (;;) {
        const bool has_next = S.next(ui + 1, nxt);
        const char* nA = has_next ? (const char*)g.A + (size_t)nxt.pm * tstepA : cA; const char* nB = has_next ? (const char*)g.Bt + (size_t)nxt.pn * tstepB : cB;
        for (int t = 0; t < nt; t += 2) {
            const bool last = (t == nt - 2);
            const char* a1 = cA + (size_t)(t + 1) * kstep;
            const char* a2 = last ? nA : cA + (size_t)(t + 2) * kstep; const char* b2 = last ? nB : cB + (size_t)(t + 2) * kstep;
            const char* a3 = a2 + kstep; const char* b3 = b2 + kstep;
            PG8_LDB(B0, 0, 0); PG8_SCHED; PG8_LDA(At, 0, 0); PG8_STAGE(PG8_SA(1, 1), a1 + hstepA, voffA);
            PG8_WAIT_L(8); PG8_BAR; PG8_WAIT_L(0); PG8_MMA(0, 0, At, B0); PG8_BAR; PG8_SCHED;
            PG8_LDB(B1, 0, 1); PG8_STAGE(PG8_SB(0, 0), b2, voffB);
            PG8_BAR; PG8_WAIT_L(0); PG8_MMA(0, 1, At, B1); PG8_BAR;
            PG8_LDA(At, 0, 1); PG8_STAGE(PG8_SA(0, 0), a2, voffA);
            PG8_BAR; PG8_WAIT_L(0); PG8_MMA(1, 0, At, B0); PG8_BAR; PG8_SCHED;
            PG8_STAGE(PG8_SB(0, 1), b2 + hstepB, voffB);
            PG8_WAIT_V(6); PG8_BAR; PG8_MMA(1, 1, At, B1); PG8_BAR;
            PG8_LDB(B0, 1, 0); PG8_SCHED; PG8_LDA(At, 1, 0); PG8_STAGE(PG8_SA(0, 1), a2 + hstepA, voffA);
            PG8_WAIT_L(8); PG8_BAR; PG8_WAIT_L(0); PG8_MMA(0, 0, At, B0); PG8_BAR; PG8_SCHED;
            PG8_LDB(B1, 1, 1); PG8_STAGE(PG8_SB(1, 0), b3, voffB);
            PG8_BAR; PG8_WAIT_L(0); PG8_MMA(0, 1, At, B1); PG8_BAR;
            PG8_LDA(At, 1, 1); PG8_STAGE(PG8_SA(1, 0), a3, voffA);
            PG8_BAR; PG8_WAIT_L(0); PG8_MMA(1, 0, At, B0); PG8_BAR; PG8_SCHED;
            PG8_STAGE(PG8_SB(1, 1), b3 + hstepB, voffB);
            PG8_WAIT_V(6); PG8_BAR; PG8_MMA(1, 1, At, B1); PG8_BAR;
        }
        E(acc, cur, wr, wc, fr, fq);
        if (!has_next) break;
#pragma unroll
        for (int a = 0; a < 2; ++a)
#pragma unroll
            for (int b = 0; b < 2; ++b)
#pragma unroll
                for (int m = 0; m < 4; ++m)
#pragma unroll
                    for (int n = 0; n < 2; ++n) acc[a][b][m][n] = (f32x4){0.f, 0.f, 0.f, 0.f};
        cur = nxt; cA = nA; cB = nB; ++ui;
    }
    PG8_WAIT_V(0);
    if (wr == 0) PG8_BAR;
    PG8_BAR;
#undef PG8_SA
#undef PG8_SB
#undef PG8_STAGE
#undef PG8_LDA
#undef PG8_LDB
#undef PG8_MMA
#undef PG8_WAIT_V
#undef PG8_WAIT_L
#undef PG8_BAR
#undef PG8_SCHED
}
}

struct EpiHgrnIn {
    static constexpr bool PERM = true;
    bf16_t* Z; const float* lbv;
    __device__ __forceinline__ void operator()(const f32x4 (&acc)[2][2][4][2], const pg8::Unit& u, int wr, int wc, int fr, int fq) const {
        const int part = u.pn >> 2;
        const int row0 = u.pm * 256 + wr * 64 + fr, col0 = u.pn * 256 + wc * 32 + 8 * fq;
        f32x4 lb[2][2];
#pragma unroll
        for (int bj = 0; bj < 2; ++bj)
#pragma unroll
            for (int n = 0; n < 2; ++n) lb[bj][n] = (part < 2) ? *(const f32x4*)(lbv + col0 + bj * 128 + 4 * n) : (f32x4){0.f, 0.f, 0.f, 0.f};
#pragma unroll
        for (int ai = 0; ai < 2; ++ai)
#pragma unroll
            for (int m = 0; m < 4; ++m) {
                bf16_t* rowp = Z + (size_t)(row0 + ai * 128 + m * 16) * 5120 + col0;
#pragma unroll
                for (int bj = 0; bj < 2; ++bj) {
                    float o[8];
#pragma unroll
                    for (int n = 0; n < 2; ++n)
#pragma unroll
                        for (int j = 0; j < 4; ++j) {
                            const float z = acc[ai][bj][m][n][j]; float r;
                            if (part < 2) { const float l = lb[bj][n][j]; const float f = l + (1.0f - l) * sigmoidf_(z); r = __logf(fmaxf(f, 1e-30f)); }
                            else if (part == 2) r = z;
                            else r = siluf_(z);
                            o[n * 4 + j] = r;
                        }
                    u32x4 w; w.x = pk2(o[0], o[1]); w.y = pk2(o[2], o[3]); w.z = pk2(o[4], o[5]); w.w = pk2(o[6], o[7]);
                    *(u32x4*)(rowp + bj * 128) = w;
                }
            }
    }
};
struct EpiConvIn {
    static constexpr bool PERM = true;
    bf16_t* Z;
    __device__ __forceinline__ void operator()(const f32x4 (&acc)[2][2][4][2], const pg8::Unit& u, int wr, int wc, int fr, int fq) const {
        const int row0 = u.pm * 256 + wr * 64 + fr;
        if (u.pn < 4) {
            const int col0 = u.pn * 256 + wc * 32 + 8 * fq;
#pragma unroll
            for (int ai = 0; ai < 2; ++ai)
#pragma unroll
                for (int m = 0; m < 4; ++m) {
                    bf16_t* rowp = Z + (size_t)(row0 + ai * 128 + m * 16) * 2048 + col0;
#pragma unroll
                    for (int bj = 0; bj < 2; ++bj) {
                        const f32x4 v0 = acc[ai][bj][m][0], v1 = acc[ai][bj][m][1];
                        u32x4 w; w.x = pk2(v0[0], v0[1]); w.y = pk2(v0[2], v0[3]); w.z = pk2(v1[0], v1[1]); w.w = pk2(v1[2], v1[3]);
                        *(u32x4*)(rowp + bj * 128) = w;
                    }
                }
        } else {
            const int col0 = 1024 + (u.pn - 4) * 128 + wc * 32 + 8 * fq;
#pragma unroll
            for (int ai = 0; ai < 2; ++ai)
#pragma unroll
                for (int m = 0; m < 4; ++m) {
                    bf16_t* rowp = Z + (size_t)(row0 + ai * 128 + m * 16) * 2048 + col0;
                    const f32x4 v0 = acc[ai][0][m][0] * acc[ai][1][m][0], v1 = acc[ai][0][m][1] * acc[ai][1][m][1];
                    u32x4 w; w.x = pk2(v0[0], v0[1]); w.y = pk2(v0[2], v0[3]); w.z = pk2(v1[0], v1[1]); w.w = pk2(v1[2], v1[3]);
                    *(u32x4*)rowp = w;
                }
        }
    }
};
struct EpiRelu2 {
    static constexpr bool PERM = true;
    bf16_t* Z;
    __device__ __forceinline__ void operator()(const f32x4 (&acc)[2][2][4][2], const pg8::Unit& u, int wr, int wc, int fr, int fq) const {
        const int row0 = u.pm * 256 + wr * 64 + fr, col0 = u.pn * 256 + wc * 32 + 8 * fq;
#pragma unroll
        for (int ai = 0; ai < 2; ++ai)
#pragma unroll
            for (int m = 0; m < 4; ++m) {
                bf16_t* rowp = Z + (size_t)(row0 + ai * 128 + m * 16) * 4096 + col0;
#pragma unroll
                for (int bj = 0; bj < 2; ++bj) {
                    float o[8];
#pragma unroll
                    for (int n = 0; n < 2; ++n)
#pragma unroll
                        for (int j = 0; j < 4; ++j) { const float z = fmaxf(acc[ai][bj][m][n][j], 0.f); o[n * 4 + j] = z * z; }
                    u32x4 w; w.x = pk2(o[0], o[1]); w.y = pk2(o[2], o[3]); w.z = pk2(o[4], o[5]); w.w = pk2(o[6], o[7]);
                    *(u32x4*)(rowp + bj * 128) = w;
                }
            }
    }
};
struct EpiResid {
    static constexpr bool PERM = false;
    float* X; const float* resL; const float* resC; const float* gate;
    __device__ __forceinline__ void operator()(const f32x4 (&acc)[2][2][4][2], const pg8::Unit& u, int wr, int wc, int fr, int fq) const {
        const int row0 = u.pm * 256 + wr * 64 + fr, col0 = u.pn * 256 + wc * 32 + 4 * fq;
        const int bb = u.pm < 128 ? (u.pm >> 5) : 4;
        const float* gp = gate + (size_t)bb * 6144 + col0;
        f32x4 gv[2][2];
#pragma unroll
        for (int bj = 0; bj < 2; ++bj)
#pragma unroll
            for (int n = 0; n < 2; ++n) gv[bj][n] = *(const f32x4*)(gp + bj * 128 + n * 16);
#pragma unroll
        for (int ai = 0; ai < 2; ++ai)
#pragma unroll
            for (int m = 0; m < 4; ++m) {
                const int row = row0 + ai * 128 + m * 16;
                const float* rp = (row < ML ? resL + (size_t)row * DM : resC + (size_t)(row - ML) * DM) + col0;
                float* xp = X + (size_t)row * DM + col0;
#pragma unroll
                for (int bj = 0; bj < 2; ++bj)
#pragma unroll
                    for (int n = 0; n < 2; ++n) {
                        const f32x4 r = *(const f32x4*)(rp + bj * 128 + n * 16);
                        *(f32x4*)(xp + bj * 128 + n * 16) = r + gv[bj][n] * acc[ai][bj][m][n];
                    }
            }
    }
};

__device__ __forceinline__ void phase_ada(const Params& p, LAS unsigned char* lds, float* mods, float* lbv) {
    int tid_ = threadIdx.x; asm volatile("" : "+v"(tid_)); const int tid = tid_;
    LAS float* s = (LAS float*)lds;
    LAS float* red = s + 5 * 1024;
    const float* c = p.in[1]; const float* cc = p.in[3];
    for (int i = tid; i < 5 * 1024; i += 512) { const int bb = i >> 10, k = i & 1023; const float v = bb < 4 ? c[bb * 1024 + k] : cc[k]; s[i] = siluf_(v); }
    __syncthreads();
    const int col = tid & 63, ks = tid >> 6;
    for (int item = blockIdx.x; item < 4 * 96; item += gridDim.x) {
        const int l = item / 96, n0 = (item % 96) * 64;
        const float* W = p.in[4] + (size_t)l * 1024 * 6144 + n0 + col;
        float a0 = 0.f, a1 = 0.f, a2 = 0.f, a3 = 0.f, a4 = 0.f;
#pragma unroll 8
        for (int k = ks * 128; k < ks * 128 + 128; ++k) {
            const float w = W[(size_t)k * 6144];
            a0 += s[k] * w; a1 += s[1024 + k] * w; a2 += s[2048 + k] * w; a3 += s[3072 + k] * w; a4 += s[4096 + k] * w;
        }
        red[(ks * 5 + 0) * 64 + col] = a0; red[(ks * 5 + 1) * 64 + col] = a1; red[(ks * 5 + 2) * 64 + col] = a2; red[(ks * 5 + 3) * 64 + col] = a3; red[(ks * 5 + 4) * 64 + col] = a4;
        __syncthreads();
        if (tid < 320) {
            const int bb = tid >> 6; float t = 0.f;
#pragma unroll
            for (int q = 0; q < 8; ++q) t += red[(q * 5 + bb) * 64 + col];
            mods[(size_t)(l * 5 + bb) * 6144 + n0 + col] = t + p.in[5][l * 6144 + n0 + col];
        }
        __syncthreads();
    }
    if (blockIdx.x == 0) {
        const float* hl = p.in[12];
        for (int i = tid; i < 2 * 1024; i += 512) {
            const int d = i >> 10, ch = i & 1023;
            const float a = hl[(d * 2 + 0) * 1024 + ch], b = hl[(d * 2 + 1) * 1024 + ch];
            const float m = fmaxf(a, b), ea = __expf(a - m), eb = __expf(b - m);
            lbv[(0 * 2 + d) * 1024 + ch] = 0.f;
            lbv[(1 * 2 + d) * 1024 + ch] = eb / (ea + eb);
        }
    }
}

__device__ __forceinline__ void cvt_tile(const float* src, int ld, int Kdim, bf16_t* dst, int ntile, int ktile, int mapmode, LAS float* T) {
    int tid_ = threadIdx.x; asm volatile("" : "+v"(tid_)); const int tid = tid_;
    const int n0 = ntile * 64, k0 = ktile * 64;
    int sc0 = n0;
    if (mapmode && n0 >= 1024) { const int t = (n0 - 1024) >> 8, w = (n0 - 1024) & 255; sc0 = (w < 128) ? 1024 + 128 * t + w : 2048 + 128 * t + (w - 128); }
    {
        const int kk = tid >> 3, n8 = (tid & 7) * 8;
        const float* sp = src + (size_t)(k0 + kk) * ld + sc0 + n8;
        const f32x4 a = *(const f32x4*)sp, b = *(const f32x4*)(sp + 4);
        LAS float* tp = T + kk * 65 + n8;
        tp[0] = a[0]; tp[1] = a[1]; tp[2] = a[2]; tp[3] = a[3]; tp[4] = b[0]; tp[5] = b[1]; tp[6] = b[2]; tp[7] = b[3];
    }
    __syncthreads();
    {
        const int nn = tid >> 3, k8 = (tid & 7) * 8;
        float v[8];
#pragma unroll
        for (int i = 0; i < 8; ++i) v[i] = T[(k8 + i) * 65 + nn];
        u32x4 w; w.x = pk2(v[0], v[1]); w.y = pk2(v[2], v[3]); w.z = pk2(v[4], v[5]); w.w = pk2(v[6], v[7]);
        *(u32x4*)(dst + (size_t)(n0 + nn) * Kdim + k0 + k8) = w;
    }
    __syncthreads();
}
__device__ __forceinline__ void phase_cvt(const Params& p, LAS unsigned char* lds, int L) {
    const int j = L >> 1; const bool rec = (L & 1) == 0;
    const int Nin = rec ? 5120 : 3072;
    const float* win = rec ? p.in[11] + (size_t)j * 1024 * 5120 : p.in[15] + (size_t)j * 1024 * 3072;
    const float* wout = rec ? p.in[14] + (size_t)j * 1024 * 1024 : p.in[18] + (size_t)j * 1024 * 1024;
    const float* w1 = p.in[9] + (size_t)L * 1024 * 4096;
    const float* w2 = p.in[10] + (size_t)L * 4096 * 1024;
    bf16_t* Win_t = (bf16_t*)(p.ws + WS_WIN); bf16_t* Wout_t = (bf16_t*)(p.ws + WS_WOUT); bf16_t* W1_t = (bf16_t*)(p.ws + WS_W1); bf16_t* W2_t = (bf16_t*)(p.ws + WS_W2);
    const int t0 = (Nin / 64) * 16, t1 = t0 + 256, t2 = t1 + 1024, t3 = t2 + 1024;
    LAS float* T = (LAS float*)lds;
    for (int it = blockIdx.x; it < t3; it += gridDim.x) {
        if (it < t0) cvt_tile(win, Nin, 1024, Win_t, it >> 4, it & 15, rec ? 0 : 1, T);
        else if (it < t1) { const int q = it - t0; cvt_tile(wout, 1024, 1024, Wout_t, q >> 4, q & 15, 0, T); }
        else if (it < t2) { const int q = it - t1; cvt_tile(w1, 4096, 1024, W1_t, q >> 4, q & 15, 0, T); }
        else { const int q = it - t2; cvt_tile(w2, 1024, 4096, W2_t, q >> 6, q & 63, 0, T); }
    }
}

__device__ __forceinline__ void phase_norm(const float* srcL, const float* srcC, int M, const float* gain, const float* mod, int shoff, int scoff, bf16_t* HA) {
    int tid_ = threadIdx.x; asm volatile("" : "+v"(tid_));
    const int lane = tid_ & 63, gw = blockIdx.x * 8 + (tid_ >> 6), nw = gridDim.x * 8;
    for (int r = gw; r < M; r += nw) {
        const float* xr = r < ML ? srcL + (size_t)r * DM : srcC + (size_t)(r - ML) * DM;
        const int bb = r < ML ? (r >> 13) : 4;
        const float* mp = mod + (size_t)bb * 6144;
        f32x4 v[4]; float ss = 0.f;
#pragma unroll
        for (int i = 0; i < 4; ++i) { v[i] = *(const f32x4*)(xr + i * 256 + lane * 4); ss += v[i][0] * v[i][0] + v[i][1] * v[i][1] + v[i][2] * v[i][2] + v[i][3] * v[i][3]; }
#pragma unroll
        for (int o = 32; o >= 1; o >>= 1) ss += __shfl_xor(ss, o);
        const float rstd = rsqrtf(ss * (1.0f / DM) + EPS);
#pragma unroll
        for (int i = 0; i < 4; ++i) {
            const int col = i * 256 + lane * 4;
            const f32x4 g = *(const f32x4*)(gain + col), sc = *(const f32x4*)(mp + scoff + col), sh = *(const f32x4*)(mp + shoff + col);
            float h[4];
#pragma unroll
            for (int q = 0; q < 4; ++q) h[q] = (v[i][q] * rstd * g[q]) * (1.0f + sc[q]) + sh[q];
            u32x2 w; w.x = pk2(h[0], h[1]); w.y = pk2(h[2], h[3]);
            *(u32x2*)(HA + (size_t)r * DM + col) = w;
        }
    }
}
__device__ __forceinline__ void phase_final(const float* X, const float* gain, float* out) {
    int tid_ = threadIdx.x; asm volatile("" : "+v"(tid_));
    const int lane = tid_ & 63, gw = blockIdx.x * 8 + (tid_ >> 6), nw = gridDim.x * 8;
    for (int r = gw; r < ML; r += nw) {
        const float* xr = X + (size_t)r * DM;
        f32x4 v[4]; float ss = 0.f;
#pragma unroll
        for (int i = 0; i < 4; ++i) { v[i] = *(const f32x4*)(xr + i * 256 + lane * 4); ss += v[i][0] * v[i][0] + v[i][1] * v[i][1] + v[i][2] * v[i][2] + v[i][3] * v[i][3]; }
#pragma unroll
        for (int o = 32; o >= 1; o >>= 1) ss += __shfl_xor(ss, o);
        const float rstd = rsqrtf(ss * (1.0f / DM) + EPS);
#pragma unroll
        for (int i = 0; i < 4; ++i) {
            const int col = i * 256 + lane * 4;
            const f32x4 g = *(const f32x4*)(gain + col);
            *(f32x4*)(out + (size_t)r * DM + col) = v[i] * rstd * g;
        }
    }
}

__device__ __forceinline__ void phase_conv(const bf16_t* Z, const float* cw, const float* cb, int axis_rows, int M, bf16_t* HA) {
    int tid_ = threadIdx.x; asm volatile("" : "+v"(tid_));
    const int gt = blockIdx.x * 512 + tid_, nth = gridDim.x * 512;
    for (int it = gt; it < M * 128; it += nth) {
        const int r = it >> 7, c8 = (it & 127) * 8;
        int dlt; bool hasp, hasn;
        if (r < ML) {
            const int t = r & (SEQ - 1);
            if (axis_rows) { dlt = 64; const int gr = t >> 6; hasp = gr > 0; hasn = gr < 127; }
            else { dlt = 1; const int gc = t & 63; hasp = gc > 0; hasn = gc < 63; }
        } else { dlt = 1; const int t = (r - ML) & (CTXL - 1); hasp = t > 0; hasn = t < CTXL - 1; }
        const bf16_t* up = Z + (size_t)r * 2048 + 1024 + c8;
        const u32x4 uc = *(const u32x4*)up;
        u32x4 upv = (u32x4){0u, 0u, 0u, 0u}, unv = (u32x4){0u, 0u, 0u, 0u};
        if (hasp) upv = *(const u32x4*)(up - (size_t)dlt * 2048);
        if (hasn) unv = *(const u32x4*)(up + (size_t)dlt * 2048);
        const u32x4 gb = *(const u32x4*)(Z + (size_t)r * 2048 + c8);
        float o[8];
#pragma unroll
        for (int q = 0; q < 8; ++q) {
            const unsigned sh = (q & 1) * 16;
            const float u0 = __uint_as_float(((upv[q >> 1] >> sh) & 0xFFFFu) << 16), u1 = __uint_as_float(((uc[q >> 1] >> sh) & 0xFFFFu) << 16), u2 = __uint_as_float(((unv[q >> 1] >> sh) & 0xFFFFu) << 16);
            const float g = __uint_as_float(((gb[q >> 1] >> sh) & 0xFFFFu) << 16);
            const int ch = c8 + q;
            o[q] = g * (cb[ch] + cw[ch] * u0 + cw[1024 + ch] * u1 + cw[2048 + ch] * u2);
        }
        u32x4 w; w.x = pk2(o[0], o[1]); w.y = pk2(o[2], o[3]); w.z = pk2(o[4], o[5]); w.w = pk2(o[6], o[7]);
        *(u32x4*)(HA + (size_t)r * DM + c8) = w;
    }
}

constexpr int G_QT = 0, G_KT = 17408, G_KTT = 34816, G_VTT = 53248, G_PP = 71680, G_STT = 80896, G_TOT = 115712, G_SSQ = 119808;
constexpr int PQ = 136, PT = 72;

__device__ __forceinline__ f32x4 mfma16(bf16x8 a, bf16x8 b, f32x4 c) { return __builtin_amdgcn_mfma_f32_16x16x32_bf16(a, b, c, 0, 0, 0); }
#define LBAR() do { asm volatile("s_waitcnt lgkmcnt(0)" ::: "memory"); __builtin_amdgcn_s_barrier(); asm volatile("" ::: "memory"); } while (0)
__device__ __forceinline__ float bflo(unsigned u) { return __uint_as_float(u << 16); }
__device__ __forceinline__ float bfhi(unsigned u) { return __uint_as_float(u & 0xFFFF0000u); }

struct GlaPF { unsigned g[8], v[8], q[8]; };
template <bool OUT>
__device__ __forceinline__ void gla_prefetch(GlaPF& pf, const bf16_t* Z, int row0, int gcol  , int h, int tid) {
    const bf16_t* zr = Z + (size_t)(row0 + (tid >> 6) * 8) * 5120 + h * 128 + 2 * (tid & 63);
#pragma unroll
    for (int i = 0; i < 8; ++i) {
        pf.g[i] = *(const unsigned*)(zr + (size_t)i * 5120 + gcol);
        pf.v[i] = *(const unsigned*)(zr + (size_t)i * 5120 + 2048);
        if (OUT) pf.q[i] = *(const unsigned*)(zr + (size_t)i * 5120 + 3072);
    }
}

template <bool OUT, int D>
__device__ __forceinline__ void gla_chunk(LAS unsigned char* lds, bf16_t* Z, int row0, int h, f32x4 (&S)[8], float (&lastsum)[2], const float* gnorm,
                                          GlaPF& pf, bool has_next, int nrow0, int ngcol, int nh) {
    int tid_ = threadIdx.x; asm volatile("" : "+v"(tid_));
    const int tid = tid_, lane = tid & 63, w = __builtin_amdgcn_readfirstlane(tid >> 6);
    const int cp = lane, tg = w;
    const int l15 = lane & 15, lq = lane >> 4;
    LAS bf16_t* QT = (LAS bf16_t*)(lds + G_QT); LAS bf16_t* KT = (LAS bf16_t*)(lds + G_KT); LAS bf16_t* KTT = (LAS bf16_t*)(lds + G_KTT);
    LAS bf16_t* VTT = (LAS bf16_t*)(lds + G_VTT); LAS bf16_t* PP = (LAS bf16_t*)(lds + G_PP); LAS bf16_t* STT = (LAS bf16_t*)(lds + G_STT);
    LAS float* TOT = (LAS float*)(lds + G_TOT); LAS float* SSQ = (LAS float*)(lds + G_SSQ);
    float g0[8], g1[8], c0[8], c1[8];
#pragma unroll
    for (int i = 0; i < 8; ++i) { g0[i] = bflo(pf.g[i]); g1[i] = bfhi(pf.g[i]); }
    if (D == 0) { c0[0] = g0[0]; c1[0] = g1[0];
#pragma unroll
        for (int i = 1; i < 8; ++i) { c0[i] = c0[i - 1] + g0[i]; c1[i] = c1[i - 1] + g1[i]; }
        *(LAS f32x2*)(TOT + tg * 128 + 2 * cp) = (f32x2){c0[7], c1[7]};
    } else { c0[7] = g0[7]; c1[7] = g1[7];
#pragma unroll
        for (int i = 6; i >= 0; --i) { c0[i] = c0[i + 1] + g0[i]; c1[i] = c1[i + 1] + g1[i]; }
        *(LAS f32x2*)(TOT + tg * 128 + 2 * cp) = (f32x2){c0[0], c1[0]};
    }
    LBAR();
    {
        float pre0 = 0.f, pre1 = 0.f, ref0 = 0.f, ref1 = 0.f, all0 = 0.f, all1 = 0.f;
#pragma unroll
        for (int t = 0; t < 8; ++t) {
            const f32x2 tv = *(const LAS f32x2*)(TOT + t * 128 + 2 * cp);
            all0 += tv.x; all1 += tv.y;
            const bool inref = (D == 0) ? (t < 4) : (t >= 4);
            if (inref) { ref0 += tv.x; ref1 += tv.y; }
            const bool inpre = (D == 0) ? (t < tg) : (t > tg);
            pre0 += inpre ? tv.x : 0.f; pre1 += inpre ? tv.y : 0.f;
        }
        if (tg == 0) { lastsum[0] += all0; lastsum[1] += all1; }
        unsigned kp0[4], kp1[4], vp0[4], vp1[4];
#pragma unroll
        for (int i = 0; i < 8; i += 2) {
            float k0[2], k1[2];
#pragma unroll
            for (int u = 0; u < 2; ++u) {
                const int ii = i + u;
                const float cum0 = pre0 + c0[ii], cum1 = pre1 + c1[ii];
                k0[u] = (1.0f - __expf(g0[ii])) * __expf(ref0 - cum0);
                k1[u] = (1.0f - __expf(g1[ii])) * __expf(ref1 - cum1);
                const int t = tg * 8 + ii;
                if (OUT) {
                    const float q0 = bflo(pf.q[ii]) * __expf(cum0 - ref0), q1 = bfhi(pf.q[ii]) * __expf(cum1 - ref1);
                    *(LAS unsigned*)(QT + t * PQ + 2 * cp) = pk2(q0, q1);
                    *(LAS unsigned*)(KT + t * PQ + 2 * cp) = pk2(k0[u], k1[u]);
                }
            }
            kp0[i >> 1] = pk2(k0[0], k0[1]); kp1[i >> 1] = pk2(k1[0], k1[1]);
            vp0[i >> 1] = (pf.v[i] & 0xFFFFu) | (pf.v[i + 1] << 16); vp1[i >> 1] = (pf.v[i] >> 16) | (pf.v[i + 1] & 0xFFFF0000u);
        }
        *(LAS u32x4*)(KTT + (2 * cp) * PT + tg * 8) = (u32x4){kp0[0], kp0[1], kp0[2], kp0[3]};
        *(LAS u32x4*)(KTT + (2 * cp + 1) * PT + tg * 8) = (u32x4){kp1[0], kp1[1], kp1[2], kp1[3]};
        *(LAS u32x4*)(VTT + (2 * cp) * PT + tg * 8) = (u32x4){vp0[0], vp0[1], vp0[2], vp0[3]};
        *(LAS u32x4*)(VTT + (2 * cp + 1) * PT + tg * 8) = (u32x4){vp1[0], vp1[1], vp1[2], vp1[3]};
    }
    float el[4];
    {
        f32x4 rs = (f32x4){0.f, 0.f, 0.f, 0.f}, ls = (f32x4){0.f, 0.f, 0.f, 0.f};
#pragma unroll
        for (int t = 0; t < 8; ++t) {
            const f32x4 tv = *(const LAS f32x4*)(TOT + t * 128 + 16 * w + lq * 4);
            const bool inref = (D == 0) ? (t < 4) : (t >= 4);
            if (inref) rs += tv; else ls += tv;
        }
        float er[4];
#pragma unroll
        for (int j = 0; j < 4; ++j) { er[j] = __expf(rs[j]); el[j] = __expf(ls[j]); }
#pragma unroll
        for (int vt = 0; vt < 8; ++vt) {
#pragma unroll
            for (int j = 0; j < 4; ++j) S[vt][j] *= er[j];
            if (OUT) { u32x2 wv; wv.x = pk2(S[vt][0], S[vt][1]); wv.y = pk2(S[vt][2], S[vt][3]);
                *(LAS u32x2*)(STT + (16 * vt + l15) * PQ + 16 * w + lq * 4) = wv; }
        }
    }
    if (has_next) gla_prefetch<OUT>(pf, Z, nrow0, ngcol, nh, tid);
    const int rt = w & 3, vh = (w >> 2) * 4;
    bf16_t* zo = Z + (size_t)(row0 + 16 * rt + l15) * 5120 + h * 128 + 16 * vh + 4 * lq;
    u32x2 ofw[4], gat[4];
    if (OUT && D == 1) {
#pragma unroll
        for (int i = 0; i < 4; ++i) { ofw[i] = *(const u32x2*)(zo + 16 * i); gat[i] = *(const u32x2*)(zo + 4096 + 16 * i); }
    }
    LBAR();
    if (OUT) {
        const int st = w >> 1, ct0 = (w & 1) * 2;
#pragma unroll
        for (int i = 0; i < 2; ++i) {
            const int ct = ct0 + i;
            f32x4 a = (f32x4){0.f, 0.f, 0.f, 0.f};
            const bool zero = (D == 0) ? (st > ct) : (st < ct);
            if (!zero) {
#pragma unroll
                for (int ks = 0; ks < 4; ++ks) {
                    const bf16x8 fa = *(const LAS bf16x8*)(KT + (16 * st + l15) * PQ + ks * 32 + lq * 8);
                    const bf16x8 fb = *(const LAS bf16x8*)(QT + (16 * ct + l15) * PQ + ks * 32 + lq * 8);
                    a = mfma16(fa, fb, a);
                }
                const int cc = 16 * ct + l15;
#pragma unroll
                for (int j = 0; j < 4; ++j) { const int ss = 16 * st + lq * 4 + j; const bool keep = (D == 0) ? (ss <= cc) : (ss >= cc); a[j] = keep ? a[j] : 0.f; }
            }
            u32x2 wv; wv.x = pk2(a[0], a[1]); wv.y = pk2(a[2], a[3]);
            *(LAS u32x2*)(PP + (16 * ct + l15) * PT + 16 * st + lq * 4) = wv;
        }
    }
    {
        bf16x8 fa[2];
#pragma unroll
        for (int ks = 0; ks < 2; ++ks) fa[ks] = *(const LAS bf16x8*)(KTT + (16 * w + l15) * PT + ks * 32 + lq * 8);
#pragma unroll
        for (int vt = 0; vt < 8; ++vt) {
#pragma unroll
            for (int ks = 0; ks < 2; ++ks) {
                const bf16x8 fb = *(const LAS bf16x8*)(VTT + (16 * vt + l15) * PT + ks * 32 + lq * 8);
                S[vt] = mfma16(fa[ks], fb, S[vt]);
            }
#pragma unroll
            for (int j = 0; j < 4; ++j) S[vt][j] *= el[j];
        }
    }
    if (OUT) {
        LBAR();
        f32x4 o[4];
#pragma unroll
        for (int i = 0; i < 4; ++i) o[i] = (f32x4){0.f, 0.f, 0.f, 0.f};
#pragma unroll
        for (int ks = 0; ks < 2; ++ks) {
            const bf16x8 fb = *(const LAS bf16x8*)(PP + (16 * rt + l15) * PT + ks * 32 + lq * 8);
#pragma unroll
            for (int i = 0; i < 4; ++i) { const bf16x8 fa = *(const LAS bf16x8*)(VTT + (16 * (vh + i) + l15) * PT + ks * 32 + lq * 8); o[i] = mfma16(fa, fb, o[i]); }
        }
#pragma unroll
        for (int ks = 0; ks < 4; ++ks) {
            const bf16x8 fb = *(const LAS bf16x8*)(QT + (16 * rt + l15) * PQ + ks * 32 + lq * 8);
#pragma unroll
            for (int i = 0; i < 4; ++i) { const bf16x8 fa = *(const LAS bf16x8*)(STT + (16 * (vh + i) + l15) * PQ + ks * 32 + lq * 8); o[i] = mfma16(fa, fb, o[i]); }
        }
        if (D == 0) {
#pragma unroll
            for (int i = 0; i < 4; ++i) { u32x2 wv; wv.x = pk2(o[i][0], o[i][1]); wv.y = pk2(o[i][2], o[i][3]); *(u32x2*)(zo + 16 * i) = wv; }
        } else {
            float sq = 0.f;
#pragma unroll
            for (int i = 0; i < 4; ++i) {
                o[i][0] += bflo(ofw[i].x); o[i][1] += bfhi(ofw[i].x); o[i][2] += bflo(ofw[i].y); o[i][3] += bfhi(ofw[i].y);
                sq += o[i][0] * o[i][0] + o[i][1] * o[i][1] + o[i][2] * o[i][2] + o[i][3] * o[i][3];
            }
            sq += __shfl_xor(sq, 16); sq += __shfl_xor(sq, 32);
            if (lq == 0) SSQ[(w >> 2) * 64 + 16 * rt + l15] = sq;
            LBAR();
            const float rstd = rsqrtf((SSQ[16 * rt + l15] + SSQ[64 + 16 * rt + l15]) * (1.0f / 128.0f) + EPS);
#pragma unroll
            for (int i = 0; i < 4; ++i) {
                const f32x4 gn = *(const f32x4*)(gnorm + h * 128 + 16 * (vh + i) + 4 * lq);
                const float y0 = o[i][0] * rstd * gn[0] * bflo(gat[i].x), y1 = o[i][1] * rstd * gn[1] * bfhi(gat[i].x);
                const float y2 = o[i][2] * rstd * gn[2] * bflo(gat[i].y), y3 = o[i][3] * rstd * gn[3] * bfhi(gat[i].y);
                u32x2 wv; wv.x = pk2(y0, y1); wv.y = pk2(y2, y3);
                *(u32x2*)(zo + 1024 + 16 * i) = wv;
            }
        }
    }
}

__device__ __forceinline__ int sc_rowbase(int b, int jsc) { return jsc == 0 ? ML + b * CTXL : b * SEQ + (jsc - 1) * 256; }

__device__ __forceinline__ void phase_gla1(LAS unsigned char* lds, bf16_t* Z, float* Sbuf, float* Dbuf) {
    int tid_ = threadIdx.x; asm volatile("" : "+v"(tid_));
    const int tid = tid_, lane = tid & 63, w = __builtin_amdgcn_readfirstlane(tid >> 6);
    GlaPF pf;
    int task = blockIdx.x;
    if (task < 2048) {
        const int bhd = task >> 5, p = task & 31, b = bhd >> 4, h = (bhd >> 1) & 7, d = bhd & 1;
        const int jsc = (p == 0) ? 0 : (d == 0 ? p : 33 - p);
        gla_prefetch<false>(pf, Z, sc_rowbase(b, jsc) + (d ? 192 : 0), d * 1024, h, tid);
    }
    for (; task < 2048; task += gridDim.x) {
        const int bhd = task >> 5, p = task & 31, b = bhd >> 4, h = (bhd >> 1) & 7, d = bhd & 1;
        const int jsc = (p == 0) ? 0 : (d == 0 ? p : 33 - p);
        const int rb = sc_rowbase(b, jsc);
        const int nt = task + gridDim.x; const bool hn = nt < 2048;
        int nrow = 0, ngc = 0, nh = 0;
        if (hn) { const int nbhd = nt >> 5, np = nt & 31, nb = nbhd >> 4, nd = nbhd & 1; nh = (nbhd >> 1) & 7;
            const int nj = (np == 0) ? 0 : (nd == 0 ? np : 33 - np); nrow = sc_rowbase(nb, nj) + (nd ? 192 : 0); ngc = nd * 1024; }
        f32x4 S[8];
#pragma unroll
        for (int vt = 0; vt < 8; ++vt) S[vt] = (f32x4){0.f, 0.f, 0.f, 0.f};
        float lastsum[2] = {0.f, 0.f};
        if (d == 0) {
#pragma unroll 1
            for (int ci = 0; ci < 4; ++ci) { const bool last = ci == 3; gla_chunk<false, 0>(lds, Z, rb + ci * 64, h, S, lastsum, nullptr, pf, last ? hn : true, last ? nrow : rb + (ci + 1) * 64, last ? ngc : 0, last ? nh : h); }
        } else {
#pragma unroll 1
            for (int ci = 3; ci >= 0; --ci) { const bool last = ci == 0; gla_chunk<false, 1>(lds, Z, rb + ci * 64, h, S, lastsum, nullptr, pf, last ? hn : true, last ? nrow : rb + (ci - 1) * 64, last ? ngc : 1024, last ? nh : h); }
        }
        float* sp = Sbuf + (size_t)task * 16384;
#pragma unroll
        for (int vt = 0; vt < 8; ++vt)
#pragma unroll
            for (int j = 0; j < 4; ++j) sp[((w * 8 + vt) * 4 + j) * 64 + lane] = S[vt][j];
        if (tid < 64) *(f32x2*)(Dbuf + (size_t)task * 128 + 2 * tid) = (f32x2){__expf(lastsum[0]), __expf(lastsum[1])};
        LBAR();
    }
}
__device__ __forceinline__ void phase_gla2(float* Sbuf, const float* Dbuf) {
    int tid_ = threadIdx.x; asm volatile("" : "+v"(tid_));
    const int gt = blockIdx.x * 512 + tid_, nth = gridDim.x * 512;
    for (int idx = gt; idx < 64 * 4096; idx += nth) {
        const int bhd = idx >> 12, e4 = idx & 4095, e = e4 * 4;
        const int k = 16 * (e >> 11) + ((e & 63) >> 4) * 4 + ((e >> 6) & 3);
        f32x4 s = (f32x4){0.f, 0.f, 0.f, 0.f};
        f32x4* sp = (f32x4*)(Sbuf + (size_t)bhd * 32 * 16384) + e4;
        const float* dp = Dbuf + (size_t)bhd * 32 * 128 + k;
#pragma unroll 8
        for (int p = 0; p < 32; ++p) { const float dd = dp[p * 128]; const f32x4 a = sp[(size_t)p * 4096]; s = s * dd + a; sp[(size_t)p * 4096] = s; }
    }
}
__device__ __forceinline__ void phase_gla3(LAS unsigned char* lds, bf16_t* Z, const float* Sbuf, const float* gnorm, int with_ctx) {
    int tid_ = threadIdx.x; asm volatile("" : "+v"(tid_));
    const int tid = tid_, lane = tid & 63, w = __builtin_amdgcn_readfirstlane(tid >> 6);
    const int jlo = with_ctx ? 0 : 1, nj = 33 - jlo, ntask = 32 * nj;
    GlaPF pf;
    int task = blockIdx.x;
    if (task < ntask) { const int bh = task / nj, jsc = jlo + task % nj; gla_prefetch<true>(pf, Z, sc_rowbase(bh >> 3, jsc), 0, bh & 7, tid); }
    for (; task < ntask; task += gridDim.x) {
        const int bh = task / nj, jsc = jlo + task % nj, b = bh >> 3, h = bh & 7;
        const int rb = sc_rowbase(b, jsc);
        const int nt = task + gridDim.x; const bool hn = nt < ntask;
        int nrow = 0, nh = 0;
        if (hn) { const int nbh = nt / nj, njsc = jlo + nt % nj; nrow = sc_rowbase(nbh >> 3, njsc); nh = nbh & 7; }
        float dummy[2] = {0.f, 0.f};
        f32x4 S[8];
        {
            const int p = jsc;
            if (p == 0) {
#pragma unroll
                for (int vt = 0; vt < 8; ++vt) S[vt] = (f32x4){0.f, 0.f, 0.f, 0.f};
            } else {
                const float* sp = Sbuf + ((size_t)((bh * 2 + 0) * 32 + (p - 1))) * 16384;
#pragma unroll
                for (int vt = 0; vt < 8; ++vt)
#pragma unroll
                    for (int j = 0; j < 4; ++j) S[vt][j] = sp[((w * 8 + vt) * 4 + j) * 64 + lane];
            }
#pragma unroll 1
            for (int ci = 0; ci < 4; ++ci) { const bool last = ci == 3; gla_chunk<true, 0>(lds, Z, rb + ci * 64, h, S, dummy, gnorm, pf, true, last ? rb + 192 : rb + (ci + 1) * 64, last ? 1024 : 0, h); }
        }
        {
            const int p = (jsc == 0) ? 0 : 33 - jsc;
            if (p == 0) {
#pragma unroll
                for (int vt = 0; vt < 8; ++vt) S[vt] = (f32x4){0.f, 0.f, 0.f, 0.f};
            } else {
                const float* sp = Sbuf + ((size_t)((bh * 2 + 1) * 32 + (p - 1))) * 16384;
#pragma unroll
                for (int vt = 0; vt < 8; ++vt)
#pragma unroll
                    for (int j = 0; j < 4; ++j) S[vt][j] = sp[((w * 8 + vt) * 4 + j) * 64 + lane];
            }
            asm volatile("s_waitcnt vmcnt(0)" ::: "memory");
            __builtin_amdgcn_fence(__ATOMIC_ACQUIRE, "agent");
            LBAR();
#pragma unroll 1
            for (int ci = 3; ci >= 0; --ci) { const bool last = ci == 0; gla_chunk<true, 1>(lds, Z, rb + ci * 64, h, S, dummy, gnorm, pf, last ? hn : true, last ? nrow : rb + (ci - 1) * 64, last ? 0 : 1024, last ? nh : h); }
        }
        asm volatile("s_waitcnt vmcnt(0)" ::: "memory");
        LBAR();
    }
}


#define XB_TMO      128
#define XB_XCNT(j)  (256  + 64 * (j))
#define XB_XSUB(j)  (1280 + 64 * (j))
#define XB_XGEN(j)  (2304 + 64 * (j))
#define XB_TOP      3328
#define XB_TOPGEN   3392
#define XCD_BAR_WORDS 3456
#define XB_SPIN_CAP (1u << 22)
__device__ __forceinline__ unsigned xb_ld(unsigned* p)              { return __hip_atomic_load(p, __ATOMIC_RELAXED, __HIP_MEMORY_SCOPE_AGENT); }
__device__ __forceinline__ unsigned xb_add(unsigned* p, unsigned v) { return __hip_atomic_fetch_add(p, v, __ATOMIC_RELAXED, __HIP_MEMORY_SCOPE_AGENT); }
__device__ __forceinline__ unsigned xb_xcc_id() { return (unsigned)__builtin_amdgcn_s_getreg((3 << 11) | 20) & 0xFu; }
#define XB_SPIN(cond, bar) do { unsigned _sp = 0; while (cond) { __builtin_amdgcn_s_sleep(1); \
    if ((++_sp & 255u) == 0u) { if (xb_ld(&(bar)[XB_TMO])) break; if (_sp > XB_SPIN_CAP) { atomicAdd(&(bar)[XB_TMO], 1u); break; } } } } while (0)
struct XcdBarrier { unsigned* bar; unsigned x; volatile LAS unsigned* st; };
__device__ __forceinline__ XcdBarrier xcd_barrier_post(unsigned* bar, volatile LAS unsigned* st) {
    XcdBarrier b; b.bar = bar; b.x = xb_xcc_id(); b.st = st;
    if (threadIdx.x == 0) (void)xb_add(&bar[XB_XCNT(b.x)], 1u);
    return b;
}
__device__ __forceinline__ void xcd_barrier_complete(unsigned* bar, unsigned x, unsigned& nloc, unsigned& nx) {
    const unsigned G = gridDim.x * gridDim.y * gridDim.z;
    unsigned sum, cnt, mine, sp = 0u;
    for (;;) {
        sum = 0u; cnt = 0u; mine = 0u;
#pragma unroll
        for (unsigned j = 0; j < 16; ++j) { const unsigned c = xb_ld(&bar[XB_XCNT(j)]); sum += c; cnt += (c > 0u) ? 1u : 0u; mine = (j == x) ? c : mine; }
        if (sum == G) break;
        __builtin_amdgcn_s_sleep(1);
        if ((++sp & 255u) == 0u) { if (xb_ld(&bar[XB_TMO])) break; if (sp > XB_SPIN_CAP) { atomicAdd(&bar[XB_TMO], 1u); break; } }
    }
    nloc = mine > 0u ? mine : 1u; nx = cnt > 0u ? cnt : 1u;
}
__device__ __forceinline__ void xcd_barrier(const XcdBarrier& b) {
    asm volatile("s_waitcnt vmcnt(0)" ::: "memory");
    __syncthreads();
    if (threadIdx.x == 0) {
        unsigned* bar = b.bar;
        __builtin_amdgcn_s_waitcnt(0);
        unsigned nloc = b.st[0], nx = b.st[1];
        if (nloc == 0u) { xcd_barrier_complete(bar, b.x, nloc, nx); b.st[0] = nloc; b.st[1] = nx; }
        const unsigned old = xb_add(&bar[XB_XSUB(b.x)], 1u);
        const unsigned gen = old / nloc;
        if (old + 1u == (gen + 1u) * nloc) {
            __builtin_amdgcn_fence(__ATOMIC_RELEASE, "agent");
            asm volatile("s_waitcnt vmcnt(0)" ::: "memory");
            const unsigned og = xb_add(&bar[XB_TOP], 1u);
            const unsigned tg = og / nx;
            if (og + 1u == (tg + 1u) * nx) xb_add(&bar[XB_TOPGEN], 1u);
            else XB_SPIN(xb_ld(&bar[XB_TOPGEN]) == tg, bar);
            __builtin_amdgcn_fence(__ATOMIC_ACQUIRE, "agent");
            xb_add(&bar[XB_XGEN(b.x)], 1u);
            asm volatile("s_waitcnt vmcnt(0)" ::: "memory");
        } else {
            XB_SPIN(xb_ld(&bar[XB_XGEN(b.x)]) == gen, bar);
            __builtin_amdgcn_fence(__ATOMIC_ACQUIRE, "agent");
            asm volatile("s_waitcnt vmcnt(0)" ::: "memory");
        }
    }
    __syncthreads();
}

__global__ void __launch_bounds__(512, 2) mega_fwd(Params p) {
    extern __shared__ __attribute__((aligned(16))) unsigned char lds_raw[];
    LAS unsigned char* lds = (LAS unsigned char*)lds_raw;
    cg::grid_group grid = cg::this_grid();
    unsigned char* ws = p.ws;
    float* X = (float*)(ws + WS_X); bf16_t* Z = (bf16_t*)(ws + WS_Z);
    bf16_t* Win_t = (bf16_t*)(ws + WS_WIN); bf16_t* Wout_t = (bf16_t*)(ws + WS_WOUT); bf16_t* W1_t = (bf16_t*)(ws + WS_W1); bf16_t* W2_t = (bf16_t*)(ws + WS_W2);
    float* Dbuf = (float*)(ws + WS_DB); float* mods = (float*)(ws + WS_MOD); float* lbv = (float*)(ws + WS_LB);
    bf16_t* HA = (bf16_t*)p.out;
    float* Sbuf = p.out;
    const int G = gridDim.x, bx = blockIdx.x;

    volatile LAS unsigned* xst = (volatile LAS unsigned*)(lds + LDS_MAIN);
    if (threadIdx.x == 0) { xst[0] = 0u; xst[1] = 0u; }
    __syncthreads();
    const XcdBarrier xbar = xcd_barrier_post((unsigned*)(ws + WS_BAR), xst);
    phase_ada(p, lds, mods, lbv);
    grid.sync();

#pragma unroll 1
    for (int L = 0; L < 4; ++L) {
        const bool rec = (L & 1) == 0; const int j = L >> 1;
        const float* modL = mods + (size_t)L * 5 * 6144;
        const int Mmix_in = (L < 3) ? MT : ML;
        const int Mlive = (L < 2) ? MT : ML;
#pragma unroll 1
        for (int s = 0; s < 2; ++s) {
            if (s == 0) phase_cvt(p, lds, L);
            {
                const float* srcL = (L == 0 && s == 0) ? p.in[0] : X;
                const float* srcC = (L == 0 && s == 0) ? p.in[2] : X + (size_t)ML * DM;
                const float* gain = (s == 0 ? p.in[6] : p.in[7]) + L * 1024;
                phase_norm(srcL, srcC, s == 0 ? Mmix_in : Mlive, gain, modL, s == 0 ? 0 : 3 * 1024, s == 0 ? 1024 : 4 * 1024, HA);
            }
            xcd_barrier(xbar);
            pg8::Gemm g; const float* gate; const float* resL; const float* resC;
            if (s == 0) {
                if (rec) {
                    { pg8::Gemm gi{HA, Win_t, Mmix_in, 5120, 1024, 1024}; pg8::StaticOrder S; S.init(gi.M, gi.N, G, bx);
                      EpiHgrnIn E{Z, lbv + (size_t)j * 2048}; pg8::gemm_phase<EpiHgrnIn>(lds, gi, S, E); }
                    xcd_barrier(xbar);
                    phase_gla1(lds, Z, Sbuf, Dbuf);
                    xcd_barrier(xbar);
                    phase_gla2(Sbuf, Dbuf);
                    xcd_barrier(xbar);
                    phase_gla3(lds, Z, Sbuf, p.in[13] + j * 1024, L < 2 ? 1 : 0);
                    xcd_barrier(xbar);
                    g = pg8::Gemm{Z + 1024, Wout_t, Mlive, 1024, 1024, 5120};
                } else {
                    { pg8::Gemm gi{HA, Win_t, Mmix_in, 3072, 1024, 1024}; pg8::StaticOrder S; S.init(gi.M, gi.N, G, bx);
                      EpiConvIn E{Z}; pg8::gemm_phase<EpiConvIn>(lds, gi, S, E); }
                    xcd_barrier(xbar);
                    phase_conv(Z, p.in[16] + (size_t)j * 3 * 1024, p.in[17] + j * 1024, j & 1, Mlive, HA);
                    xcd_barrier(xbar);
                    g = pg8::Gemm{HA, Wout_t, Mlive, 1024, 1024, 1024};
                }
                gate = modL + 2 * 1024;
                resL = (L == 0) ? p.in[0] : X; resC = (L == 0) ? p.in[2] : X + (size_t)ML * DM;
            } else {
                { pg8::Gemm gi{HA, W1_t, Mlive, 4096, 1024, 1024}; pg8::StaticOrder S; S.init(gi.M, gi.N, G, bx);
                  EpiRelu2 E{Z}; pg8::gemm_phase<EpiRelu2>(lds, gi, S, E); }
                xcd_barrier(xbar);
                g = pg8::Gemm{Z, W2_t, Mlive, 1024, 4096, 4096};
                gate = modL + 5 * 1024;
                resL = X; resC = X + (size_t)ML * DM;
            }
            { pg8::StaticOrder S; S.init(g.M, g.N, G, bx); EpiResid E{X, resL, resC, gate}; pg8::gemm_phase<EpiResid>(lds, g, S, E); }
            xcd_barrier(xbar);
        }
    }
    phase_final(X, p.in[8], p.out);
}

extern "C" void kernel_launch(void* const* d_in, const int* in_sizes, int n_in, void* d_out, int out_size, void* d_ws, size_t ws_size, hipStream_t stream) {
    static int grid = 0;
    if (grid == 0) {
        if (n_in != 19 || out_size != ML * DM || ws_size < WS_END) { fprintf(stderr, "kernel_launch: unexpected shapes / workspace (n_in %d out %d ws %zu need %zu)\n", n_in, out_size, ws_size, (size_t)WS_END); grid = -1; return; }
        int dev = 0, cus = 0, per_cu = 0;
        if (hipGetDevice(&dev) != hipSuccess || hipDeviceGetAttribute(&cus, hipDeviceAttributeMultiprocessorCount, dev) != hipSuccess) { grid = -1; return; }
        if (hipFuncSetAttribute((const void*)mega_fwd, hipFuncAttributeMaxDynamicSharedMemorySize, LDS_BYTES) != hipSuccess) { fprintf(stderr, "kernel_launch: hipFuncSetAttribute failed\n"); grid = -1; return; }
        if (hipOccupancyMaxActiveBlocksPerMultiprocessor(&per_cu, (const void*)mega_fwd, 512, LDS_BYTES) != hipSuccess || per_cu < 1) { fprintf(stderr, "kernel_launch: occupancy query failed (%d)\n", per_cu); per_cu = 1; (void)hipGetLastError(); }
        grid = cus * per_cu;
    }
    if (grid < 0) return;
    if (hipMemsetAsync((char*)d_ws + WS_BAR, 0, XCD_BAR_WORDS * 4, stream) != hipSuccess) { fprintf(stderr, "kernel_launch: memset failed\n"); return; }
    Params p{};
    for (int i = 0; i < 19; ++i) p.in[i] = (const float*)d_in[i];
    p.out = (float*)d_out; p.ws = (unsigned char*)d_ws;
    void* args[] = {&p};
    hipError_t e = hipLaunchCooperativeKernel((const void*)mega_fwd, dim3(grid), dim3(512), args, LDS_BYTES, stream);
    if (e != hipSuccess) fprintf(stderr, "cooperative launch failed: %s (grid %d)\n", hipGetErrorString(e), grid);
}
```

```cpp
#include <hip/hip_runtime.h>
#include <hip/hip_cooperative_groups.h>
#include <cstdio>
namespace cg = cooperative_groups;

#define LAS __attribute__((address_space(3)))
typedef unsigned short bf16_t;
typedef short bf16x8 __attribute__((ext_vector_type(8)));
typedef float f32x4 __attribute__((ext_vector_type(4)));
typedef unsigned u32x4 __attribute__((ext_vector_type(4)));
typedef unsigned u32x2 __attribute__((ext_vector_type(2)));
typedef float f32x2 __attribute__((ext_vector_type(2)));

constexpr int DM = 1024, NB = 4, SEQ = 8192, CTXL = 256, DFF = 4096;
constexpr int ML = NB * SEQ;
constexpr int MC = NB * CTXL;
constexpr int MT = ML + MC;
constexpr float EPS = 1e-6f;

constexpr size_t WS_X = 0;
constexpr size_t WS_Z = WS_X + (size_t)MT * DM * 4;
constexpr size_t WS_WIN = WS_Z + (size_t)MT * 5120 * 2;
constexpr size_t WS_WOUT = WS_WIN + (size_t)5120 * 1024 * 2;
constexpr size_t WS_W1 = WS_WOUT + (size_t)1024 * 1024 * 2;
constexpr size_t WS_W2 = WS_W1 + (size_t)4096 * 1024 * 2;
constexpr size_t WS_DB = WS_W2 + (size_t)4096 * 1024 * 2;
constexpr size_t WS_MOD = WS_DB + (size_t)2048 * 128 * 4;
constexpr size_t WS_LB = WS_MOD + (size_t)4 * 5 * 6144 * 4;
constexpr size_t WS_BAR = WS_LB + (size_t)2 * 2 * 1024 * 4;
constexpr size_t WS_END = WS_BAR + (size_t)3456 * 4;

constexpr int LDS_MAIN = 131072;
constexpr int LDS_BYTES = LDS_MAIN + 16;

struct Params { const float* in[19]; float* out; unsigned char* ws; };

__device__ __forceinline__ float bf2f(bf16_t b) { return __uint_as_float(((unsigned)b) << 16); }
__device__ __forceinline__ bf16_t f2bf(float f) { unsigned u = __float_as_uint(f); u += 0x7FFFu + ((u >> 16) & 1u); return (bf16_t)(u >> 16); }
typedef __bf16 bf16v2_t __attribute__((ext_vector_type(2)));
__device__ __forceinline__ unsigned pk2(float lo, float hi) { const f32x2 v = {lo, hi}; const bf16v2_t r = __builtin_convertvector(v, bf16v2_t); return __builtin_bit_cast(unsigned, r); }
__device__ __forceinline__ float sigmoidf_(float z) { return __builtin_amdgcn_rcpf(1.0f + __expf(-z)); }
__device__ __forceinline__ float siluf_(float z) { return z * __builtin_amdgcn_rcpf(1.0f + __expf(-z)); }

namespace pg8 {
constexpr int BM = 256, BK = 64, HALF = 128, HTB = HALF * BK * 2, NXCD = 8, WGM = 8;
__device__ __forceinline__ int lds_byte(int r, int c) { const int st = (r >> 4) * 2 + (c >> 5), rr = r & 15, cc = c & 31, ob = rr * 64 + cc * 2; return st * 1024 + (ob ^ (((ob >> 9) & 1) << 5)); }
__device__ __forceinline__ void stage_rc(int b, int& R, int& C) { const int st = b / 1024, sb = b % 1024, swz = sb ^ (((sb >> 9) & 1) << 5); R = (st >> 1) * 16 + swz / 64; C = (st & 1) * 32 + (swz % 64) / 2; }
__device__ __forceinline__ int perm32(int rho) { const int n = rho >> 4, i = rho & 15; return 8 * (i >> 2) + 4 * n + (i & 3); }

struct Unit { int pm, pn; };
struct Gemm { const bf16_t* A; const bf16_t* Bt; int M, N, K, lda; };

struct StaticOrder {
    int nM, nN, nwg, G, c;
    __device__ void init(int M, int N, int G_, int c_) { nM = M / BM; nN = N / BM; nwg = nM * nN; G = G_; c = c_; }
    __device__ bool next(int i, Unit& u) const {
        const long L = (long)i * G + c; if (L >= nwg) return false;
        int wgid = (int)L; { const int q = nwg / NXCD, r = nwg % NXCD, xcd = wgid % NXCD, off = wgid / NXCD; wgid = (xcd < r ? xcd * (q + 1) : r * (q + 1) + (xcd - r) * q) + off; }
        const int nig = WGM * nN, gid = wgid / nig, fm = gid * WGM, gsz = (nM - fm) < WGM ? (nM - fm) : WGM;
        u.pm = fm + ((wgid % nig) % gsz); u.pn = (wgid % nig) / gsz; return true;
    }
};

template <class Epi>
__device__ __forceinline__ void gemm_phase(LAS unsigned char* lds, const Gemm g, const StaticOrder& S, const Epi& E) {
    int tid_ = threadIdx.x; asm volatile("" : "+v"(tid_));
    const int tid = tid_, wid = __builtin_amdgcn_readfirstlane(tid >> 6), lane = tid & 63, wr = wid >> 2, wc = wid & 3, fr = lane & 15, fq = lane >> 4;
    const int K = g.K, nt = K / BK, lda = g.lda;
    unsigned voffA[2], voffB[2];
#pragma unroll
    for (int i = 0; i < 2; ++i) { int R, C; stage_rc(tid * 16 + i * 8192, R, C); const int Rb = Epi::PERM ? ((R & ~31) + perm32(R & 31)) : R;
        voffA[i] = (unsigned)(R * lda + C) * 2u; voffB[i] = (unsigned)(Rb * K + C) * 2u; }
    const size_t kstep = (size_t)(BK * 2);
    const size_t hstepA = (size_t)HALF * lda * 2, hstepB = (size_t)HALF * K * 2;
    const size_t tstepA = 2 * hstepA, tstepB = 2 * hstepB;
    const unsigned ldsw = (unsigned)wid * 1024u;
    const int aoff = lds_byte(wr * 64 + fr, fq * 8), boff = lds_byte(wc * 32 + fr, fq * 8);
#define PG8_SA(b, h) (((b) * 2 + (h)) * HTB)
#define PG8_SB(b, h) ((4 + (b) * 2 + (h)) * HTB)
#define PG8_STAGE(bufoff, gbase, voff) do { _Pragma("unroll") for (int _i = 0; _i < 2; ++_i) \
        __builtin_amdgcn_global_load_lds((const unsigned*)((const char*)(gbase) + (voff)[_i]), (LAS unsigned*)(lds + (bufoff) + ldsw + _i * 8192), 16, 0, 0); } while (0)
#define PG8_LDA(dst, b, h) do { _Pragma("unroll") for (int m = 0; m < 4; ++m) _Pragma("unroll") for (int k = 0; k < 2; ++k) dst[m][k] = *(const LAS bf16x8*)(lds + PG8_SA(b, h) + aoff + m * 2048 + k * 1024); } while (0)
#define PG8_LDB(dst, b, h) do { _Pragma("unroll") for (int n = 0; n < 2; ++n) _Pragma("unroll") for (int k = 0; k < 2; ++k) dst[n][k] = *(const LAS bf16x8*)(lds + PG8_SB(b, h) + boff + n * 2048 + k * 1024); } while (0)
#define PG8_MMA(ai, bj, At, Bt) do { __builtin_amdgcn_s_setprio(1); _Pragma("unroll") for (int m = 0; m < 4; ++m) _Pragma("unroll") for (int n = 0; n < 2; ++n) _Pragma("unroll") for (int k = 0; k < 2; ++k) \
        acc[ai][bj][m][n] = __builtin_amdgcn_mfma_f32_16x16x32_bf16(Bt[n][k], At[m][k], acc[ai][bj][m][n], 0, 0, 0); __builtin_amdgcn_s_setprio(0); } while (0)
#define PG8_WAIT_V(n) asm volatile("s_waitcnt vmcnt(" #n ")" ::: "memory")
#define PG8_WAIT_L(n) asm volatile("s_waitcnt lgkmcnt(" #n ")" ::: "memory")
#define PG8_BAR __builtin_amdgcn_s_barrier()
#define PG8_SCHED __builtin_amdgcn_sched_barrier(0)
    Unit cur, nxt; int ui = 0;
    if (!S.next(0, cur)) return;
    f32x4 acc[2][2][4][2];
#pragma unroll
    for (int a = 0; a < 2; ++a)
#pragma unroll
        for (int b = 0; b < 2; ++b)
#pragma unroll
            for (int m = 0; m < 4; ++m)
#pragma unroll
                for (int n = 0; n < 2; ++n) acc[a][b][m][n] = (f32x4){0.f, 0.f, 0.f, 0.f};
    bf16x8 At[4][2], B0[2][2], B1[2][2];
    const char* cA = (const char*)g.A + (size_t)cur.pm * tstepA; const char* cB = (const char*)g.Bt + (size_t)cur.pn * tstepB;
    PG8_STAGE(PG8_SB(0, 0), cB, voffB); PG8_STAGE(PG8_SA(0, 0), cA, voffA); PG8_STAGE(PG8_SB(0, 1), cB + hstepB, voffB); PG8_STAGE(PG8_SA(0, 1), cA + hstepA, voffA);
    if (wr == 1) PG8_BAR;
    PG8_WAIT_V(4); PG8_BAR;
    PG8_STAGE(PG8_SB(1, 0), cB + kstep, voffB); PG8_STAGE(PG8_SA(1, 0), cA + kstep, voffA); PG8_STAGE(PG8_SB(1, 1), cB + hstepB + kstep, voffB);
    PG8_WAIT_V(6); PG8_BAR;
    for (;;) {
        const bool has_next = S.next(ui + 1, nxt);
        const char* nA = has_next ? (const char*)g.A + (size_t)nxt.pm * tstepA : cA; const char* nB = has_next ? (const char*)g.Bt + (size_t)nxt.pn * tstepB : cB;
        for (int t = 0; t < nt; t += 2) {
            const bool last = (t == nt - 2);
            const char* a1 = cA + (size_t)(t + 1) * kstep;
            const char* a2 = last ? nA : cA + (size_t)(t + 2) * kstep; const char* b2 = last ? nB : cB + (size_t)(t + 2) * kstep;
            const char* a3 = a2 + kstep; const char* b3 = b2 + kstep;
            PG8_LDB(B0, 0, 0); PG8_SCHED; PG8_LDA(At, 0, 0); PG8_STAGE(PG8_SA(1, 1), a1 + hstepA, voffA);
            PG8_WAIT_L(8); PG8_BAR; PG8_WAIT_L(0); PG8_MMA(0, 0, At, B0); PG8_BAR; PG8_SCHED;
            PG8_LDB(B1, 0, 1); PG8_STAGE(PG8_SB(0, 0), b2, voffB);
            PG8_BAR; PG8_WAIT_L(0); PG8_MMA(0, 1, At, B1); PG8_BAR;
            PG8_LDA(At, 0, 1); PG8_STAGE(PG8_SA(0, 0), a2, voffA);
            PG8_BAR; PG8_WAIT_L(0); PG8_MMA(1, 0, At, B0); PG8_BAR; PG8_SCHED;
            PG8_STAGE(PG8_SB(0, 1), b2 + hstepB, voffB);
            PG8_WAIT_V(6); PG8_BAR; PG8_MMA(1, 1, At, B1); PG8_BAR;
            PG8_LDB(B0, 1, 0); PG8_SCHED; PG8_LDA(At, 1, 0); PG8_STAGE(PG8_SA(0, 1), a2 + hstepA, voffA);
            PG8_WAIT_L(8); PG8_BAR; PG8_WAIT_L(0); PG8_MMA(0, 0, At, B0); PG8_BAR; PG8_SCHED;
            PG8_LDB(B1, 1, 1); PG8_STAGE(PG8_SB(1, 0), b3, voffB);
            PG8_BAR; PG8_WAIT_L(0); PG8_MMA(0, 1, At, B1); PG8_BAR;
            PG8_LDA(At, 1, 1); PG8_STAGE(PG8_SA(1, 0), a3, voffA);
            PG8_BAR; PG8_WAIT_L(0); PG8_MMA(1, 0, At, B0); PG8_BAR; PG8_SCHED;
            PG8_STAGE(PG8_SB(1, 1), b3 + hstepB, voffB);
            PG8_WAIT_V(6); PG8_BAR; PG8_MMA(1, 1, At, B1); PG8_BAR;
        }
        E(acc, cur, wr, wc, fr, fq);
        if (!has_next) break;
#pragma unroll
        for (int a = 0; a < 2; ++a)
#pragma unroll
            for (int b = 0; b < 2; ++b)
#pragma unroll
                for (int m = 0; m < 4; ++m)
#pragma unroll
                    for (int n = 0; n < 2; ++n) acc[a][b][m][n] = (f32x4){0.f, 0.f, 0.f, 0.f};
        cur = nxt; cA = nA; cB = nB; ++ui;
    }
    PG8_WAIT_V(0);
    if (wr == 0) PG8_BAR;
    PG8_BAR;
#undef PG8_SA
#undef PG8_SB
#undef PG8_STAGE
#undef PG8_LDA
#undef PG8_LDB
#undef PG8_MMA
#undef PG8_WAIT_V
#undef PG8_WAIT_L
#undef PG8_BAR
#undef PG8_SCHED
}
}

struct EpiHgrnIn {
    static constexpr bool PERM = true;
    bf16_t* Z; const float* lbv;
    __device__ __forceinline__ void operator()(const f32x4 (&acc)[2][2][4][2], const pg8::Unit& u, int wr, int wc, int fr, int fq) const {
        const int part = u.pn >> 2;
        const int row0 = u.pm * 256 + wr * 64 + fr, col0 = u.pn * 256 + wc * 32 + 8 * fq;
        f32x4 lb[2][2];
#pragma unroll
        for (int bj = 0; bj < 2; ++bj)
#pragma unroll
            for (int n = 0; n < 2; ++n) lb[bj][n] = (part < 2) ? *(const f32x4*)(lbv + col0 + bj * 128 + 4 * n) : (f32x4){0.f, 0.f, 0.f, 0.f};
#pragma unroll
        for (int ai = 0; ai < 2; ++ai)
#pragma unroll
            for (int m = 0; m < 4; ++m) {
                bf16_t* rowp = Z + (size_t)(row0 + ai * 128 + m * 16) * 5120 + col0;
#pragma unroll
                for (int bj = 0; bj < 2; ++bj) {
                    float o[8];
#pragma unroll
                    for (int n = 0; n < 2; ++n)
#pragma unroll
                        for (int j = 0; j < 4; ++j) {
                            const float z = acc[ai][bj][m][n][j]; float r;
                            if (part < 2) { const float l = lb[bj][n][j]; const float f = l + (1.0f - l) * sigmoidf_(z); r = __logf(fmaxf(f, 1e-30f)); }
                            else if (part == 2) r = z;
                            else r = siluf_(z);
                            o[n * 4 + j] = r;
                        }
                    u32x4 w; w.x = pk2(o[0], o[1]); w.y = pk2(o[2], o[3]); w.z = pk2(o[4], o[5]); w.w = pk2(o[6], o[7]);
                    *(u32x4*)(rowp + bj * 128) = w;
                }
            }
    }
};
struct EpiConvIn {
    static constexpr bool PERM = true;
    bf16_t* Z;
    __device__ __forceinline__ void operator()(const f32x4 (&acc)[2][2][4][2], const pg8::Unit& u, int wr, int wc, int fr, int fq) const {
        const int row0 = u.pm * 256 + wr * 64 + fr;
        if (u.pn < 4) {
            const int col0 = u.pn * 256 + wc * 32 + 8 * fq;
#pragma unroll
            for (int ai = 0; ai < 2; ++ai)
#pragma unroll
                for (int m = 0; m < 4; ++m) {
                    bf16_t* rowp = Z + (size_t)(row0 + ai * 128 + m * 16) * 2048 + col0;
#pragma unroll
                    for (int bj = 0; bj < 2; ++bj) {
                        const f32x4 v0 = acc[ai][bj][m][0], v1 = acc[ai][bj][m][1];
                        u32x4 w; w.x = pk2(v0[0], v0[1]); w.y = pk2(v0[2], v0[3]); w.z = pk2(v1[0], v1[1]); w.w = pk2(v1[2], v1[3]);
                        *(u32x4*)(rowp + bj * 128) = w;
                    }
                }
        } else {
            const int col0 = 1024 + (u.pn - 4) * 128 + wc * 32 + 8 * fq;
#pragma unroll
            for (int ai = 0; ai < 2; ++ai)
#pragma unroll
                for (int m = 0; m < 4; ++m) {
                    bf16_t* rowp = Z + (size_t)(row0 + ai * 128 + m * 16) * 2048 + col0;
                    const f32x4 v0 = acc[ai][0][m][0] * acc[ai][1][m][0], v1 = acc[ai][0][m][1] * acc[ai][1][m][1];
                    u32x4 w; w.x = pk2(v0[0], v0[1]); w.y = pk2(v0[2], v0[3]); w.z = pk2(v1[0], v1[1]); w.w = pk2(v1[2], v1[3]);
                    *(u32x4*)rowp = w;
                }
        }
    }
};
struct EpiRelu2 {
    static constexpr bool PERM = true;
    bf16_t* Z;
    __device__ __forceinline__ void operator()(const f32x4 (&acc)[2][2][4][2], const pg8::Unit& u, int wr, int wc, int fr, int fq) const {
        const int row0 = u.pm * 256 + wr * 64 + fr, col0 = u.pn * 256 + wc * 32 + 8 * fq;
#pragma unroll
        for (int ai = 0; ai < 2; ++ai)
#pragma unroll
            for (int m = 0; m < 4; ++m) {
                bf16_t* rowp = Z + (size_t)(row0 + ai * 128 + m * 16) * 4096 + col0;
#pragma unroll
                for (int bj = 0; bj < 2; ++bj) {
                    float o[8];
#pragma unroll
                    for (int n = 0; n < 2; ++n)
#pragma unroll
                        for (int j = 0; j < 4; ++j) { const float z = fmaxf(acc[ai][bj][m][n][j], 0.f); o[n * 4 + j] = z * z; }
                    u32x4 w; w.x = pk2(o[0], o[1]); w.y = pk2(o[2], o[3]); w.z = pk2(o[4], o[5]); w.w = pk2(o[6], o[7]);
                    *(u32x4*)(rowp + bj * 128) = w;
                }
            }
    }
};
struct EpiResid {
    static constexpr bool PERM = false;
    float* X; const float* resL; const float* resC; const float* gate;
    __device__ __forceinline__ void operator()(const f32x4 (&acc)[2][2][4][2], const pg8::Unit& u, int wr, int wc, int fr, int fq) const {
        const int row0 = u.pm * 256 + wr * 64 + fr, col0 = u.pn * 256 + wc * 32 + 4 * fq;
        const int bb = u.pm < 128 ? (u.pm >> 5) : 4;
        const float* gp = gate + (size_t)bb * 6144 + col0;
        f32x4 gv[2][2];
#pragma unroll
        for (int bj = 0; bj < 2; ++bj)
#pragma unroll
            for (int n = 0; n < 2; ++n) gv[bj][n] = *(const f32x4*)(gp + bj * 128 + n * 16);
#pragma unroll
        for (int ai = 0; ai < 2; ++ai)
#pragma unroll
            for (int m = 0; m < 4; ++m) {
                const int row = row0 + ai * 128 + m * 16;
                const float* rp = (row < ML ? resL + (size_t)row * DM : resC + (size_t)(row - ML) * DM) + col0;
                float* xp = X + (size_t)row * DM + col0;
#pragma unroll
                for (int bj = 0; bj < 2; ++bj)
#pragma unroll
                    for (int n = 0; n < 2; ++n) {
                        const f32x4 r = *(const f32x4*)(rp + bj * 128 + n * 16);
                        *(f32x4*)(xp + bj * 128 + n * 16) = r + gv[bj][n] * acc[ai][bj][m][n];
                    }
            }
    }
};

__device__ __forceinline__ void phase_ada(const Params& p, LAS unsigned char* lds, float* mods, float* lbv) {
    int tid_ = threadIdx.x; asm volatile("" : "+v"(tid_)); const int tid = tid_;
    LAS float* s = (LAS float*)lds;
    LAS float* red = s + 5 * 1024;
    const float* c = p.in[1]; const float* cc = p.in[3];
    for (int i = tid; i < 5 * 1024; i += 512) { const int bb = i >> 10, k = i & 1023; const float v = bb < 4 ? c[bb * 1024 + k] : cc[k]; s[i] = siluf_(v); }
    __syncthreads();
    const int col = tid & 63, ks = tid >> 6;
    for (int item = blockIdx.x; item < 4 * 96; item += gridDim.x) {
        const int l = item / 96, n0 = (item % 96) * 64;
        const float* W = p.in[4] + (size_t)l * 1024 * 6144 + n0 + col;
        float a0 = 0.f, a1 = 0.f, a2 = 0.f, a3 = 0.f, a4 = 0.f;
#pragma unroll 8
        for (int k = ks * 128; k < ks * 128 + 128; ++k) {
            const float w = W[(size_t)k * 6144];
            a0 += s[k] * w; a1 += s[1024 + k] * w; a2 += s[2048 + k] * w; a3 += s[3072 + k] * w; a4 += s[4096 + k] * w;
        }
        red[(ks * 5 + 0) * 64 + col] = a0; red[(ks * 5 + 1) * 64 + col] = a1; red[(ks * 5 + 2) * 64 + col] = a2; red[(ks * 5 + 3) * 64 + col] = a3; red[(ks * 5 + 4) * 64 + col] = a4;
        __syncthreads();
        if (tid < 320) {
            const int bb = tid >> 6; float t = 0.f;
#pragma unroll
            for (int q = 0; q < 8; ++q) t += red[(q * 5 + bb) * 64 + col];
            mods[(size_t)(l * 5 + bb) * 6144 + n0 + col] = t + p.in[5][l * 6144 + n0 + col];
        }
        __syncthreads();
    }
    if (blockIdx.x == 0) {
        const float* hl = p.in[12];
        for (int i = tid; i < 2 * 1024; i += 512) {
            const int d = i >> 10, ch = i & 1023;
            const float a = hl[(d * 2 + 0) * 1024 + ch], b = hl[(d * 2 + 1) * 1024 + ch];
            const float m = fmaxf(a, b), ea = __expf(a - m), eb = __expf(b - m);
            lbv[(0 * 2 + d) * 1024 + ch] = 0.f;
            lbv[(1 * 2 + d) * 1024 + ch] = eb / (ea + eb);
        }
    }
}

__device__ __forceinline__ void cvt_tile(const float* src, int ld, int Kdim, bf16_t* dst, int ntile, int ktile, int mapmode, LAS float* T) {
    int tid_ = threadIdx.x; asm volatile("" : "+v"(tid_)); const int tid = tid_;
    const int n0 = ntile * 64, k0 = ktile * 64;
    int sc0 = n0;
    if (mapmode && n0 >= 1024) { const int t = (n0 - 1024) >> 8, w = (n0 - 1024) & 255; sc0 = (w < 128) ? 1024 + 128 * t + w : 2048 + 128 * t + (w - 128); }
    {
        const int kk = tid >> 3, n8 = (tid & 7) * 8;
        const float* sp = src + (size_t)(k0 + kk) * ld + sc0 + n8;
        const f32x4 a = *(const f32x4*)sp, b = *(const f32x4*)(sp + 4);
        LAS float* tp = T + kk * 65 + n8;
        tp[0] = a[0]; tp[1] = a[1]; tp[2] = a[2]; tp[3] = a[3]; tp[4] = b[0]; tp[5] = b[1]; tp[6] = b[2]; tp[7] = b[3];
    }
    __syncthreads();
    {
        const int nn = tid >> 3, k8 = (tid & 7) * 8;
        float v[8];
#pragma unroll
        for (int i = 0; i < 8; ++i) v[i] = T[(k8 + i) * 65 + nn];
        u32x4 w; w.x = pk2(v[0], v[1]); w.y = pk2(v[2], v[3]); w.z = pk2(v[4], v[5]); w.w = pk2(v[6], v[7]);
        *(u32x4*)(dst + (size_t)(n0 + nn) * Kdim + k0 + k8) = w;
    }
    __syncthreads();
}
__device__ __forceinline__ void phase_cvt(const Params& p, LAS unsigned char* lds, int L) {
    const int j = L >> 1; const bool rec = (L & 1) == 0;
    const int Nin = rec ? 5120 : 3072;
    const float* win = rec ? p.in[11] + (size_t)j * 1024 * 5120 : p.in[15] + (size_t)j * 1024 * 3072;
    const float* wout = rec ? p.in[14] + (size_t)j * 1024 * 1024 : p.in[18] + (size_t)j * 1024 * 1024;
    const float* w1 = p.in[9] + (size_t)L * 1024 * 4096;
    const float* w2 = p.in[10] + (size_t)L * 4096 * 1024;
    bf16_t* Win_t = (bf16_t*)(p.ws + WS_WIN); bf16_t* Wout_t = (bf16_t*)(p.ws + WS_WOUT); bf16_t* W1_t = (bf16_t*)(p.ws + WS_W1); bf16_t* W2_t = (bf16_t*)(p.ws + WS_W2);
    const int t0 = (Nin / 64) * 16, t1 = t0 + 256, t2 = t1 + 1024, t3 = t2 + 1024;
    LAS float* T = (LAS float*)lds;
    for (int it = blockIdx.x; it < t3; it += gridDim.x) {
        if (it < t0) cvt_tile(win, Nin, 1024, Win_t, it >> 4, it & 15, rec ? 0 : 1, T);
        else if (it < t1) { const int q = it - t0; cvt_tile(wout, 1024, 1024, Wout_t, q >> 4, q & 15, 0, T); }
        else if (it < t2) { const int q = it - t1; cvt_tile(w1, 4096, 1024, W1_t, q >> 4, q & 15, 0, T); }
        else { const int q = it - t2; cvt_tile(w2, 1024, 4096, W2_t, q >> 6, q & 63, 0, T); }
    }
}

__device__ __forceinline__ void phase_norm(const float* srcL, const float* srcC, int M, const float* gain, const float* mod, int shoff, int scoff, bf16_t* HA) {
    int tid_ = threadIdx.x; asm volatile("" : "+v"(tid_));
    const int lane = tid_ & 63, gw = blockIdx.x * 8 + (tid_ >> 6), nw = gridDim.x * 8;
    for (int r = gw; r < M; r += nw) {
        const float* xr = r < ML ? srcL + (size_t)r * DM : srcC + (size_t)(r - ML) * DM;
        const int bb = r < ML ? (r >> 13) : 4;
        const float* mp = mod + (size_t)bb * 6144;
        f32x4 v[4]; float ss = 0.f;
#pragma unroll
        for (int i = 0; i < 4; ++i) { v[i] = *(const f32x4*)(xr + i * 256 + lane * 4); ss += v[i][0] * v[i][0] + v[i][1] * v[i][1] + v[i][2] * v[i][2] + v[i][3] * v[i][3]; }
#pragma unroll
        for (int o = 32; o >= 1; o >>= 1) ss += __shfl_xor(ss, o);
        const float rstd = rsqrtf(ss * (1.0f / DM) + EPS);
#pragma unroll
        for (int i = 0; i < 4; ++i) {
            const int col = i * 256 + lane * 4;
            const f32x4 g = *(const f32x4*)(gain + col), sc = *(const f32x4*)(mp + scoff + col), sh = *(const f32x4*)(mp + shoff + col);
            float h[4];
#pragma unroll
            for (int q = 0; q < 4; ++q) h[q] = (v[i][q] * rstd * g[q]) * (1.0f + sc[q]) + sh[q];
            u32x2 w; w.x = pk2(h[0], h[1]); w.y = pk2(h[2], h[3]);
            *(u32x2*)(HA + (size_t)r * DM + col) = w;
        }
    }
}
__device__ __forceinline__ void phase_final(const float* X, const float* gain, float* out) {
    int tid_ = threadIdx.x; asm volatile("" : "+v"(tid_));
    const int lane = tid_ & 63, gw = blockIdx.x * 8 + (tid_ >> 6), nw = gridDim.x * 8;
    for (int r = gw; r < ML; r += nw) {
        const float* xr = X + (size_t)r * DM;
        f32x4 v[4]; float ss = 0.f;
#pragma unroll
        for (int i = 0; i < 4; ++i) { v[i] = *(const f32x4*)(xr + i * 256 + lane * 4); ss += v[i][0] * v[i][0] + v[i][1] * v[i][1] + v[i][2] * v[i][2] + v[i][3] * v[i][3]; }
#pragma unroll
        for (int o = 32; o >= 1; o >>= 1) ss += __shfl_xor(ss, o);
        const float rstd = rsqrtf(ss * (1.0f / DM) + EPS);
#pragma unroll
        for (int i = 0; i < 4; ++i) {
            const int col = i * 256 + lane * 4;
            const f32x4 g = *(const f32x4*)(gain + col);
            *(f32x4*)(out + (size_t)r * DM + col) = v[i] * rstd * g;
        }
    }
}

__device__ __forceinline__ void phase_conv(const bf16_t* Z, const float* cw, const float* cb, int axis_rows, int M, bf16_t* HA) {
    int tid_ = threadIdx.x; asm volatile("" : "+v"(tid_));
    const int gt = blockIdx.x * 512 + tid_, nth = gridDim.x * 512;
    for (int it = gt; it < M * 128; it += nth) {
        const int r = it >> 7, c8 = (it & 127) * 8;
        int dlt; bool hasp, hasn;
        if (r < ML) {
            const int t = r & (SEQ - 1);
            if (axis_rows) { dlt = 64; const int gr = t >> 6; hasp = gr > 0; hasn = gr < 127; }
            else { dlt = 1; const int gc = t & 63; hasp = gc > 0; hasn = gc < 63; }
        } else { dlt = 1; const int t = (r - ML) & (CTXL - 1); hasp = t > 0; hasn = t < CTXL - 1; }
        const bf16_t* up = Z + (size_t)r * 2048 + 1024 + c8;
        const u32x4 uc = *(const u32x4*)up;
        u32x4 upv = (u32x4){0u, 0u, 0u, 0u}, unv = (u32x4){0u, 0u, 0u, 0u};
        if (hasp) upv = *(const u32x4*)(up - (size_t)dlt * 2048);
        if (hasn) unv = *(const u32x4*)(up + (size_t)dlt * 2048);
        const u32x4 gb = *(const u32x4*)(Z + (size_t)r * 2048 + c8);
        float o[8];
#pragma unroll
        for (int q = 0; q < 8; ++q) {
            const unsigned sh = (q & 1) * 16;
            const float u0 = __uint_as_float(((upv[q >> 1] >> sh) & 0xFFFFu) << 16), u1 = __uint_as_float(((uc[q >> 1] >> sh) & 0xFFFFu) << 16), u2 = __uint_as_float(((unv[q >> 1] >> sh) & 0xFFFFu) << 16);
            const float g = __uint_as_float(((gb[q >> 1] >> sh) & 0xFFFFu) << 16);
            const int ch = c8 + q;
            o[q] = g * (cb[ch] + cw[ch] * u0 + cw[1024 + ch] * u1 + cw[2048 + ch] * u2);
        }
        u32x4 w; w.x = pk2(o[0], o[1]); w.y = pk2(o[2], o[3]); w.z = pk2(o[4], o[5]); w.w = pk2(o[6], o[7]);
        *(u32x4*)(HA + (size_t)r * DM + c8) = w;
    }
}

constexpr int G_QT = 0, G_KT = 17408, G_KTT = 34816, G_VTT = 53248, G_PP = 71680, G_STT = 80896, G_TOT = 115712, G_SSQ = 119808;
constexpr int PQ = 136, PT = 72;

__device__ __forceinline__ f32x4 mfma16(bf16x8 a, bf16x8 b, f32x4 c) { return __builtin_amdgcn_mfma_f32_16x16x32_bf16(a, b, c, 0, 0, 0); }
#define LBAR() do { asm volatile("s_waitcnt lgkmcnt(0)" ::: "memory"); __builtin_amdgcn_s_barrier(); asm volatile("" ::: "memory"); } while (0)
__device__ __forceinline__ float bflo(unsigned u) { return __uint_as_float(u << 16); }
__device__ __forceinline__ float bfhi(unsigned u) { return __uint_as_float(u & 0xFFFF0000u); }

struct GlaPF { unsigned g[8], v[8], q[8]; };
template <bool OUT>
__device__ __forceinline__ void gla_prefetch(GlaPF& pf, const bf16_t* Z, int row0, int gcol  , int h, int tid) {
    const bf16_t* zr = Z + (size_t)(row0 + (tid >> 6) * 8) * 5120 + h * 128 + 2 * (tid & 63);
#pragma unroll
    for (int i = 0; i < 8; ++i) {
        pf.g[i] = *(const unsigned*)(zr + (size_t)i * 5120 + gcol);
        pf.v[i] = *(const unsigned*)(zr + (size_t)i * 5120 + 2048);
        if (OUT) pf.q[i] = *(const unsigned*)(zr + (size_t)i * 5120 + 3072);
    }
}

template <bool OUT, int D>
__device__ __forceinline__ void gla_chunk(LAS unsigned char* lds, bf16_t* Z, int row0, int h, f32x4 (&S)[8], float (&lastsum)[2], const float* gnorm,
                                          GlaPF& pf, bool has_next, int nrow0, int ngcol, int nh) {
    int tid_ = threadIdx.x; asm volatile("" : "+v"(tid_));
    const int tid = tid_, lane = tid & 63, w = __builtin_amdgcn_readfirstlane(tid >> 6);
    const int cp = lane, tg = w;
    const int l15 = lane & 15, lq = lane >> 4;
    LAS bf16_t* QT = (LAS bf16_t*)(lds + G_QT); LAS bf16_t* KT = (LAS bf16_t*)(lds + G_KT); LAS bf16_t* KTT = (LAS bf16_t*)(lds + G_KTT);
    LAS bf16_t* VTT = (LAS bf16_t*)(lds + G_VTT); LAS bf16_t* PP = (LAS bf16_t*)(lds + G_PP); LAS bf16_t* STT = (LAS bf16_t*)(lds + G_STT);
    LAS float* TOT = (LAS float*)(lds + G_TOT); LAS float* SSQ = (LAS float*)(lds + G_SSQ);
    float g0[8], g1[8], c0[8], c1[8];
#pragma unroll
    for (int i = 0; i < 8; ++i) { g0[i] = bflo(pf.g[i]); g1[i] = bfhi(pf.g[i]); }
    if (D == 0) { c0[0] = g0[0]; c1[0] = g1[0];
#pragma unroll
        for (int i = 1; i < 8; ++i) { c0[i] = c0[i - 1] + g0[i]; c1[i] = c1[i - 1] + g1[i]; }
        *(LAS f32x2*)(TOT + tg * 128 + 2 * cp) = (f32x2){c0[7], c1[7]};
    } else { c0[7] = g0[7]; c1[7] = g1[7];
#pragma unroll
        for (int i = 6; i >= 0; --i) { c0[i] = c0[i + 1] + g0[i]; c1[i] = c1[i + 1] + g1[i]; }
        *(LAS f32x2*)(TOT + tg * 128 + 2 * cp) = (f32x2){c0[0], c1[0]};
    }
    LBAR();
    {
        float pre0 = 0.f, pre1 = 0.f, ref0 = 0.f, ref1 = 0.f, all0 = 0.f, all1 = 0.f;
#pragma unroll
        for (int t = 0; t < 8; ++t) {
            const f32x2 tv = *(const LAS f32x2*)(TOT + t * 128 + 2 * cp);
            all0 += tv.x; all1 += tv.y;
            const bool inref = (D == 0) ? (t < 4) : (t >= 4);
            if (inref) { ref0 += tv.x; ref1 += tv.y; }
            const bool inpre = (D == 0) ? (t < tg) : (t > tg);
            pre0 += inpre ? tv.x : 0.f; pre1 += inpre ? tv.y : 0.f;
        }
        if (tg == 0) { lastsum[0] += all0; lastsum[1] += all1; }
        unsigned kp0[4], kp1[4], vp0[4], vp1[4];
#pragma unroll
        for (int i = 0; i < 8; i += 2) {
            float k0[2], k1[2];
#pragma unroll
            for (int u = 0; u < 2; ++u) {
                const int ii = i + u;
                const float cum0 = pre0 + c0[ii], cum1 = pre1 + c1[ii];
                k0[u] = (1.0f - __expf(g0[ii])) * __expf(ref0 - cum0);
                k1[u] = (1.0f - __expf(g1[ii])) * __expf(ref1 - cum1);
                const int t = tg * 8 + ii;
                if (OUT) {
                    const float q0 = bflo(pf.q[ii]) * __expf(cum0 - ref0), q1 = bfhi(pf.q[ii]) * __expf(cum1 - ref1);
                    *(LAS unsigned*)(QT + t * PQ + 2 * cp) = pk2(q0, q1);
                    *(LAS unsigned*)(KT + t * PQ + 2 * cp) = pk2(k0[u], k1[u]);
                }
            }
            kp0[i >> 1] = pk2(k0[0], k0[1]); kp1[i >> 1] = pk2(k1[0], k1[1]);
            vp0[i >> 1] = (pf.v[i] & 0xFFFFu) | (pf.v[i + 1] << 16); vp1[i >> 1] = (pf.v[i] >> 16) | (pf.v[i + 1] & 0xFFFF0000u);
        }
        *(LAS u32x4*)(KTT + (2 * cp) * PT + tg * 8) = (u32x4){kp0[0], kp0[1], kp0[2], kp0[3]};
        *(LAS u32x4*)(KTT + (2 * cp + 1) * PT + tg * 8) = (u32x4){kp1[0], kp1[1], kp1[2], kp1[3]};
        *(LAS u32x4*)(VTT + (2 * cp) * PT + tg * 8) = (u32x4){vp0[0], vp0[1], vp0[2], vp0[3]};
        *(LAS u32x4*)(VTT + (2 * cp + 1) * PT + tg * 8) = (u32x4){vp1[0], vp1[1], vp1[2], vp1[3]};
    }
    float el[4];
    {
        f32x4 rs = (f32x4){0.f, 0.f, 0.f, 0.f}, ls = (f32x4){0.f, 0.f, 0.f, 0.f};
#pragma unroll
        for (int t = 0; t < 8; ++t) {
            const f32x4 tv = *(const LAS f32x4*)(TOT + t * 128 + 16 * w + lq * 4);
            const bool inref = (D == 0) ? (t < 4) : (t >= 4);
            if (inref) rs += tv; else ls += tv;
        }
        float er[4];
#pragma unroll
        for (int j = 0; j < 4; ++j) { er[j] = __expf(rs[j]); el[j] = __expf(ls[j]); }
#pragma unroll
        for (int vt = 0; vt < 8; ++vt) {
#pragma unroll
            for (int j = 0; j < 4; ++j) S[vt][j] *= er[j];
            if (OUT) { u32x2 wv; wv.x = pk2(S[vt][0], S[vt][1]); wv.y = pk2(S[vt][2], S[vt][3]);
                *(LAS u32x2*)(STT + (16 * vt + l15) * PQ + 16 * w + lq * 4) = wv; }
        }
    }
    if (has_next) gla_prefetch<OUT>(pf, Z, nrow0, ngcol, nh, tid);
    const int rt = w & 3, vh = (w >> 2) * 4;
    bf16_t* zo = Z + (size_t)(row0 + 16 * rt + l15) * 5120 + h * 128 + 16 * vh + 4 * lq;
    u32x2 ofw[4], gat[4];
    if (OUT && D == 1) {
#pragma unroll
        for (int i = 0; i < 4; ++i) { ofw[i] = *(const u32x2*)(zo + 16 * i); gat[i] = *(const u32x2*)(zo + 4096 + 16 * i); }
    }
    LBAR();
    if (OUT) {
        const int st = w >> 1, ct0 = (w & 1) * 2;
#pragma unroll
        for (int i = 0; i < 2; ++i) {
            const int ct = ct0 + i;
            f32x4 a = (f32x4){0.f, 0.f, 0.f, 0.f};
            const bool zero = (D == 0) ? (st > ct) : (st < ct);
            if (!zero) {
#pragma unroll
                for (int ks = 0; ks < 4; ++ks) {
                    const bf16x8 fa = *(const LAS bf16x8*)(KT + (16 * st + l15) * PQ + ks * 32 + lq * 8);
                    const bf16x8 fb = *(const LAS bf16x8*)(QT + (16 * ct + l15) * PQ + ks * 32 + lq * 8);
                    a = mfma16(fa, fb, a);
                }
                const int cc = 16 * ct + l15;
#pragma unroll
                for (int j = 0; j < 4; ++j) { const int ss = 16 * st + lq * 4 + j; const bool keep = (D == 0) ? (ss <= cc) : (ss >= cc); a[j] = keep ? a[j] : 0.f; }
            }
            u32x2 wv; wv.x = pk2(a[0], a[1]); wv.y = pk2(a[2], a[3]);
            *(LAS u32x2*)(PP + (16 * ct + l15) * PT + 16 * st + lq * 4) = wv;
        }
    }
    {
        bf16x8 fa[2];
#pragma unroll
        for (int ks = 0; ks < 2; ++ks) fa[ks] = *(const LAS bf16x8*)(KTT + (16 * w + l15) * PT + ks * 32 + lq * 8);
#pragma unroll
        for (int vt = 0; vt < 8; ++vt) {
#pragma unroll
            for (int ks = 0; ks < 2; ++ks) {
                const bf16x8 fb = *(const LAS bf16x8*)(VTT + (16 * vt + l15) * PT + ks * 32 + lq * 8);
                S[vt] = mfma16(fa[ks], fb, S[vt]);
            }
#pragma unroll
            for (int j = 0; j < 4; ++j) S[vt][j] *= el[j];
        }
    }
    if (OUT) {
        LBAR();
        f32x4 o[4];
#pragma unroll
        for (int i = 0; i < 4; ++i) o[i] = (f32x4){0.f, 0.f, 0.f, 0.f};
#pragma unroll
        for (int ks = 0; ks < 2; ++ks) {
            const bf16x8 fb = *(const LAS bf16x8*)(PP + (16 * rt + l15) * PT + ks * 32 + lq * 8);
#pragma unroll
            for (int i = 0; i < 4; ++i) { const bf16x8 fa = *(const LAS bf16x8*)(VTT + (16 * (vh + i) + l15) * PT + ks * 32 + lq * 8); o[i] = mfma16(fa, fb, o[i]); }
        }
#pragma unroll
        for (int ks = 0; ks < 4; ++ks) {
            const bf16x8 fb = *(const LAS bf16x8*)(QT + (16 * rt + l15) * PQ + ks * 32 + lq * 8);
#pragma unroll
            for (int i = 0; i < 4; ++i) { const bf16x8 fa = *(const LAS bf16x8*)(STT + (16 * (vh + i) + l15) * PQ + ks * 32 + lq * 8); o[i] = mfma16(fa, fb, o[i]); }
        }
        if (D == 0) {
#pragma unroll
            for (int i = 0; i < 4; ++i) { u32x2 wv; wv.x = pk2(o[i][0], o[i][1]); wv.y = pk2(o[i][2], o[i][3]); *(u32x2*)(zo + 16 * i) = wv; }
        } else {
            float sq = 0.f;
#pragma unroll
            for (int i = 0; i < 4; ++i) {
                o[i][0] += bflo(ofw[i].x); o[i][1] += bfhi(ofw[i].x); o[i][2] += bflo(ofw[i].y); o[i][3] += bfhi(ofw[i].y);
                sq += o[i][0] * o[i][0] + o[i][1] * o[i][1] + o[i][2] * o[i][2] + o[i][3] * o[i][3];
            }
            sq += __shfl_xor(sq, 16); sq += __shfl_xor(sq, 32);
            if (lq == 0) SSQ[(w >> 2) * 64 + 16 * rt + l15] = sq;
            LBAR();
            const float rstd = rsqrtf((SSQ[16 * rt + l15] + SSQ[64 + 16 * rt + l15]) * (1.0f / 128.0f) + EPS);
#pragma unroll
            for (int i = 0; i < 4; ++i) {
                const f32x4 gn = *(const f32x4*)(gnorm + h * 128 + 16 * (vh + i) + 4 * lq);
                const float y0 = o[i][0] * rstd * gn[0] * bflo(gat[i].x), y1 = o[i][1] * rstd * gn[1] * bfhi(gat[i].x);
                const float y2 = o[i][2] * rstd * gn[2] * bflo(gat[i].y), y3 = o[i][3] * rstd * gn[3] * bfhi(gat[i].y);
                u32x2 wv; wv.x = pk2(y0, y1); wv.y = pk2(y2, y3);
                *(u32x2*)(zo + 1024 + 16 * i) = wv;
            }
        }
    }
}

__device__ __forceinline__ int sc_rowbase(int b, int jsc) { return jsc == 0 ? ML + b * CTXL : b * SEQ + (jsc - 1) * 256; }

__device__ __forceinline__ void phase_gla1(LAS unsigned char* lds, bf16_t* Z, float* Sbuf, float* Dbuf) {
    int tid_ = threadIdx.x; asm volatile("" : "+v"(tid_));
    const int tid = tid_, lane = tid & 63, w = __builtin_amdgcn_readfirstlane(tid >> 6);
    GlaPF pf;
    int task = blockIdx.x;
    if (task < 2048) {
        const int bhd = task >> 5, p = task & 31, b = bhd >> 4, h = (bhd >> 1) & 7, d = bhd & 1;
        const int jsc = (p == 0) ? 0 : (d == 0 ? p : 33 - p);
        gla_prefetch<false>(pf, Z, sc_rowbase(b, jsc) + (d ? 192 : 0), d * 1024, h, tid);
    }
    for (; task < 2048; task += gridDim.x) {
        const int bhd = task >> 5, p = task & 31, b = bhd >> 4, h = (bhd >> 1) & 7, d = bhd & 1;
        const int jsc = (p == 0) ? 0 : (d == 0 ? p : 33 - p);
        const int rb = sc_rowbase(b, jsc);
        const int nt = task + gridDim.x; const bool hn = nt < 2048;
        int nrow = 0, ngc = 0, nh = 0;
        if (hn) { const int nbhd = nt >> 5, np = nt & 31, nb = nbhd >> 4, nd = nbhd & 1; nh = (nbhd >> 1) & 7;
            const int nj = (np == 0) ? 0 : (nd == 0 ? np : 33 - np); nrow = sc_rowbase(nb, nj) + (nd ? 192 : 0); ngc = nd * 1024; }
        f32x4 S[8];
#pragma unroll
        for (int vt = 0; vt < 8; ++vt) S[vt] = (f32x4){0.f, 0.f, 0.f, 0.f};
        float lastsum[2] = {0.f, 0.f};
        if (d == 0) {
#pragma unroll 1
            for (int ci = 0; ci < 4; ++ci) { const bool last = ci == 3; gla_chunk<false, 0>(lds, Z, rb + ci * 64, h, S, lastsum, nullptr, pf, last ? hn : true, last ? nrow : rb + (ci + 1) * 64, last ? ngc : 0, last ? nh : h); }
        } else {
#pragma unroll 1
            for (int ci = 3; ci >= 0; --ci) { const bool last = ci == 0; gla_chunk<false, 1>(lds, Z, rb + ci * 64, h, S, lastsum, nullptr, pf, last ? hn : true, last ? nrow : rb + (ci - 1) * 64, last ? ngc : 1024, last ? nh : h); }
        }
        float* sp = Sbuf + (size_t)task * 16384;
#pragma unroll
        for (int vt = 0; vt < 8; ++vt)
#pragma unroll
            for (int j = 0; j < 4; ++j) sp[((w * 8 + vt) * 4 + j) * 64 + lane] = S[vt][j];
        if (tid < 64) *(f32x2*)(Dbuf + (size_t)task * 128 + 2 * tid) = (f32x2){__expf(lastsum[0]), __expf(lastsum[1])};
        LBAR();
    }
}
__device__ __forceinline__ void phase_gla2(float* Sbuf, const float* Dbuf) {
    int tid_ = threadIdx.x; asm volatile("" : "+v"(tid_));
    const int gt = blockIdx.x * 512 + tid_, nth = gridDim.x * 512;
    for (int idx = gt; idx < 64 * 4096; idx += nth) {
        const int bhd = idx >> 12, e4 = idx & 4095, e = e4 * 4;
        const int k = 16 * (e >> 11) + ((e & 63) >> 4) * 4 + ((e >> 6) & 3);
        f32x4 s = (f32x4){0.f, 0.f, 0.f, 0.f};
        f32x4* sp = (f32x4*)(Sbuf + (size_t)bhd * 32 * 16384) + e4;
        const float* dp = Dbuf + (size_t)bhd * 32 * 128 + k;
#pragma unroll 8
        for (int p = 0; p < 32; ++p) { const float dd = dp[p * 128]; const f32x4 a = sp[(size_t)p * 4096]; s = s * dd + a; sp[(size_t)p * 4096] = s; }
    }
}
__device__ __forceinline__ void phase_gla3(LAS unsigned char* lds, bf16_t* Z, const float* Sbuf, const float* gnorm, int with_ctx) {
    int tid_ = threadIdx.x; asm volatile("" : "+v"(tid_));
    const int tid = tid_, lane = tid & 63, w = __builtin_amdgcn_readfirstlane(tid >> 6);
    const int jlo = with_ctx ? 0 : 1, nj = 33 - jlo, ntask = 32 * nj;
    GlaPF pf;
    int task = blockIdx.x;
    if (task < ntask) { const int bh = task / nj, jsc = jlo + task % nj; gla_prefetch<true>(pf, Z, sc_rowbase(bh >> 3, jsc), 0, bh & 7, tid); }
    for (; task < ntask; task += gridDim.x) {
        const int bh = task / nj, jsc = jlo + task % nj, b = bh >> 3, h = bh & 7;
        const int rb = sc_rowbase(b, jsc);
        const int nt = task + gridDim.x; const bool hn = nt < ntask;
        int nrow = 0, nh = 0;
        if (hn) { const int nbh = nt / nj, njsc = jlo + nt % nj; nrow = sc_rowbase(nbh >> 3, njsc); nh = nbh & 7; }
        float dummy[2] = {0.f, 0.f};
        f32x4 S[8];
        {
            const int p = jsc;
            if (p == 0) {
#pragma unroll
                for (int vt = 0; vt < 8; ++vt) S[vt] = (f32x4){0.f, 0.f, 0.f, 0.f};
            } else {
                const float* sp = Sbuf + ((size_t)((bh * 2 + 0) * 32 + (p - 1))) * 16384;
#pragma unroll
                for (int vt = 0; vt < 8; ++vt)
#pragma unroll
                    for (int j = 0; j < 4; ++j) S[vt][j] = sp[((w * 8 + vt) * 4 + j) * 64 + lane];
            }
#pragma unroll 1
            for (int ci = 0; ci < 4; ++ci) { const bool last = ci == 3; gla_chunk<true, 0>(lds, Z, rb + ci * 64, h, S, dummy, gnorm, pf, true, last ? rb + 192 : rb + (ci + 1) * 64, last ? 1024 : 0, h); }
        }
        {
            const int p = (jsc == 0) ? 0 : 33 - jsc;
            if (p == 0) {
#pragma unroll
                for (int vt = 0; vt < 8; ++vt) S[vt] = (f32x4){0.f, 0.f, 0.f, 0.f};
            } else {
                const float* sp = Sbuf + ((size_t)((bh * 2 + 1) * 32 + (p - 1))) * 16384;
#pragma unroll
                for (int vt = 0; vt < 8; ++vt)
#pragma unroll
                    for (int j = 0; j < 4; ++j) S[vt][j] = sp[((w * 8 + vt) * 4 + j) * 64 + lane];
            }
            asm volatile("s_waitcnt vmcnt(0)" ::: "memory");
            __builtin_amdgcn_fence(__ATOMIC_ACQUIRE, "agent");
            LBAR();
#pragma unroll 1
            for (int ci = 3; ci >= 0; --ci) { const bool last = ci == 0; gla_chunk<true, 1>(lds, Z, rb + ci * 64, h, S, dummy, gnorm, pf, last ? hn : true, last ? nrow : rb + (ci - 1) * 64, last ? 0 : 1024, last ? nh : h); }
        }
        asm volatile("s_waitcnt vmcnt(0)" ::: "memory");
        LBAR();
    }
}


#define XB_TMO      128
#define XB_XCNT(j)  (256  + 64 * (j))
#define XB_XSUB(j)  (1280 + 64 * (j))
#define XB_XGEN(j)  (2304 + 64 * (j))
#define XB_TOP      3328
#define XB_TOPGEN   3392
#define XCD_BAR_WORDS 3456
#define XB_SPIN_CAP (1u << 22)
__device__ __forceinline__ unsigned xb_ld(unsigned* p)              { return __hip_atomic_load(p, __ATOMIC_RELAXED, __HIP_MEMORY_SCOPE_AGENT); }
__device__ __forceinline__ unsigned xb_add(unsigned* p, unsigned v) { return __hip_atomic_fetch_add(p, v, __ATOMIC_RELAXED, __HIP_MEMORY_SCOPE_AGENT); }
__device__ __forceinline__ unsigned xb_xcc_id() { return (unsigned)__builtin_amdgcn_s_getreg((3 << 11) | 20) & 0xFu; }
#define XB_SPIN(cond, bar) do { unsigned _sp = 0; while (cond) { __builtin_amdgcn_s_sleep(1); \
    if ((++_sp & 255u) == 0u) { if (xb_ld(&(bar)[XB_TMO])) break; if (_sp > XB_SPIN_CAP) { atomicAdd(&(bar)[XB_TMO], 1u); break; } } } } while (0)
struct XcdBarrier { unsigned* bar; unsigned x; volatile LAS unsigned* st; };
__device__ __forceinline__ XcdBarrier xcd_barrier_post(unsigned* bar, volatile LAS unsigned* st) {
    XcdBarrier b; b.bar = bar; b.x = xb_xcc_id(); b.st = st;
    if (threadIdx.x == 0) (void)xb_add(&bar[XB_XCNT(b.x)], 1u);
    return b;
}
__device__ __forceinline__ void xcd_barrier_complete(unsigned* bar, unsigned x, unsigned& nloc, unsigned& nx) {
    const unsigned G = gridDim.x * gridDim.y * gridDim.z;
    unsigned sum, cnt, mine, sp = 0u;
    for (;;) {
        sum = 0u; cnt = 0u; mine = 0u;
#pragma unroll
        for (unsigned j = 0; j < 16; ++j) { const unsigned c = xb_ld(&bar[XB_XCNT(j)]); sum += c; cnt += (c > 0u) ? 1u : 0u; mine = (j == x) ? c : mine; }
        if (sum == G) break;
        __builtin_amdgcn_s_sleep(1);
        if ((++sp & 255u) == 0u) { if (xb_ld(&bar[XB_TMO])) break; if (sp > XB_SPIN_CAP) { atomicAdd(&bar[XB_TMO], 1u); break; } }
    }
    nloc = mine > 0u ? mine : 1u; nx = cnt > 0u ? cnt : 1u;
}
__device__ __forceinline__ void xcd_barrier(const XcdBarrier& b) {
    asm volatile("s_waitcnt vmcnt(0)" ::: "memory");
    __syncthreads();
    if (threadIdx.x == 0) {
        unsigned* bar = b.bar;
        __builtin_amdgcn_s_waitcnt(0);
        unsigned nloc = b.st[0], nx = b.st[1];
        if (nloc == 0u) { xcd_barrier_complete(bar, b.x, nloc, nx); b.st[0] = nloc; b.st[1] = nx; }
        const unsigned old = xb_add(&bar[XB_XSUB(b.x)], 1u);
        const unsigned gen = old / nloc;
        if (old + 1u == (gen + 1u) * nloc) {
            __builtin_amdgcn_fence(__ATOMIC_RELEASE, "agent");
            asm volatile("s_waitcnt vmcnt(0)" ::: "memory");
            const unsigned og = xb_add(&bar[XB_TOP], 1u);
            const unsigned tg = og / nx;
            if (og + 1u == (tg + 1u) * nx) xb_add(&bar[XB_TOPGEN], 1u);
            else XB_SPIN(xb_ld(&bar[XB_TOPGEN]) == tg, bar);
            __builtin_amdgcn_fence(__ATOMIC_ACQUIRE, "agent");
            xb_add(&bar[XB_XGEN(b.x)], 1u);
            asm volatile("s_waitcnt vmcnt(0)" ::: "memory");
        } else {
            XB_SPIN(xb_ld(&bar[XB_XGEN(b.x)]) == gen, bar);
            __builtin_amdgcn_fence(__ATOMIC_ACQUIRE, "agent");
            asm volatile("s_waitcnt vmcnt(0)" ::: "memory");
        }
    }
    __syncthreads();
}

__global__ void __launch_bounds__(512, 2) mega_fwd(Params p) {
    extern __shared__ __attribute__((aligned(16))) unsigned char lds_raw[];
    LAS unsigned char* lds = (LAS unsigned char*)lds_raw;
    cg::grid_group grid = cg::this_grid();
    unsigned char* ws = p.ws;
    float* X = (float*)(ws + WS_X); bf16_t* Z = (bf16_t*)(ws + WS_Z);
    bf16_t* Win_t = (bf16_t*)(ws + WS_WIN); bf16_t* Wout_t = (bf16_t*)(ws + WS_WOUT); bf16_t* W1_t = (bf16_t*)(ws + WS_W1); bf16_t* W2_t = (bf16_t*)(ws + WS_W2);
    float* Dbuf = (float*)(ws + WS_DB); float* mods = (float*)(ws + WS_MOD); float* lbv = (float*)(ws + WS_LB);
    bf16_t* HA = (bf16_t*)p.out;
    float* Sbuf = p.out;
    const int G = gridDim.x, bx = blockIdx.x;

    volatile LAS unsigned* xst = (volatile LAS unsigned*)(lds + LDS_MAIN);
    if (threadIdx.x == 0) { xst[0] = 0u; xst[1] = 0u; }
    __syncthreads();
    const XcdBarrier xbar = xcd_barrier_post((unsigned*)(ws + WS_BAR), xst);
    phase_ada(p, lds, mods, lbv);
    grid.sync();

#pragma unroll 1
    for (int L = 0; L < 4; ++L) {
        const bool rec = (L & 1) == 0; const int j = L >> 1;
        const float* modL = mods + (size_t)L * 5 * 6144;
        const int Mmix_in = (L < 3) ? MT : ML;
        const int Mlive = (L < 2) ? MT : ML;
#pragma unroll 1
        for (int s = 0; s < 2; ++s) {
            if (s == 0) phase_cvt(p, lds, L);
            {
                const float* srcL = (L == 0 && s == 0) ? p.in[0] : X;
                const float* srcC = (L == 0 && s == 0) ? p.in[2] : X + (size_t)ML * DM;
                const float* gain = (s == 0 ? p.in[6] : p.in[7]) + L * 1024;
                phase_norm(srcL, srcC, s == 0 ? Mmix_in : Mlive, gain, modL, s == 0 ? 0 : 3 * 1024, s == 0 ? 1024 : 4 * 1024, HA);
            }
            xcd_barrier(xbar);
            pg8::Gemm g; const float* gate; const float* resL; const float* resC;
            if (s == 0) {
                if (rec) {
                    { pg8::Gemm gi{HA, Win_t, Mmix_in, 5120, 1024, 1024}; pg8::StaticOrder S; S.init(gi.M, gi.N, G, bx);
                      EpiHgrnIn E{Z, lbv + (size_t)j * 2048}; pg8::gemm_phase<EpiHgrnIn>(lds, gi, S, E); }
                    xcd_barrier(xbar);
                    phase_gla1(lds, Z, Sbuf, Dbuf);
                    xcd_barrier(xbar);
                    phase_gla2(Sbuf, Dbuf);
                    xcd_barrier(xbar);
                    phase_gla3(lds, Z, Sbuf, p.in[13] + j * 1024, L < 2 ? 1 : 0);
                    xcd_barrier(xbar);
                    g = pg8::Gemm{Z + 1024, Wout_t, Mlive, 1024, 1024, 5120};
                } else {
                    { pg8::Gemm gi{HA, Win_t, Mmix_in, 3072, 1024, 1024}; pg8::StaticOrder S; S.init(gi.M, gi.N, G, bx);
                      EpiConvIn E{Z}; pg8::gemm_phase<EpiConvIn>(lds, gi, S, E); }
                    xcd_barrier(xbar);
                    phase_conv(Z, p.in[16] + (size_t)j * 3 * 1024, p.in[17] + j * 1024, j & 1, Mlive, HA);
                    xcd_barrier(xbar);
                    g = pg8::Gemm{HA, Wout_t, Mlive, 1024, 1024, 1024};
                }
                gate = modL + 2 * 1024;
                resL = (L == 0) ? p.in[0] : X; resC = (L == 0) ? p.in[2] : X + (size_t)ML * DM;
            } else {
                { pg8::Gemm gi{HA, W1_t, Mlive, 4096, 1024, 1024}; pg8::StaticOrder S; S.init(gi.M, gi.N, G, bx);
                  EpiRelu2 E{Z}; pg8::gemm_phase<EpiRelu2>(lds, gi, S, E); }
                xcd_barrier(xbar);
                g = pg8::Gemm{Z, W2_t, Mlive, 1024, 4096, 4096};
                gate = modL + 5 * 1024;
                resL = X; resC = X + (size_t)ML * DM;
            }
            { pg8::StaticOrder S; S.init(g.M, g.N, G, bx); EpiResid E{X, resL, resC, gate}; pg8::gemm_phase<EpiResid>(lds, g, S, E); }
            xcd_barrier(xbar);
        }
    }
    phase_final(X, p.in[8], p.out);
}

extern "C" void kernel_launch(void* const* d_in, const int* in_sizes, int n_in, void* d_out, int out_size, void* d_ws, size_t ws_size, hipStream_t stream) {
    static int grid = 0;
    if (grid == 0) {
        if (n_in != 19 || out_size != ML * DM || ws_size < WS_END) { fprintf(stderr, "kernel_launch: unexpected shapes / workspace (n_in %d out %d ws %zu need %zu)\n", n_in, out_size, ws_size, (size_t)WS_END); grid = -1; return; }
        int dev = 0, cus = 0, per_cu = 0;
        if (hipGetDevice(&dev) != hipSuccess || hipDeviceGetAttribute(&cus, hipDeviceAttributeMultiprocessorCount, dev) != hipSuccess) { grid = -1; return; }
        if (hipFuncSetAttribute((const void*)mega_fwd, hipFuncAttributeMaxDynamicSharedMemorySize, LDS_BYTES) != hipSuccess) { fprintf(stderr, "kernel_launch: hipFuncSetAttribute failed\n"); grid = -1; return; }
        if (hipOccupancyMaxActiveBlocksPerMultiprocessor(&per_cu, (const void*)mega_fwd, 512, LDS_BYTES) != hipSuccess || per_cu < 1) { fprintf(stderr, "kernel_launch: occupancy query failed (%d)\n", per_cu); per_cu = 1; (void)hipGetLastError(); }
        grid = cus * per_cu;
    }
    if (grid < 0) return;
    if (hipMemsetAsync((char*)d_ws + WS_BAR, 0, XCD_BAR_WORDS * 4, stream) != hipSuccess) { fprintf(stderr, "kernel_launch: memset failed\n"); return; }
    Params p{};
    for (int i = 0; i < 19; ++i) p.in[i] = (const float*)d_in[i];
    p.out = (float*)d_out; p.ws = (unsigned char*)d_ws;
    void* args[] = {&p};
    hipError_t e = hipLaunchCooperativeKernel((const void*)mega_fwd, dim3(grid), dim3(512), args, LDS_BYTES, stream);
    if (e != hipSuccess) fprintf(stderr, "cooperative launch failed: %s (grid %d)\n", hipGetErrorString(e), grid);
}
```

```cpp
#include <hip/hip_runtime.h>
#include <hip/hip_cooperative_groups.h>
#include <cstdio>
namespace cg = cooperative_groups;

#define LAS __attribute__((address_space(3)))
typedef unsigned short bf16_t;
typedef short bf16x8 __attribute__((ext_vector_type(8)));
typedef float f32x4 __attribute__((ext_vector_type(4)));
typedef unsigned u32x4 __attribute__((ext_vector_type(4)));
typedef unsigned u32x2 __attribute__((ext_vector_type(2)));
typedef float f32x2 __attribute__((ext_vector_type(2)));

constexpr int DM = 1024, NB = 4, SEQ = 8192, CTXL = 256, DFF = 4096;
constexpr int ML = NB * SEQ;
constexpr int MC = NB * CTXL;
constexpr int MT = ML + MC;
constexpr float EPS = 1e-6f;

constexpr size_t WS_X = 0;
constexpr size_t WS_Z = WS_X + (size_t)MT * DM * 4;
constexpr size_t WS_WIN = WS_Z + (size_t)MT * 5120 * 2;
constexpr size_t WS_WOUT = WS_WIN + (size_t)5120 * 1024 * 2;
constexpr size_t WS_W1 = WS_WOUT + (size_t)1024 * 1024 * 2;
constexpr size_t WS_W2 = WS_W1 + (size_t)4096 * 1024 * 2;
constexpr size_t WS_DB = WS_W2 + (size_t)4096 * 1024 * 2;
constexpr size_t WS_MOD = WS_DB + (size_t)2048 * 128 * 4;
constexpr size_t WS_LB = WS_MOD + (size_t)4 * 5 * 6144 * 4;
constexpr size_t WS_BAR = WS_LB + (size_t)2 * 2 * 1024 * 4;
constexpr size_t WS_P = WS_BAR + (size_t)3456 * 4 + 128;
constexpr size_t WS_END = WS_P + (size_t)4 * 1024 * 1024 * 4;

constexpr int LDS_MAIN = 131072;
constexpr int LDS_BYTES = LDS_MAIN + 16;

struct Params { const float* in[19]; float* out; unsigned char* ws; };

__device__ __forceinline__ float bf2f(bf16_t b) { return __uint_as_float(((unsigned)b) << 16); }
__device__ __forceinline__ bf16_t f2bf(float f) { unsigned u = __float_as_uint(f); u += 0x7FFFu + ((u >> 16) & 1u); return (bf16_t)(u >> 16); }
typedef __bf16 bf16v2_t __attribute__((ext_vector_type(2)));
__device__ __forceinline__ unsigned pk2(float lo, float hi) { const f32x2 v = {lo, hi}; const bf16v2_t r = __builtin_convertvector(v, bf16v2_t); return __builtin_bit_cast(unsigned, r); }
__device__ __forceinline__ float sigmoidf_(float z) { return __builtin_amdgcn_rcpf(1.0f + __expf(-z)); }
__device__ __forceinline__ float siluf_(float z) { return z * __builtin_amdgcn_rcpf(1.0f + __expf(-z)); }

namespace pg8 {
constexpr int BM = 256, BK = 64, HALF = 128, HTB = HALF * BK * 2, NXCD = 8, WGM = 8;
__device__ __forceinline__ int lds_byte(int r, int c) { const int st = (r >> 4) * 2 + (c >> 5), rr = r & 15, cc = c & 31, ob = rr * 64 + cc * 2; return st * 1024 + (ob ^ (((ob >> 9) & 1) << 5)); }
__device__ __forceinline__ void stage_rc(int b, int& R, int& C) { const int st = b / 1024, sb = b % 1024, swz = sb ^ (((sb >> 9) & 1) << 5); R = (st >> 1) * 16 + swz / 64; C = (st & 1) * 32 + (swz % 64) / 2; }
__device__ __forceinline__ int perm32(int rho) { const int n = rho >> 4, i = rho & 15; return 8 * (i >> 2) + 4 * n + (i & 3); }

struct Unit { int pm, pn, ks, nt; };
struct Gemm { const bf16_t* A; const bf16_t* Bt; int M, N, K, lda, ldb; };

struct StaticOrder {
    int nM, nN, nwg, G, c, ntk, nctx, ksb;
    __device__ void init(int M, int N, int K, int G_, int c_, int nctx_ = 0) { nM = M / BM; nN = N / BM; nwg = nM * nN; G = G_; c = c_; ntk = K / BK; nctx = nctx_; ksb = (K / 4) * 2; }
    __device__ bool next(int i, Unit& u) const {
        const long L = (long)i * G + c;
        if (L >= nwg) {
            const int t = (int)(L - nwg); if (t >= nctx) return false;
            u.ks = t >> 4; u.pm = 128 + ((t & 15) >> 2); u.pn = t & 3; u.nt = ntk >> 2; return true;
        }
        int wgid = (int)L; { const int q = nwg / NXCD, r = nwg % NXCD, xcd = wgid % NXCD, off = wgid / NXCD; wgid = (xcd < r ? xcd * (q + 1) : r * (q + 1) + (xcd - r) * q) + off; }
        const int nig = WGM * nN, gid = wgid / nig, fm = gid * WGM, gsz = (nM - fm) < WGM ? (nM - fm) : WGM;
        u.pm = fm + ((wgid % nig) % gsz); u.pn = (wgid % nig) / gsz; u.ks = 0; u.nt = ntk; return true;
    }
};

template <class Epi, class Sched>
__device__ __forceinline__ void gemm_phase(LAS unsigned char* lds, const Gemm g, const Sched& S, const Epi& E) {
    int tid_ = threadIdx.x; asm volatile("" : "+v"(tid_));
    const int tid = tid_, wid = __builtin_amdgcn_readfirstlane(tid >> 6), lane = tid & 63, wr = wid >> 2, wc = wid & 3, fr = lane & 15, fq = lane >> 4;
    const int lda = g.lda, ldb = g.ldb;
    unsigned voffA[2], voffB[2];
#pragma unroll
    for (int i = 0; i < 2; ++i) { int R, C; stage_rc(tid * 16 + i * 8192, R, C); const int Rb = Epi::PERM ? ((R & ~31) + perm32(R & 31)) : R;
        voffA[i] = (unsigned)(R * lda + C) * 2u; voffB[i] = (unsigned)(Rb * ldb + C) * 2u; }
    const size_t kstep = (size_t)(BK * 2);
    const size_t hstepA = (size_t)HALF * lda * 2, hstepB = (size_t)HALF * ldb * 2;
    const size_t ksb = (size_t)S.ksb;
    const size_t tstepA = 2 * hstepA, tstepB = 2 * hstepB;
    const unsigned ldsw = (unsigned)wid * 1024u;
    const int aoff = lds_byte(wr * 64 + fr, fq * 8), boff = lds_byte(wc * 32 + fr, fq * 8);
#define PG8_SA(b, h) (((b) * 2 + (h)) * HTB)
#define PG8_SB(b, h) ((4 + (b) * 2 + (h)) * HTB)
#define PG8_STAGE(bufoff, gbase, voff) do { _Pragma("unroll") for (int _i = 0; _i < 2; ++_i) \
        __builtin_amdgcn_global_load_lds((const unsigned*)((const char*)(gbase) + (voff)[_i]), (LAS unsigned*)(lds + (bufoff) + ldsw + _i * 8192), 16, 0, 0); } while (0)
#define PG8_LDA(dst, b, h) do { _Pragma("unroll") for (int m = 0; m < 4; ++m) _Pragma("unroll") for (int k = 0; k < 2; ++k) dst[m][k] = *(const LAS bf16x8*)(lds + PG8_SA(b, h) + aoff + m * 2048 + k * 1024); } while (0)
#define PG8_LDB(dst, b, h) do { _Pragma("unroll") for (int n = 0; n < 2; ++n) _Pragma("unroll") for (int k = 0; k < 2; ++k) dst[n][k] = *(const LAS bf16x8*)(lds + PG8_SB(b, h) + boff + n * 2048 + k * 1024); } while (0)
#define PG8_MMA(ai, bj, At, Bt) do { __builtin_amdgcn_s_setprio(1); _Pragma("unroll") for (int m = 0; m < 4; ++m) _Pragma("unroll") for (int n = 0; n < 2; ++n) _Pragma("unroll") for (int k = 0; k < 2; ++k) \
        acc[ai][bj][m][n] = __builtin_amdgcn_mfma_f32_16x16x32_bf16(Bt[n][k], At[m][k], acc[ai][bj][m][n], 0, 0, 0); __builtin_amdgcn_s_setprio(0); } while (0)
#define PG8_WAIT_V(n) asm volatile("s_waitcnt vmcnt(" #n ")" ::: "memory")
#define PG8_WAIT_L(n) asm volatile("s_waitcnt lgkmcnt(" #n ")" ::: "memory")
#define PG8_BAR __builtin_amdgcn_s_barrier()
#define PG8_SCHED __builtin_amdgcn_sched_barrier(0)
    Unit cur, nxt; int ui = 0;
    if (!S.next(0, cur)) return;
    f32x4 acc[2][2][4][2];
#pragma unroll
    for (int a = 0; a < 2; ++a)
#pragma unroll
        for (int b = 0; b < 2; ++b)
#pragma unroll
            for (int m = 0; m < 4; ++m)
#pragma unroll
                for (int n = 0; n < 2; ++n) acc[a][b][m][n] = (f32x4){0.f, 0.f, 0.f, 0.f};
    bf16x8 At[4][2], B0[2][2], B1[2][2];
    const char* cA = (const char*)g.A + (size_t)cur.pm * tstepA + (size_t)cur.ks * ksb; const char* cB = (const char*)g.Bt + (size_t)cur.pn * tstepB + (size_t)cur.ks * ksb;
    PG8_STAGE(PG8_SB(0, 0), cB, voffB); PG8_STAGE(PG8_SA(0, 0), cA, voffA); PG8_STAGE(PG8_SB(0, 1), cB + hstepB, voffB); PG8_STAGE(PG8_SA(0, 1), cA + hstepA, voffA);
    if (wr == 1) PG8_BAR;
    PG8_WAIT_V(4); PG8_BAR;
    PG8_STAGE(PG8_SB(1, 0), cB + kstep, voffB); PG8_STAGE(PG8_SA(1, 0), cA + kstep, voffA); PG8_STAGE(PG8_SB(1, 1), cB + hstepB + kstep, voffB);
    PG8_WAIT_V(6); PG8_BAR;
    for (;;) {
        const bool has_next = S.next(ui + 1, nxt);
        const char* nA = has_next ? (const char*)g.A + (size_t)nxt.pm * tstepA + (size_t)nxt.ks * ksb : cA; const char* nB = has_next ? (const char*)g.Bt + (size_t)nxt.pn * tstepB + (size_t)nxt.ks * ksb : cB;
        const int nt = cur.nt;
        for (int t = 0; t < nt; t += 2) {
            const bool last = (t == nt - 2);
            const char* a1 = cA + (size_t)(t + 1) * kstep;
            const char* a2 = last ? nA : cA + (size_t)(t + 2) * kstep; const char* b2 = last ? nB : cB + (size_t)(t + 2) * kstep;
            const char* a3 = a2 + kstep; const char* b3 = b2 + kstep;
            PG8_LDB(B0, 0, 0); PG8_SCHED; PG8_LDA(At, 0, 0); PG8_STAGE(PG8_SA(1, 1), a1 + hstepA, voffA);
            PG8_WAIT_L(8); PG8_BAR; PG8_WAIT_L(0); PG8_MMA(0, 0, At, B0); PG8_BAR; PG8_SCHED;
            PG8_LDB(B1, 0, 1); PG8_STAGE(PG8_SB(0, 0), b2, voffB);
            PG8_BAR; PG8_WAIT_L(0); PG8_MMA(0, 1, At, B1); PG8_BAR;
            PG8_LDA(At, 0, 1); PG8_STAGE(PG8_SA(0, 0), a2, voffA);
            PG8_BAR; PG8_WAIT_L(0); PG8_MMA(1, 0, At, B0); PG8_BAR; PG8_SCHED;
            PG8_STAGE(PG8_SB(0, 1), b2 + hstepB, voffB);
            PG8_WAIT_V(6); PG8_BAR; PG8_MMA(1, 1, At, B1); PG8_BAR;
            PG8_LDB(B0, 1, 0); PG8_SCHED; PG8_LDA(At, 1, 0); PG8_STAGE(PG8_SA(0, 1), a2 + hstepA, voffA);
            PG8_WAIT_L(8); PG8_BAR; PG8_WAIT_L(0); PG8_MMA(0, 0, At, B0); PG8_BAR; PG8_SCHED;
            PG8_LDB(B1, 1, 1); PG8_STAGE(PG8_SB(1, 0), b3, voffB);
            PG8_BAR; PG8_WAIT_L(0); PG8_MMA(0, 1, At, B1); PG8_BAR;
            PG8_LDA(At, 1, 1); PG8_STAGE(PG8_SA(1, 0), a3, voffA);
            PG8_BAR; PG8_WAIT_L(0); PG8_MMA(1, 0, At, B0); PG8_BAR; PG8_SCHED;
            PG8_STAGE(PG8_SB(1, 1), b3 + hstepB, voffB);
            PG8_WAIT_V(6); PG8_BAR; PG8_MMA(1, 1, At, B1); PG8_BAR;
        }
        E(acc, cur, wr, wc, fr, fq);
        if (!has_next) break;
#pragma unroll
        for (int a = 0; a < 2; ++a)
#pragma unroll
            for (int b = 0; b < 2; ++b)
#pragma unroll
                for (int m = 0; m < 4; ++m)
#pragma unroll
                    for (int n = 0; n < 2; ++n) acc[a][b][m][n] = (f32x4){0.f, 0.f, 0.f, 0.f};
        cur = nxt; cA = nA; cB = nB; ++ui;
    }
    PG8_WAIT_V(0);
    if (wr == 0) PG8_BAR;
    PG8_BAR;
#undef PG8_SA
#undef PG8_SB
#undef PG8_STAGE
#undef PG8_LDA
#undef PG8_LDB
#undef PG8_MMA
#undef PG8_WAIT_V
#undef PG8_WAIT_L
#undef PG8_BAR
#undef PG8_SCHED
}
}

struct EpiHgrnIn {
    static constexpr bool PERM = true;
    bf16_t* Z; const float* lbv;
    __device__ __forceinline__ void operator()(const f32x4 (&acc)[2][2][4][2], const pg8::Unit& u, int wr, int wc, int fr, int fq) const {
        const int part = u.pn >> 2;
        const int row0 = u.pm * 256 + wr * 64 + fr, col0 = u.pn * 256 + wc * 32 + 8 * fq;
        f32x4 lb[2][2];
#pragma unroll
        for (int bj = 0; bj < 2; ++bj)
#pragma unroll
            for (int n = 0; n < 2; ++n) lb[bj][n] = (part < 2) ? *(const f32x4*)(lbv + col0 + bj * 128 + 4 * n) : (f32x4){0.f, 0.f, 0.f, 0.f};
#pragma unroll
        for (int ai = 0; ai < 2; ++ai)
#pragma unroll
            for (int m = 0; m < 4; ++m) {
                bf16_t* rowp = Z + (size_t)(row0 + ai * 128 + m * 16) * 5120 + col0;
#pragma unroll
                for (int bj = 0; bj < 2; ++bj) {
                    float o[8];
#pragma unroll
                    for (int n = 0; n < 2; ++n)
#pragma unroll
                        for (int j = 0; j < 4; ++j) {
                            const float z = acc[ai][bj][m][n][j]; float r;
                            if (part < 2) { const float l = lb[bj][n][j]; const float f = l + (1.0f - l) * sigmoidf_(z); r = __logf(fmaxf(f, 1e-30f)); }
                            else if (part == 2) r = z;
                            else r = siluf_(z);
                            o[n * 4 + j] = r;
                        }
                    u32x4 w; w.x = pk2(o[0], o[1]); w.y = pk2(o[2], o[3]); w.z = pk2(o[4], o[5]); w.w = pk2(o[6], o[7]);
                    *(u32x4*)(rowp + bj * 128) = w;
                }
            }
    }
};
struct EpiConvIn {
    static constexpr bool PERM = true;
    bf16_t* Z;
    __device__ __forceinline__ void operator()(const f32x4 (&acc)[2][2][4][2], const pg8::Unit& u, int wr, int wc, int fr, int fq) const {
        const int row0 = u.pm * 256 + wr * 64 + fr;
        if (u.pn < 4) {
            const int col0 = u.pn * 256 + wc * 32 + 8 * fq;
#pragma unroll
            for (int ai = 0; ai < 2; ++ai)
#pragma unroll
                for (int m = 0; m < 4; ++m) {
                    bf16_t* rowp = Z + (size_t)(row0 + ai * 128 + m * 16) * 2048 + col0;
#pragma unroll
                    for (int bj = 0; bj < 2; ++bj) {
                        const f32x4 v0 = acc[ai][bj][m][0], v1 = acc[ai][bj][m][1];
                        u32x4 w; w.x = pk2(v0[0], v0[1]); w.y = pk2(v0[2], v0[3]); w.z = pk2(v1[0], v1[1]); w.w = pk2(v1[2], v1[3]);
                        *(u32x4*)(rowp + bj * 128) = w;
                    }
                }
        } else {
            const int col0 = 1024 + (u.pn - 4) * 128 + wc * 32 + 8 * fq;
#pragma unroll
            for (int ai = 0; ai < 2; ++ai)
#pragma unroll
                for (int m = 0; m < 4; ++m) {
                    bf16_t* rowp = Z + (size_t)(row0 + ai * 128 + m * 16) * 2048 + col0;
                    const f32x4 v0 = acc[ai][0][m][0] * acc[ai][1][m][0], v1 = acc[ai][0][m][1] * acc[ai][1][m][1];
                    u32x4 w; w.x = pk2(v0[0], v0[1]); w.y = pk2(v0[2], v0[3]); w.z = pk2(v1[0], v1[1]); w.w = pk2(v1[2], v1[3]);
                    *(u32x4*)rowp = w;
                }
        }
    }
};
struct EpiRelu2 {
    static constexpr bool PERM = true;
    bf16_t* Z;
    __device__ __forceinline__ void operator()(const f32x4 (&acc)[2][2][4][2], const pg8::Unit& u, int wr, int wc, int fr, int fq) const {
        const int row0 = u.pm * 256 + wr * 64 + fr, col0 = u.pn * 256 + wc * 32 + 8 * fq;
#pragma unroll
        for (int ai = 0; ai < 2; ++ai)
#pragma unroll
            for (int m = 0; m < 4; ++m) {
                bf16_t* rowp = Z + (size_t)(row0 + ai * 128 + m * 16) * 4096 + col0;
#pragma unroll
                for (int bj = 0; bj < 2; ++bj) {
                    float o[8];
#pragma unroll
                    for (int n = 0; n < 2; ++n)
#pragma unroll
                        for (int j = 0; j < 4; ++j) { const float z = fmaxf(acc[ai][bj][m][n][j], 0.f); o[n * 4 + j] = z * z; }
                    u32x4 w; w.x = pk2(o[0], o[1]); w.y = pk2(o[2], o[3]); w.z = pk2(o[4], o[5]); w.w = pk2(o[6], o[7]);
                    *(u32x4*)(rowp + bj * 128) = w;
                }
            }
    }
};
struct EpiCtxPartial {
    static constexpr bool PERM = false;
    float* P;
    __device__ __forceinline__ void operator()(const f32x4 (&acc)[2][2][4][2], const pg8::Unit& u, int wr, int wc, int fr, int fq) const {
        const int row0 = (u.pm - 128) * 256 + wr * 64 + fr, col0 = u.pn * 256 + wc * 32 + 4 * fq;
        float* pp0 = P + ((size_t)u.ks * 1024 + row0) * DM + col0;
#pragma unroll
        for (int ai = 0; ai < 2; ++ai)
#pragma unroll
            for (int m = 0; m < 4; ++m) {
                float* pp = pp0 + (size_t)(ai * 128 + m * 16) * DM;
#pragma unroll
                for (int bj = 0; bj < 2; ++bj)
#pragma unroll
                    for (int n = 0; n < 2; ++n) *(f32x4*)(pp + bj * 128 + n * 16) = acc[ai][bj][m][n];
            }
    }
};
struct EpiResid {
    static constexpr bool PERM = false;
    float* X; const float* resL; const float* resC; const float* gate; float* P;
    __device__ __forceinline__ void operator()(const f32x4 (&acc)[2][2][4][2], const pg8::Unit& u, int wr, int wc, int fr, int fq) const {
        if (u.pm >= 128) { EpiCtxPartial EP{P}; EP(acc, u, wr, wc, fr, fq); return; }
        const int row0 = u.pm * 256 + wr * 64 + fr, col0 = u.pn * 256 + wc * 32 + 4 * fq;
        const int bb = u.pm >> 5;
        const float* gp = gate + (size_t)bb * 6144 + col0;
        f32x4 gv[2][2];
#pragma unroll
        for (int bj = 0; bj < 2; ++bj)
#pragma unroll
            for (int n = 0; n < 2; ++n) gv[bj][n] = *(const f32x4*)(gp + bj * 128 + n * 16);
#pragma unroll
        for (int ai = 0; ai < 2; ++ai)
#pragma unroll
            for (int m = 0; m < 4; ++m) {
                const int row = row0 + ai * 128 + m * 16;
                const float* rp = (row < ML ? resL + (size_t)row * DM : resC + (size_t)(row - ML) * DM) + col0;
                float* xp = X + (size_t)row * DM + col0;
#pragma unroll
                for (int bj = 0; bj < 2; ++bj)
#pragma unroll
                    for (int n = 0; n < 2; ++n) {
                        const f32x4 r = *(const f32x4*)(rp + bj * 128 + n * 16);
                        *(f32x4*)(xp + bj * 128 + n * 16) = r + gv[bj][n] * acc[ai][bj][m][n];
                    }
            }
    }
};

__device__ __forceinline__ void phase_ada(const Params& p, LAS unsigned char* lds, float* mods, float* lbv) {
    int tid_ = threadIdx.x; asm volatile("" : "+v"(tid_)); const int tid = tid_;
    LAS float* s = (LAS float*)lds;
    LAS float* red = s + 5 * 1024;
    const float* c = p.in[1]; const float* cc = p.in[3];
    for (int i = tid; i < 5 * 1024; i += 512) { const int bb = i >> 10, k = i & 1023; const float v = bb < 4 ? c[bb * 1024 + k] : cc[k]; s[i] = siluf_(v); }
    __syncthreads();
    const int col = tid & 63, ks = tid >> 6;
    for (int item = blockIdx.x; item < 4 * 96; item += gridDim.x) {
        const int l = item / 96, n0 = (item % 96) * 64;
        const float* W = p.in[4] + (size_t)l * 1024 * 6144 + n0 + col;
        float a0 = 0.f, a1 = 0.f, a2 = 0.f, a3 = 0.f, a4 = 0.f;
#pragma unroll 8
        for (int k = ks * 128; k < ks * 128 + 128; ++k) {
            const float w = W[(size_t)k * 6144];
            a0 += s[k] * w; a1 += s[1024 + k] * w; a2 += s[2048 + k] * w; a3 += s[3072 + k] * w; a4 += s[4096 + k] * w;
        }
        red[(ks * 5 + 0) * 64 + col] = a0; red[(ks * 5 + 1) * 64 + col] = a1; red[(ks * 5 + 2) * 64 + col] = a2; red[(ks * 5 + 3) * 64 + col] = a3; red[(ks * 5 + 4) * 64 + col] = a4;
        __syncthreads();
        if (tid < 320) {
            const int bb = tid >> 6; float t = 0.f;
#pragma unroll
            for (int q = 0; q < 8; ++q) t += red[(q * 5 + bb) * 64 + col];
            mods[(size_t)(l * 5 + bb) * 6144 + n0 + col] = t + p.in[5][l * 6144 + n0 + col];
        }
        __syncthreads();
    }
    if (blockIdx.x == 0) {
        const float* hl = p.in[12];
        for (int i = tid; i < 2 * 1024; i += 512) {
            const int d = i >> 10, ch = i & 1023;
            const float a = hl[(d * 2 + 0) * 1024 + ch], b = hl[(d * 2 + 1) * 1024 + ch];
            const float m = fmaxf(a, b), ea = __expf(a - m), eb = __expf(b - m);
            lbv[(0 * 2 + d) * 1024 + ch] = 0.f;
            lbv[(1 * 2 + d) * 1024 + ch] = eb / (ea + eb);
        }
    }
}

__device__ __forceinline__ void cvt_tile(const float* src, int ld, int Kdim, bf16_t* dst, int ntile, int ktile, int mapmode, LAS float* T) {
    int tid_ = threadIdx.x; asm volatile("" : "+v"(tid_)); const int tid = tid_;
    const int n0 = ntile * 64, k0 = ktile * 64;
    int sc0 = n0;
    if (mapmode && n0 >= 1024) { const int t = (n0 - 1024) >> 8, w = (n0 - 1024) & 255; sc0 = (w < 128) ? 1024 + 128 * t + w : 2048 + 128 * t + (w - 128); }
    {
        const int kk = tid >> 3, n8 = (tid & 7) * 8;
        const float* sp = src + (size_t)(k0 + kk) * ld + sc0 + n8;
        const f32x4 a = *(const f32x4*)sp, b = *(const f32x4*)(sp + 4);
        LAS float* tp = T + kk * 65 + n8;
        tp[0] = a[0]; tp[1] = a[1]; tp[2] = a[2]; tp[3] = a[3]; tp[4] = b[0]; tp[5] = b[1]; tp[6] = b[2]; tp[7] = b[3];
    }
    __syncthreads();
    {
        const int nn = tid >> 3, k8 = (tid & 7) * 8;
        float v[8];
#pragma unroll
        for (int i = 0; i < 8; ++i) v[i] = T[(k8 + i) * 65 + nn];
        u32x4 w; w.x = pk2(v[0], v[1]); w.y = pk2(v[2], v[3]); w.z = pk2(v[4], v[5]); w.w = pk2(v[6], v[7]);
        *(u32x4*)(dst + (size_t)(n0 + nn) * Kdim + k0 + k8) = w;
    }
    __syncthreads();
}
__device__ __forceinline__ void phase_cvt(const Params& p, LAS unsigned char* lds, int L) {
    const int j = L >> 1; const bool rec = (L & 1) == 0;
    const int Nin = rec ? 5120 : 3072;
    const float* win = rec ? p.in[11] + (size_t)j * 1024 * 5120 : p.in[15] + (size_t)j * 1024 * 3072;
    const float* wout = rec ? p.in[14] + (size_t)j * 1024 * 1024 : p.in[18] + (size_t)j * 1024 * 1024;
    const float* w1 = p.in[9] + (size_t)L * 1024 * 4096;
    const float* w2 = p.in[10] + (size_t)L * 4096 * 1024;
    bf16_t* Win_t = (bf16_t*)(p.ws + WS_WIN); bf16_t* Wout_t = (bf16_t*)(p.ws + WS_WOUT); bf16_t* W1_t = (bf16_t*)(p.ws + WS_W1); bf16_t* W2_t = (bf16_t*)(p.ws + WS_W2);
    const int t0 = (Nin / 64) * 16, t1 = t0 + 256, t2 = t1 + 1024, t3 = t2 + 1024;
    LAS float* T = (LAS float*)lds;
    for (int it = blockIdx.x; it < t3; it += gridDim.x) {
        if (it < t0) cvt_tile(win, Nin, 1024, Win_t, it >> 4, it & 15, rec ? 0 : 1, T);
        else if (it < t1) { const int q = it - t0; cvt_tile(wout, 1024, 1024, Wout_t, q >> 4, q & 15, 0, T); }
        else if (it < t2) { const int q = it - t1; cvt_tile(w1, 4096, 1024, W1_t, q >> 4, q & 15, 0, T); }
        else { const int q = it - t2; cvt_tile(w2, 1024, 4096, W2_t, q >> 6, q & 63, 0, T); }
    }
}

__device__ __forceinline__ void phase_norm(const float* srcL, const float* srcC, int M, const float* gain, const float* mod, int shoff, int scoff, bf16_t* HA, float* Xcopy  , const float* P  , const float* pgate, float* Xw) {
    int tid_ = threadIdx.x; asm volatile("" : "+v"(tid_));
    const int lane = tid_ & 63, gw = blockIdx.x * 8 + (tid_ >> 6), nw = gridDim.x * 8;
    for (int r = gw; r < M; r += nw) {
        const float* xr = r < ML ? srcL + (size_t)r * DM : srcC + (size_t)(r - ML) * DM;
        const int bb = r < ML ? (r >> 13) : 4;
        const float* mp = mod + (size_t)bb * 6144;
        f32x4 v[4]; float ss = 0.f;
#pragma unroll
        for (int i = 0; i < 4; ++i) v[i] = *(const f32x4*)(xr + i * 256 + lane * 4);
        if (P != nullptr && r >= ML) {
#pragma unroll
            for (int i = 0; i < 4; ++i) {
                const int col = i * 256 + lane * 4; const float* pp = P + (size_t)(r - ML) * DM + col;
                const f32x4 sum = (*(const f32x4*)pp + *(const f32x4*)(pp + (size_t)1024 * DM)) + (*(const f32x4*)(pp + (size_t)2048 * DM) + *(const f32x4*)(pp + (size_t)3072 * DM));
                v[i] += *(const f32x4*)(pgate + col) * sum;
                *(f32x4*)(Xw + (size_t)r * DM + col) = v[i];
            }
        }
#pragma unroll
        for (int i = 0; i < 4; ++i) ss += v[i][0] * v[i][0] + v[i][1] * v[i][1] + v[i][2] * v[i][2] + v[i][3] * v[i][3];
#pragma unroll
        for (int o = 32; o >= 1; o >>= 1) ss += __shfl_xor(ss, o);
        const float rstd = rsqrtf(ss * (1.0f / DM) + EPS);
        if (Xcopy != nullptr && r >= ML) {
#pragma unroll
            for (int i = 0; i < 4; ++i) *(f32x4*)(Xcopy + (size_t)r * DM + i * 256 + lane * 4) = v[i];
        }
#pragma unroll
        for (int i = 0; i < 4; ++i) {
            const int col = i * 256 + lane * 4;
            const f32x4 g = *(const f32x4*)(gain + col), sc = *(const f32x4*)(mp + scoff + col), sh = *(const f32x4*)(mp + shoff + col);
            float h[4];
#pragma unroll
            for (int q = 0; q < 4; ++q) h[q] = (v[i][q] * rstd * g[q]) * (1.0f + sc[q]) + sh[q];
            u32x2 w; w.x = pk2(h[0], h[1]); w.y = pk2(h[2], h[3]);
            *(u32x2*)(HA + (size_t)r * DM + col) = w;
        }
    }
}
__device__ __forceinline__ void phase_final(const float* X, const float* gain, float* out) {
    int tid_ = threadIdx.x; asm volatile("" : "+v"(tid_));
    const int lane = tid_ & 63, gw = blockIdx.x * 8 + (tid_ >> 6), nw = gridDim.x * 8;
    for (int r = gw; r < ML; r += nw) {
        const float* xr = X + (size_t)r * DM;
        f32x4 v[4]; float ss = 0.f;
#pragma unroll
        for (int i = 0; i < 4; ++i) { v[i] = *(const f32x4*)(xr + i * 256 + lane * 4); ss += v[i][0] * v[i][0] + v[i][1] * v[i][1] + v[i][2] * v[i][2] + v[i][3] * v[i][3]; }
#pragma unroll
        for (int o = 32; o >= 1; o >>= 1) ss += __shfl_xor(ss, o);
        const float rstd = rsqrtf(ss * (1.0f / DM) + EPS);
#pragma unroll
        for (int i = 0; i < 4; ++i) {
            const int col = i * 256 + lane * 4;
            const f32x4 g = *(const f32x4*)(gain + col);
            *(f32x4*)(out + (size_t)r * DM + col) = v[i] * rstd * g;
        }
    }
}

__device__ __forceinline__ void phase_conv(const bf16_t* Z, const float* cw, const float* cb, int axis_rows, int M, bf16_t* HA) {
    int tid_ = threadIdx.x; asm volatile("" : "+v"(tid_));
    const int gt = blockIdx.x * 512 + tid_, nth = gridDim.x * 512;
    for (int it = gt; it < M * 128; it += nth) {
        const int r = it >> 7, c8 = (it & 127) * 8;
        int dlt; bool hasp, hasn;
        if (r < ML) {
            const int t = r & (SEQ - 1);
            if (axis_rows) { dlt = 64; const int gr = t >> 6; hasp = gr > 0; hasn = gr < 127; }
            else { dlt = 1; const int gc = t & 63; hasp = gc > 0; hasn = gc < 63; }
        } else { dlt = 1; const int t = (r - ML) & (CTXL - 1); hasp = t > 0; hasn = t < CTXL - 1; }
        const bf16_t* up = Z + (size_t)r * 2048 + 1024 + c8;
        const u32x4 uc = *(const u32x4*)up;
        u32x4 upv = (u32x4){0u, 0u, 0u, 0u}, unv = (u32x4){0u, 0u, 0u, 0u};
        if (hasp) upv = *(const u32x4*)(up - (size_t)dlt * 2048);
        if (hasn) unv = *(const u32x4*)(up + (size_t)dlt * 2048);
        const u32x4 gb = *(const u32x4*)(Z + (size_t)r * 2048 + c8);
        float o[8];
#pragma unroll
        for (int q = 0; q < 8; ++q) {
            const unsigned sh = (q & 1) * 16;
            const float u0 = __uint_as_float(((upv[q >> 1] >> sh) & 0xFFFFu) << 16), u1 = __uint_as_float(((uc[q >> 1] >> sh) & 0xFFFFu) << 16), u2 = __uint_as_float(((unv[q >> 1] >> sh) & 0xFFFFu) << 16);
            const float g = __uint_as_float(((gb[q >> 1] >> sh) & 0xFFFFu) << 16);
            const int ch = c8 + q;
            o[q] = g * (cb[ch] + cw[ch] * u0 + cw[1024 + ch] * u1 + cw[2048 + ch] * u2);
        }
        u32x4 w; w.x = pk2(o[0], o[1]); w.y = pk2(o[2], o[3]); w.z = pk2(o[4], o[5]); w.w = pk2(o[6], o[7]);
        *(u32x4*)(HA + (size_t)r * DM + c8) = w;
    }
}

constexpr int G_QT = 0, G_KT = 17408, G_KTT = 34816, G_VTT = 53248, G_PP = 71680, G_STT = 80896, G_TOT = 115712, G_SSQ = 119808;
constexpr int PQ = 136, PT = 72;

__device__ __forceinline__ f32x4 mfma16(bf16x8 a, bf16x8 b, f32x4 c) { return __builtin_amdgcn_mfma_f32_16x16x32_bf16(a, b, c, 0, 0, 0); }
#define LBAR() do { asm volatile("s_waitcnt lgkmcnt(0)" ::: "memory"); __builtin_amdgcn_s_barrier(); asm volatile("" ::: "memory"); } while (0)
__device__ __forceinline__ float bflo(unsigned u) { return __uint_as_float(u << 16); }
__device__ __forceinline__ float bfhi(unsigned u) { return __uint_as_float(u & 0xFFFF0000u); }

struct GlaPF { unsigned g[8], v[8], q[8]; };
template <bool OUT>
__device__ __forceinline__ void gla_prefetch(GlaPF& pf, const bf16_t* Z, int row0, int gcol  , int h, int tid) {
    const bf16_t* zr = Z + (size_t)(row0 + (tid >> 6) * 8) * 5120 + h * 128 + 2 * (tid & 63);
#pragma unroll
    for (int i = 0; i < 8; ++i) {
        pf.g[i] = *(const unsigned*)(zr + (size_t)i * 5120 + gcol);
        pf.v[i] = *(const unsigned*)(zr + (size_t)i * 5120 + 2048);
        if (OUT) pf.q[i] = *(const unsigned*)(zr + (size_t)i * 5120 + 3072);
    }
}

template <bool OUT, int D>
__device__ __forceinline__ void gla_chunk(LAS unsigned char* lds, bf16_t* Z, int row0, int h, f32x4 (&S)[8], float (&lastsum)[2], const float* gnorm,
                                          GlaPF& pf, bool has_next, int nrow0, int ngcol, int nh) {
    int tid_ = threadIdx.x; asm volatile("" : "+v"(tid_));
    const int tid = tid_, lane = tid & 63, w = __builtin_amdgcn_readfirstlane(tid >> 6);
    const int cp = lane, tg = w;
    const int l15 = lane & 15, lq = lane >> 4;
    LAS bf16_t* QT = (LAS bf16_t*)(lds + G_QT); LAS bf16_t* KT = (LAS bf16_t*)(lds + G_KT); LAS bf16_t* KTT = (LAS bf16_t*)(lds + G_KTT);
    LAS bf16_t* VTT = (LAS bf16_t*)(lds + G_VTT); LAS bf16_t* PP = (LAS bf16_t*)(lds + G_PP); LAS bf16_t* STT = (LAS bf16_t*)(lds + G_STT);
    LAS float* TOT = (LAS float*)(lds + G_TOT); LAS float* SSQ = (LAS float*)(lds + G_SSQ);
    float g0[8], g1[8], c0[8], c1[8];
#pragma unroll
    for (int i = 0; i < 8; ++i) { g0[i] = bflo(pf.g[i]); g1[i] = bfhi(pf.g[i]); }
    if (D == 0) { c0[0] = g0[0]; c1[0] = g1[0];
#pragma unroll
        for (int i = 1; i < 8; ++i) { c0[i] = c0[i - 1] + g0[i]; c1[i] = c1[i - 1] + g1[i]; }
        *(LAS f32x2*)(TOT + tg * 128 + 2 * cp) = (f32x2){c0[7], c1[7]};
    } else { c0[7] = g0[7]; c1[7] = g1[7];
#pragma unroll
        for (int i = 6; i >= 0; --i) { c0[i] = c0[i + 1] + g0[i]; c1[i] = c1[i + 1] + g1[i]; }
        *(LAS f32x2*)(TOT + tg * 128 + 2 * cp) = (f32x2){c0[0], c1[0]};
    }
    LBAR();
    {
        float pre0 = 0.f, pre1 = 0.f, ref0 = 0.f, ref1 = 0.f, all0 = 0.f, all1 = 0.f;
#pragma unroll
        for (int t = 0; t < 8; ++t) {
            const f32x2 tv = *(const LAS f32x2*)(TOT + t * 128 + 2 * cp);
            all0 += tv.x; all1 += tv.y;
            const bool inref = (D == 0) ? (t < 4) : (t >= 4);
            if (inref) { ref0 += tv.x; ref1 += tv.y; }
            const bool inpre = (D == 0) ? (t < tg) : (t > tg);
            pre0 += inpre ? tv.x : 0.f; pre1 += inpre ? tv.y : 0.f;
        }
        if (tg == 0) { lastsum[0] += all0; lastsum[1] += all1; }
        unsigned kp0[4], kp1[4], vp0[4], vp1[4];
#pragma unroll
        for (int i = 0; i < 8; i += 2) {
            float k0[2], k1[2];
#pragma unroll
            for (int u = 0; u < 2; ++u) {
                const int ii = i + u;
                const float cum0 = pre0 + c0[ii], cum1 = pre1 + c1[ii];
                k0[u] = (1.0f - __expf(g0[ii])) * __expf(ref0 - cum0);
                k1[u] = (1.0f - __expf(g1[ii])) * __expf(ref1 - cum1);
                const int t = tg * 8 + ii;
                if (OUT) {
                    const float q0 = bflo(pf.q[ii]) * __expf(cum0 - ref0), q1 = bfhi(pf.q[ii]) * __expf(cum1 - ref1);
                    *(LAS unsigned*)(QT + t * PQ + 2 * cp) = pk2(q0, q1);
                    *(LAS unsigned*)(KT + t * PQ + 2 * cp) = pk2(k0[u], k1[u]);
                }
            }
            kp0[i >> 1] = pk2(k0[0], k0[1]); kp1[i >> 1] = pk2(k1[0], k1[1]);
            vp0[i >> 1] = (pf.v[i] & 0xFFFFu) | (pf.v[i + 1] << 16); vp1[i >> 1] = (pf.v[i] >> 16) | (pf.v[i + 1] & 0xFFFF0000u);
        }
        *(LAS u32x4*)(KTT + (2 * cp) * PT + tg * 8) = (u32x4){kp0[0], kp0[1], kp0[2], kp0[3]};
        *(LAS u32x4*)(KTT + (2 * cp + 1) * PT + tg * 8) = (u32x4){kp1[0], kp1[1], kp1[2], kp1[3]};
        *(LAS u32x4*)(VTT + (2 * cp) * PT + tg * 8) = (u32x4){vp0[0], vp0[1], vp0[2], vp0[3]};
        *(LAS u32x4*)(VTT + (2 * cp + 1) * PT + tg * 8) = (u32x4){vp1[0], vp1[1], vp1[2], vp1[3]};
    }
    float el[4];
    {
        f32x4 rs = (f32x4){0.f, 0.f, 0.f, 0.f}, ls = (f32x4){0.f, 0.f, 0.f, 0.f};
#pragma unroll
        for (int t = 0; t < 8; ++t) {
            const f32x4 tv = *(const LAS f32x4*)(TOT + t * 128 + 16 * w + lq * 4);
            const bool inref = (D == 0) ? (t < 4) : (t >= 4);
            if (inref) rs += tv; else ls += tv;
        }
        float er[4];
#pragma unroll
        for (int j = 0; j < 4; ++j) { er[j] = __expf(rs[j]); el[j] = __expf(ls[j]); }
#pragma unroll
        for (int vt = 0; vt < 8; ++vt) {
#pragma unroll
            for (int j = 0; j < 4; ++j) S[vt][j] *= er[j];
            if (OUT) { u32x2 wv; wv.x = pk2(S[vt][0], S[vt][1]); wv.y = pk2(S[vt][2], S[vt][3]);
                *(LAS u32x2*)(STT + (16 * vt + l15) * PQ + 16 * w + lq * 4) = wv; }
        }
    }
    if (has_next) gla_prefetch<OUT>(pf, Z, nrow0, ngcol, nh, tid);
    const int rt = w & 3, vh = (w >> 2) * 4;
    bf16_t* zo = Z + (size_t)(row0 + 16 * rt + l15) * 5120 + h * 128 + 16 * vh + 4 * lq;
    u32x2 ofw[4], gat[4];
    if (OUT && D == 1) {
#pragma unroll
        for (int i = 0; i < 4; ++i) { ofw[i] = *(const u32x2*)(zo + 16 * i); gat[i] = *(const u32x2*)(zo + 4096 + 16 * i); }
    }
    LBAR();
    if (OUT) {
        const int st = w >> 1, ct0 = (w & 1) * 2;
#pragma unroll
        for (int i = 0; i < 2; ++i) {
            const int ct = ct0 + i;
            f32x4 a = (f32x4){0.f, 0.f, 0.f, 0.f};
            const bool zero = (D == 0) ? (st > ct) : (st < ct);
            if (!zero) {
#pragma unroll
                for (int ks = 0; ks < 4; ++ks) {
                    const bf16x8 fa = *(const LAS bf16x8*)(KT + (16 * st + l15) * PQ + ks * 32 + lq * 8);
                    const bf16x8 fb = *(const LAS bf16x8*)(QT + (16 * ct + l15) * PQ + ks * 32 + lq * 8);
                    a = mfma16(fa, fb, a);
                }
                const int cc = 16 * ct + l15;
#pragma unroll
                for (int j = 0; j < 4; ++j) { const int ss = 16 * st + lq * 4 + j; const bool keep = (D == 0) ? (ss <= cc) : (ss >= cc); a[j] = keep ? a[j] : 0.f; }
            }
            u32x2 wv; wv.x = pk2(a[0], a[1]); wv.y = pk2(a[2], a[3]);
            *(LAS u32x2*)(PP + (16 * ct + l15) * PT + 16 * st + lq * 4) = wv;
        }
    }
    {
        bf16x8 fa[2];
#pragma unroll
        for (int ks = 0; ks < 2; ++ks) fa[ks] = *(const LAS bf16x8*)(KTT + (16 * w + l15) * PT + ks * 32 + lq * 8);
#pragma unroll
        for (int vt = 0; vt < 8; ++vt) {
#pragma unroll
            for (int ks = 0; ks < 2; ++ks) {
                const bf16x8 fb = *(const LAS bf16x8*)(VTT + (16 * vt + l15) * PT + ks * 32 + lq * 8);
                S[vt] = mfma16(fa[ks], fb, S[vt]);
            }
#pragma unroll
            for (int j = 0; j < 4; ++j) S[vt][j] *= el[j];
        }
    }
    if (OUT) {
        LBAR();
        f32x4 o[4];
#pragma unroll
        for (int i = 0; i < 4; ++i) o[i] = (f32x4){0.f, 0.f, 0.f, 0.f};
#pragma unroll
        for (int ks = 0; ks < 2; ++ks) {
            const bf16x8 fb = *(const LAS bf16x8*)(PP + (16 * rt + l15) * PT + ks * 32 + lq * 8);
#pragma unroll
            for (int i = 0; i < 4; ++i) { const bf16x8 fa = *(const LAS bf16x8*)(VTT + (16 * (vh + i) + l15) * PT + ks * 32 + lq * 8); o[i] = mfma16(fa, fb, o[i]); }
        }
#pragma unroll
        for (int ks = 0; ks < 4; ++ks) {
            const bf16x8 fb = *(const LAS bf16x8*)(QT + (16 * rt + l15) * PQ + ks * 32 + lq * 8);
#pragma unroll
            for (int i = 0; i < 4; ++i) { const bf16x8 fa = *(const LAS bf16x8*)(STT + (16 * (vh + i) + l15) * PQ + ks * 32 + lq * 8); o[i] = mfma16(fa, fb, o[i]); }
        }
        if (D == 0) {
#pragma unroll
            for (int i = 0; i < 4; ++i) { u32x2 wv; wv.x = pk2(o[i][0], o[i][1]); wv.y = pk2(o[i][2], o[i][3]); *(u32x2*)(zo + 16 * i) = wv; }
        } else {
            float sq = 0.f;
#pragma unroll
            for (int i = 0; i < 4; ++i) {
                o[i][0] += bflo(ofw[i].x); o[i][1] += bfhi(ofw[i].x); o[i][2] += bflo(ofw[i].y); o[i][3] += bfhi(ofw[i].y);
                sq += o[i][0] * o[i][0] + o[i][1] * o[i][1] + o[i][2] * o[i][2] + o[i][3] * o[i][3];
            }
            sq += __shfl_xor(sq, 16); sq += __shfl_xor(sq, 32);
            if (lq == 0) SSQ[(w >> 2) * 64 + 16 * rt + l15] = sq;
            LBAR();
            const float rstd = rsqrtf((SSQ[16 * rt + l15] + SSQ[64 + 16 * rt + l15]) * (1.0f / 128.0f) + EPS);
#pragma unroll
            for (int i = 0; i < 4; ++i) {
                const f32x4 gn = *(const f32x4*)(gnorm + h * 128 + 16 * (vh + i) + 4 * lq);
                const float y0 = o[i][0] * rstd * gn[0] * bflo(gat[i].x), y1 = o[i][1] * rstd * gn[1] * bfhi(gat[i].x);
                const float y2 = o[i][2] * rstd * gn[2] * bflo(gat[i].y), y3 = o[i][3] * rstd * gn[3] * bfhi(gat[i].y);
                u32x2 wv; wv.x = pk2(y0, y1); wv.y = pk2(y2, y3);
                *(u32x2*)(zo + 1024 + 16 * i) = wv;
            }
        }
    }
}

__device__ __forceinline__ int sc_rowbase(int b, int jsc) { return jsc == 0 ? ML + b * CTXL : b * SEQ + (jsc - 1) * 256; }

__device__ __forceinline__ void phase_gla1(LAS unsigned char* lds, bf16_t* Z, float* Sbuf, float* Dbuf) {
    int tid_ = threadIdx.x; asm volatile("" : "+v"(tid_));
    const int tid = tid_, lane = tid & 63, w = __builtin_amdgcn_readfirstlane(tid >> 6);
    GlaPF pf;
    int task = blockIdx.x;
    if (task < 2048) {
        const int bhd = task >> 5, p = task & 31, b = bhd >> 4, h = (bhd >> 1) & 7, d = bhd & 1;
        const int jsc = (p == 0) ? 0 : (d == 0 ? p : 33 - p);
        gla_prefetch<false>(pf, Z, sc_rowbase(b, jsc) + (d ? 192 : 0), d * 1024, h, tid);
    }
    for (; task < 2048; task += gridDim.x) {
        const int bhd = task >> 5, p = task & 31, b = bhd >> 4, h = (bhd >> 1) & 7, d = bhd & 1;
        const int jsc = (p == 0) ? 0 : (d == 0 ? p : 33 - p);
        const int rb = sc_rowbase(b, jsc);
        const int nt = task + gridDim.x; const bool hn = nt < 2048;
        int nrow = 0, ngc = 0, nh = 0;
        if (hn) { const int nbhd = nt >> 5, np = nt & 31, nb = nbhd >> 4, nd = nbhd & 1; nh = (nbhd >> 1) & 7;
            const int nj = (np == 0) ? 0 : (nd == 0 ? np : 33 - np); nrow = sc_rowbase(nb, nj) + (nd ? 192 : 0); ngc = nd * 1024; }
        f32x4 S[8];
#pragma unroll
        for (int vt = 0; vt < 8; ++vt) S[vt] = (f32x4){0.f, 0.f, 0.f, 0.f};
        float lastsum[2] = {0.f, 0.f};
        if (d == 0) {
#pragma unroll 1
            for (int ci = 0; ci < 4; ++ci) { const bool last = ci == 3; gla_chunk<false, 0>(lds, Z, rb + ci * 64, h, S, lastsum, nullptr, pf, last ? hn : true, last ? nrow : rb + (ci + 1) * 64, last ? ngc : 0, last ? nh : h); }
        } else {
#pragma unroll 1
            for (int ci = 3; ci >= 0; --ci) { const bool last = ci == 0; gla_chunk<false, 1>(lds, Z, rb + ci * 64, h, S, lastsum, nullptr, pf, last ? hn : true, last ? nrow : rb + (ci - 1) * 64, last ? ngc : 1024, last ? nh : h); }
        }
        float* sp = Sbuf + (size_t)task * 16384;
#pragma unroll
        for (int vt = 0; vt < 8; ++vt)
#pragma unroll
            for (int j = 0; j < 4; ++j) sp[((w * 8 + vt) * 4 + j) * 64 + lane] = S[vt][j];
        if (tid < 64) *(f32x2*)(Dbuf + (size_t)task * 128 + 2 * tid) = (f32x2){__expf(lastsum[0]), __expf(lastsum[1])};
        LBAR();
    }
}
__device__ __forceinline__ void phase_gla2(float* Sbuf, const float* Dbuf) {
    int tid_ = threadIdx.x; asm volatile("" : "+v"(tid_));
    const int gt = blockIdx.x * 512 + tid_, nth = gridDim.x * 512;
    for (int idx = gt; idx < 64 * 4096; idx += nth) {
        const int bhd = idx >> 12, e4 = idx & 4095, e = e4 * 4;
        const int k = 16 * (e >> 11) + ((e & 63) >> 4) * 4 + ((e >> 6) & 3);
        f32x4 s = (f32x4){0.f, 0.f, 0.f, 0.f};
        f32x4* sp = (f32x4*)(Sbuf + (size_t)bhd * 32 * 16384) + e4;
        const float* dp = Dbuf + (size_t)bhd * 32 * 128 + k;
#pragma unroll 8
        for (int p = 0; p < 32; ++p) { const float dd = dp[p * 128]; const f32x4 a = sp[(size_t)p * 4096]; s = s * dd + a; sp[(size_t)p * 4096] = s; }
    }
}
__device__ __forceinline__ void phase_gla3(LAS unsigned char* lds, bf16_t* Z, const float* Sbuf, const float* gnorm, int with_ctx) {
    int tid_ = threadIdx.x; asm volatile("" : "+v"(tid_));
    const int tid = tid_, lane = tid & 63, w = __builtin_amdgcn_readfirstlane(tid >> 6);
    const int jlo = with_ctx ? 0 : 1, nj = 33 - jlo, ntask = 32 * nj;
    GlaPF pf;
    int task = blockIdx.x;
    if (task < ntask) { const int bh = task / nj, jsc = jlo + task % nj; gla_prefetch<true>(pf, Z, sc_rowbase(bh >> 3, jsc), 0, bh & 7, tid); }
    for (; task < ntask; task += gridDim.x) {
        const int bh = task / nj, jsc = jlo + task % nj, b = bh >> 3, h = bh & 7;
        const int rb = sc_rowbase(b, jsc);
        const int nt = task + gridDim.x; const bool hn = nt < ntask;
        int nrow = 0, nh = 0;
        if (hn) { const int nbh = nt / nj, njsc = jlo + nt % nj; nrow = sc_rowbase(nbh >> 3, njsc); nh = nbh & 7; }
        float dummy[2] = {0.f, 0.f};
        f32x4 S[8];
        {
            const int p = jsc;
            if (p == 0) {
#pragma unroll
                for (int vt = 0; vt < 8; ++vt) S[vt] = (f32x4){0.f, 0.f, 0.f, 0.f};
            } else {
                const float* sp = Sbuf + ((size_t)((bh * 2 + 0) * 32 + (p - 1))) * 16384;
#pragma unroll
                for (int vt = 0; vt < 8; ++vt)
#pragma unroll
                    for (int j = 0; j < 4; ++j) S[vt][j] = sp[((w * 8 + vt) * 4 + j) * 64 + lane];
            }
#pragma unroll 1
            for (int ci = 0; ci < 4; ++ci) { const bool last = ci == 3; gla_chunk<true, 0>(lds, Z, rb + ci * 64, h, S, dummy, gnorm, pf, true, last ? rb + 192 : rb + (ci + 1) * 64, last ? 1024 : 0, h); }
        }
        {
            const int p = (jsc == 0) ? 0 : 33 - jsc;
            if (p == 0) {
#pragma unroll
                for (int vt = 0; vt < 8; ++vt) S[vt] = (f32x4){0.f, 0.f, 0.f, 0.f};
            } else {
                const float* sp = Sbuf + ((size_t)((bh * 2 + 1) * 32 + (p - 1))) * 16384;
#pragma unroll
                for (int vt = 0; vt < 8; ++vt)
#pragma unroll
                    for (int j = 0; j < 4; ++j) S[vt][j] = sp[((w * 8 + vt) * 4 + j) * 64 + lane];
            }
            asm volatile("s_waitcnt vmcnt(0)" ::: "memory");
            __builtin_amdgcn_fence(__ATOMIC_ACQUIRE, "agent");
            LBAR();
#pragma unroll 1
            for (int ci = 3; ci >= 0; --ci) { const bool last = ci == 0; gla_chunk<true, 1>(lds, Z, rb + ci * 64, h, S, dummy, gnorm, pf, last ? hn : true, last ? nrow : rb + (ci - 1) * 64, last ? 0 : 1024, last ? nh : h); }
        }
        asm volatile("s_waitcnt vmcnt(0)" ::: "memory");
        LBAR();
    }
}


#define XB_TMO      128
#define XB_XCNT(j)  (256  + 64 * (j))
#define XB_XSUB(j)  (1280 + 64 * (j))
#define XB_XGEN(j)  (2304 + 64 * (j))
#define XB_TOP      3328
#define XB_TOPGEN   3392
#define XCD_BAR_WORDS 3456
#define XB_SPIN_CAP (1u << 22)
__device__ __forceinline__ unsigned xb_ld(unsigned* p)              { return __hip_atomic_load(p, __ATOMIC_RELAXED, __HIP_MEMORY_SCOPE_AGENT); }
__device__ __forceinline__ unsigned xb_add(unsigned* p, unsigned v) { return __hip_atomic_fetch_add(p, v, __ATOMIC_RELAXED, __HIP_MEMORY_SCOPE_AGENT); }
__device__ __forceinline__ unsigned xb_xcc_id() { return (unsigned)__builtin_amdgcn_s_getreg((3 << 11) | 20) & 0xFu; }
#define XB_SPIN(cond, bar) do { unsigned _sp = 0; while (cond) { __builtin_amdgcn_s_sleep(1); \
    if ((++_sp & 255u) == 0u) { if (xb_ld(&(bar)[XB_TMO])) break; if (_sp > XB_SPIN_CAP) { atomicAdd(&(bar)[XB_TMO], 1u); break; } } } } while (0)
struct XcdBarrier { unsigned* bar; unsigned x; volatile LAS unsigned* st; };
__device__ __forceinline__ XcdBarrier xcd_barrier_post(unsigned* bar, volatile LAS unsigned* st) {
    XcdBarrier b; b.bar = bar; b.x = xb_xcc_id(); b.st = st;
    if (threadIdx.x == 0) (void)xb_add(&bar[XB_XCNT(b.x)], 1u);
    return b;
}
__device__ __forceinline__ void xcd_barrier_complete(unsigned* bar, unsigned x, unsigned& nloc, unsigned& nx) {
    const unsigned G = gridDim.x * gridDim.y * gridDim.z;
    unsigned sum, cnt, mine, sp = 0u;
    for (;;) {
        sum = 0u; cnt = 0u; mine = 0u;
#pragma unroll
        for (unsigned j = 0; j < 16; ++j) { const unsigned c = xb_ld(&bar[XB_XCNT(j)]); sum += c; cnt += (c > 0u) ? 1u : 0u; mine = (j == x) ? c : mine; }
        if (sum == G) break;
        __builtin_amdgcn_s_sleep(1);
        if ((++sp & 255u) == 0u) { if (xb_ld(&bar[XB_TMO])) break; if (sp > XB_SPIN_CAP) { atomicAdd(&bar[XB_TMO], 1u); break; } }
    }
    nloc = mine > 0u ? mine : 1u; nx = cnt > 0u ? cnt : 1u;
}
__device__ __forceinline__ void xcd_barrier(const XcdBarrier& b) {
    asm volatile("s_waitcnt vmcnt(0)" ::: "memory");
    __syncthreads();
    if (threadIdx.x == 0) {
        unsigned* bar = b.bar;
        __builtin_amdgcn_s_waitcnt(0);
        unsigned nloc = b.st[0], nx = b.st[1];
        if (nloc == 0u) { xcd_barrier_complete(bar, b.x, nloc, nx); b.st[0] = nloc; b.st[1] = nx; }
        const unsigned old = xb_add(&bar[XB_XSUB(b.x)], 1u);
        const unsigned gen = old / nloc;
        if (old + 1u == (gen + 1u) * nloc) {
            __builtin_amdgcn_fence(__ATOMIC_RELEASE, "agent");
            asm volatile("s_waitcnt vmcnt(0)" ::: "memory");
            const unsigned og = xb_add(&bar[XB_TOP], 1u);
            const unsigned tg = og / nx;
            if (og + 1u == (tg + 1u) * nx) xb_add(&bar[XB_TOPGEN], 1u);
            else XB_SPIN(xb_ld(&bar[XB_TOPGEN]) == tg, bar);
            __builtin_amdgcn_fence(__ATOMIC_ACQUIRE, "agent");
            xb_add(&bar[XB_XGEN(b.x)], 1u);
            asm volatile("s_waitcnt vmcnt(0)" ::: "memory");
        } else {
            XB_SPIN(xb_ld(&bar[XB_XGEN(b.x)]) == gen, bar);
            __builtin_amdgcn_fence(__ATOMIC_ACQUIRE, "agent");
            asm volatile("s_waitcnt vmcnt(0)" ::: "memory");
        }
    }
    __syncthreads();
}

__global__ void __launch_bounds__(512, 2) mega_fwd(Params p) {
    extern __shared__ __attribute__((aligned(16))) unsigned char lds_raw[];
    LAS unsigned char* lds = (LAS unsigned char*)lds_raw;
    cg::grid_group grid = cg::this_grid();
    unsigned char* ws = p.ws;
    float* X = (float*)(ws + WS_X); bf16_t* Z = (bf16_t*)(ws + WS_Z);
    bf16_t* Win_t = (bf16_t*)(ws + WS_WIN); bf16_t* Wout_t = (bf16_t*)(ws + WS_WOUT); bf16_t* W1_t = (bf16_t*)(ws + WS_W1); bf16_t* W2_t = (bf16_t*)(ws + WS_W2);
    float* Dbuf = (float*)(ws + WS_DB); float* mods = (float*)(ws + WS_MOD); float* lbv = (float*)(ws + WS_LB);
    bf16_t* HA = (bf16_t*)p.out;
    float* Sbuf = p.out;
    const int G = gridDim.x, bx = blockIdx.x;

    volatile LAS unsigned* xst = (volatile LAS unsigned*)(lds + LDS_MAIN);
    if (threadIdx.x == 0) { xst[0] = 0u; xst[1] = 0u; }
    __syncthreads();
    const XcdBarrier xbar = xcd_barrier_post((unsigned*)(ws + WS_BAR), xst);
    phase_ada(p, lds, mods, lbv);
    grid.sync();

#pragma unroll 1
    for (int L = 0; L < 4; ++L) {
        const bool rec = (L & 1) == 0; const int j = L >> 1;
        const float* modL = mods + (size_t)L * 5 * 6144;
        const int Mmix_in = (L < 3) ? MT : ML;
        const int Mlive = (L < 2) ? MT : ML;
#pragma unroll 1
        for (int s = 0; s < 2; ++s) {
            if (s == 0) phase_cvt(p, lds, L);
            {
                const float* srcL = (L == 0 && s == 0) ? p.in[0] : X;
                const float* srcC = (L == 0 && s == 0) ? p.in[2] : X + (size_t)ML * DM;
                const float* gain = (s == 0 ? p.in[6] : p.in[7]) + L * 1024;
                phase_norm(srcL, srcC, s == 0 ? Mmix_in : Mlive, gain, modL, s == 0 ? 0 : 3 * 1024, s == 0 ? 1024 : 4 * 1024, HA, (L == 0 && s == 0) ? X : nullptr,
                           ((s == 1 && L < 2) || (s == 0 && (L == 1 || L == 2))) ? (const float*)(ws + WS_P) : nullptr,
                           s == 1 ? modL + 4 * 6144 + 2 * 1024 : mods + (size_t)((L > 0 ? L - 1 : 0) * 5 + 4) * 6144 + 5 * 1024, X);
            }
            xcd_barrier(xbar);
            pg8::Gemm g; const float* gate; const float* resL; const float* resC;
            if (s == 0) {
                if (rec) {
                    { pg8::Gemm gi{HA, Win_t, Mmix_in, 5120, 1024, 1024, 1024}; pg8::StaticOrder S; S.init(gi.M, gi.N, gi.K, G, bx);
                      EpiHgrnIn E{Z, lbv + (size_t)j * 2048}; pg8::gemm_phase<EpiHgrnIn, pg8::StaticOrder>(lds, gi, S, E); }
                    xcd_barrier(xbar);
                    phase_gla1(lds, Z, Sbuf, Dbuf);
                    xcd_barrier(xbar);
                    phase_gla2(Sbuf, Dbuf);
                    xcd_barrier(xbar);
                    phase_gla3(lds, Z, Sbuf, p.in[13] + j * 1024, L < 2 ? 1 : 0);
                    xcd_barrier(xbar);
                    g = pg8::Gemm{Z + 1024, Wout_t, ML, 1024, 1024, 5120, 1024};
                } else {
                    { pg8::Gemm gi{HA, Win_t, Mmix_in, 3072, 1024, 1024, 1024}; pg8::StaticOrder S; S.init(gi.M, gi.N, gi.K, G, bx);
                      EpiConvIn E{Z}; pg8::gemm_phase<EpiConvIn, pg8::StaticOrder>(lds, gi, S, E); }
                    xcd_barrier(xbar);
                    phase_conv(Z, p.in[16] + (size_t)j * 3 * 1024, p.in[17] + j * 1024, j & 1, Mlive, HA);
                    xcd_barrier(xbar);
                    g = pg8::Gemm{HA, Wout_t, ML, 1024, 1024, 1024, 1024};
                }
                gate = modL + 2 * 1024;
                resL = (L == 0) ? p.in[0] : X; resC = (L == 0) ? p.in[2] : X + (size_t)ML * DM;
            } else {
                { pg8::Gemm gi{HA, W1_t, Mlive, 4096, 1024, 1024, 1024}; pg8::StaticOrder S; S.init(gi.M, gi.N, gi.K, G, bx);
                  EpiRelu2 E{Z}; pg8::gemm_phase<EpiRelu2, pg8::StaticOrder>(lds, gi, S, E); }
                xcd_barrier(xbar);
                g = pg8::Gemm{Z, W2_t, ML, 1024, 4096, 4096, 4096};
                gate = modL + 5 * 1024;
                resL = X; resC = X + (size_t)ML * DM;
            }
            { pg8::StaticOrder S; S.init(g.M, g.N, g.K, G, bx, L < 2 ? 64 : 0); EpiResid E{X, resL, resC, gate, (float*)(ws + WS_P)}; pg8::gemm_phase<EpiResid, pg8::StaticOrder>(lds, g, S, E); }
            xcd_barrier(xbar);
        }
    }
    phase_final(X, p.in[8], p.out);
}

extern "C" void kernel_launch(void* const* d_in, const int* in_sizes, int n_in, void* d_out, int out_size, void* d_ws, size_t ws_size, hipStream_t stream) {
    static int grid = 0;
    if (grid == 0) {
        if (n_in != 19 || out_size != ML * DM || ws_size < WS_END) { fprintf(stderr, "kernel_launch: unexpected shapes / workspace (n_in %d out %d ws %zu need %zu)\n", n_in, out_size, ws_size, (size_t)WS_END); grid = -1; return; }
        int dev = 0, cus = 0, per_cu = 0;
        if (hipGetDevice(&dev) != hipSuccess || hipDeviceGetAttribute(&cus, hipDeviceAttributeMultiprocessorCount, dev) != hipSuccess) { grid = -1; return; }
        if (hipFuncSetAttribute((const void*)mega_fwd, hipFuncAttributeMaxDynamicSharedMemorySize, LDS_BYTES) != hipSuccess) { fprintf(stderr, "kernel_launch: hipFuncSetAttribute failed\n"); grid = -1; return; }
        if (hipOccupancyMaxActiveBlocksPerMultiprocessor(&per_cu, (const void*)mega_fwd, 512, LDS_BYTES) != hipSuccess || per_cu < 1) { fprintf(stderr, "kernel_launch: occupancy query failed (%d)\n", per_cu); per_cu = 1; (void)hipGetLastError(); }
        grid = cus * per_cu;
    }
    if (grid < 0) return;
    if (hipMemsetAsync((char*)d_ws + WS_BAR, 0, XCD_BAR_WORDS * 4, stream) != hipSuccess) { fprintf(stderr, "kernel_launch: memset failed\n"); return; }
    Params p{};
    for (int i = 0; i < 19; ++i) p.in[i] = (const float*)d_in[i];
    p.out = (float*)d_out; p.ws = (unsigned char*)d_ws;
    void* args[] = {&p};
    hipError_t e = hipLaunchCooperativeKernel((const void*)mega_fwd, dim3(grid), dim3(512), args, LDS_BYTES, stream);
    if (e != hipSuccess) fprintf(stderr, "cooperative launch failed: %s (grid %d)\n", hipGetErrorString(e), grid);
}
```

```cpp
#include <hip/hip_runtime.h>
#include <hip/hip_cooperative_groups.h>
#include <cstdio>
namespace cg = cooperative_groups;

#define LAS __attribute__((address_space(3)))
typedef unsigned short bf16_t;
typedef short bf16x8 __attribute__((ext_vector_type(8)));
typedef float f32x4 __attribute__((ext_vector_type(4)));
typedef unsigned u32x4 __attribute__((ext_vector_type(4)));
typedef unsigned u32x2 __attribute__((ext_vector_type(2)));
typedef float f32x2 __attribute__((ext_vector_type(2)));

constexpr int DM = 1024, NB = 4, SEQ = 8192, CTXL = 256, DFF = 4096;
constexpr int ML = NB * SEQ;
constexpr int MC = NB * CTXL;
constexpr int MT = ML + MC;
constexpr float EPS = 1e-6f;

constexpr size_t WS_X = 0;
constexpr size_t WS_Z = WS_X + (size_t)MT * DM * 4;
constexpr size_t WS_WIN = WS_Z + (size_t)MT * 5120 * 2;
constexpr size_t WS_WOUT = WS_WIN + (size_t)5120 * 1024 * 2;
constexpr size_t WS_W1 = WS_WOUT + (size_t)1024 * 1024 * 2;
constexpr size_t WS_W2 = WS_W1 + (size_t)4096 * 1024 * 2;
constexpr size_t WS_DB = WS_W2 + (size_t)4096 * 1024 * 2;
constexpr size_t WS_MOD = WS_DB + (size_t)2048 * 128 * 4;
constexpr size_t WS_LB = WS_MOD + (size_t)4 * 5 * 6144 * 4;
constexpr size_t WS_BAR = WS_LB + (size_t)2 * 2 * 1024 * 4;
constexpr size_t WS_P = WS_BAR + (size_t)3456 * 4 + 128;
constexpr size_t WS_END = WS_P + (size_t)4 * 1024 * 1024 * 4;

constexpr int LDS_MAIN = 131072;
constexpr int LDS_BYTES = LDS_MAIN + 16;

struct Params { const float* in[19]; float* out; unsigned char* ws; };

__device__ __forceinline__ float bf2f(bf16_t b) { return __uint_as_float(((unsigned)b) << 16); }
__device__ __forceinline__ bf16_t f2bf(float f) { unsigned u = __float_as_uint(f); u += 0x7FFFu + ((u >> 16) & 1u); return (bf16_t)(u >> 16); }
typedef __bf16 bf16v2_t __attribute__((ext_vector_type(2)));
__device__ __forceinline__ unsigned pk2(float lo, float hi) { const f32x2 v = {lo, hi}; const bf16v2_t r = __builtin_convertvector(v, bf16v2_t); return __builtin_bit_cast(unsigned, r); }
__device__ __forceinline__ float bflo(unsigned u) { return __uint_as_float(u << 16); }
__device__ __forceinline__ float bfhi(unsigned u) { return __uint_as_float(u & 0xFFFF0000u); }
__device__ __forceinline__ float sigmoidf_(float z) { return __builtin_amdgcn_rcpf(1.0f + __expf(-z)); }
__device__ __forceinline__ float siluf_(float z) { return z * __builtin_amdgcn_rcpf(1.0f + __expf(-z)); }

namespace pg8 {
constexpr int BM = 256, BK = 64, HALF = 128, HTB = HALF * BK * 2, NXCD = 8, WGM = 8;
__device__ __forceinline__ int lds_byte(int r, int c) { const int st = (r >> 4) * 2 + (c >> 5), rr = r & 15, cc = c & 31, ob = rr * 64 + cc * 2; return st * 1024 + (ob ^ (((ob >> 9) & 1) << 5)); }
__device__ __forceinline__ void stage_rc(int b, int& R, int& C) { const int st = b / 1024, sb = b % 1024, swz = sb ^ (((sb >> 9) & 1) << 5); R = (st >> 1) * 16 + swz / 64; C = (st & 1) * 32 + (swz % 64) / 2; }
__device__ __forceinline__ int perm32(int rho) { const int n = rho >> 4, i = rho & 15; return 8 * (i >> 2) + 4 * n + (i & 3); }

struct Unit { int pm, pn, ks, nt; };
struct Gemm { const bf16_t* A; const bf16_t* Bt; int M, N, K, lda, ldb; };

struct StaticOrder {
    int nM, nN, nwg, G, c, ntk, nctx, ksb;
    __device__ void init(int M, int N, int K, int G_, int c_, int nctx_ = 0) { nM = M / BM; nN = N / BM; nwg = nM * nN; G = G_; c = c_; ntk = K / BK; nctx = nctx_; ksb = (K / 4) * 2; }
    __device__ bool next(int i, Unit& u) const {
        int i2 = i;
        if (c < nctx) {
            if (i == 0) { const int t = c; u.ks = t >> 4; u.pm = 128 + ((t & 15) >> 2); u.pn = t & 3; u.nt = ntk >> 2; return true; }
            i2 = i - 1;
        }
        const long L = (long)i2 * G + c;
        if (L >= nwg) return false;
        int wgid = (int)L; { const int q = nwg / NXCD, r = nwg % NXCD, xcd = wgid % NXCD, off = wgid / NXCD; wgid = (xcd < r ? xcd * (q + 1) : r * (q + 1) + (xcd - r) * q) + off; }
        const int nig = WGM * nN, gid = wgid / nig, fm = gid * WGM, gsz = (nM - fm) < WGM ? (nM - fm) : WGM;
        u.pm = fm + ((wgid % nig) % gsz); u.pn = (wgid % nig) / gsz; u.ks = 0; u.nt = ntk; return true;
    }
};

template <class Epi, class Sched>
__device__ __forceinline__ void gemm_phase(LAS unsigned char* lds, const Gemm g, const Sched& S, const Epi& E) {
    int tid_ = threadIdx.x; asm volatile("" : "+v"(tid_));
    const int tid = tid_, wid = __builtin_amdgcn_readfirstlane(tid >> 6), lane = tid & 63, wr = wid >> 2, wc = wid & 3, fr = lane & 15, fq = lane >> 4;
    const int lda = g.lda, ldb = g.ldb;
    unsigned voffA[2], voffB[2];
#pragma unroll
    for (int i = 0; i < 2; ++i) { int R, C; stage_rc(tid * 16 + i * 8192, R, C); const int Rb = Epi::PERM ? ((R & ~31) + perm32(R & 31)) : R;
        voffA[i] = (unsigned)(R * lda + C) * 2u; voffB[i] = (unsigned)(Rb * ldb + C) * 2u; }
    const size_t kstep = (size_t)(BK * 2);
    const size_t hstepA = (size_t)HALF * lda * 2, hstepB = (size_t)HALF * ldb * 2;
    const size_t ksb = (size_t)S.ksb;
    const size_t tstepA = 2 * hstepA, tstepB = 2 * hstepB;
    const unsigned ldsw = (unsigned)wid * 1024u;
    const int aoff = lds_byte(wr * 64 + fr, fq * 8), boff = lds_byte(wc * 32 + fr, fq * 8);
#define PG8_SA(b, h) (((b) * 2 + (h)) * HTB)
#define PG8_SB(b, h) ((4 + (b) * 2 + (h)) * HTB)
#define PG8_STAGE(bufoff, gbase, voff) do { _Pragma("unroll") for (int _i = 0; _i < 2; ++_i) \
        __builtin_amdgcn_global_load_lds((const unsigned*)((const char*)(gbase) + (voff)[_i]), (LAS unsigned*)(lds + (bufoff) + ldsw + _i * 8192), 16, 0, 0); } while (0)
#define PG8_LDA(dst, b, h) do { _Pragma("unroll") for (int m = 0; m < 4; ++m) _Pragma("unroll") for (int k = 0; k < 2; ++k) dst[m][k] = *(const LAS bf16x8*)(lds + PG8_SA(b, h) + aoff + m * 2048 + k * 1024); } while (0)
#define PG8_LDB(dst, b, h) do { _Pragma("unroll") for (int n = 0; n < 2; ++n) _Pragma("unroll") for (int k = 0; k < 2; ++k) dst[n][k] = *(const LAS bf16x8*)(lds + PG8_SB(b, h) + boff + n * 2048 + k * 1024); } while (0)
#define PG8_MMA(ai, bj, At, Bt) do { __builtin_amdgcn_s_setprio(1); _Pragma("unroll") for (int m = 0; m < 4; ++m) _Pragma("unroll") for (int n = 0; n < 2; ++n) _Pragma("unroll") for (int k = 0; k < 2; ++k) \
        acc[ai][bj][m][n] = __builtin_amdgcn_mfma_f32_16x16x32_bf16(Bt[n][k], At[m][k], acc[ai][bj][m][n], 0, 0, 0); __builtin_amdgcn_s_setprio(0); } while (0)
#define PG8_WAIT_V(n) asm volatile("s_waitcnt vmcnt(" #n ")" ::: "memory")
#define PG8_WAIT_L(n) asm volatile("s_waitcnt lgkmcnt(" #n ")" ::: "memory")
#define PG8_BAR __builtin_amdgcn_s_barrier()
#define PG8_SCHED __builtin_amdgcn_sched_barrier(0)
    Unit cur, nxt; int ui = 0;
    if (!S.next(0, cur)) return;
    f32x4 acc[2][2][4][2];
#pragma unroll
    for (int a = 0; a < 2; ++a)
#pragma unroll
        for (int b = 0; b < 2; ++b)
#pragma unroll
            for (int m = 0; m < 4; ++m)
#pragma unroll
                for (int n = 0; n < 2; ++n) acc[a][b][m][n] = (f32x4){0.f, 0.f, 0.f, 0.f};
    bf16x8 At[4][2], B0[2][2], B1[2][2];
    const char* cA = (const char*)g.A + (size_t)cur.pm * tstepA + (size_t)cur.ks * ksb; const char* cB = (const char*)g.Bt + (size_t)cur.pn * tstepB + (size_t)cur.ks * ksb;
    PG8_STAGE(PG8_SB(0, 0), cB, voffB); PG8_STAGE(PG8_SA(0, 0), cA, voffA); PG8_STAGE(PG8_SB(0, 1), cB + hstepB, voffB); PG8_STAGE(PG8_SA(0, 1), cA + hstepA, voffA);
    if (wr == 1) PG8_BAR;
    PG8_WAIT_V(4); PG8_BAR;
    PG8_STAGE(PG8_SB(1, 0), cB + kstep, voffB); PG8_STAGE(PG8_SA(1, 0), cA + kstep, voffA); PG8_STAGE(PG8_SB(1, 1), cB + hstepB + kstep, voffB);
    PG8_WAIT_V(6); PG8_BAR;
    for (;;) {
        const bool has_next = S.next(ui + 1, nxt);
        const char* nA = has_next ? (const char*)g.A + (size_t)nxt.pm * tstepA + (size_t)nxt.ks * ksb : cA; const char* nB = has_next ? (const char*)g.Bt + (size_t)nxt.pn * tstepB + (size_t)nxt.ks * ksb : cB;
        const int nt = cur.nt;
        for (int t = 0; t < nt; t += 2) {
            const bool last = (t == nt - 2);
            const char* a1 = cA + (size_t)(t + 1) * kstep;
            const char* a2 = last ? nA : cA + (size_t)(t + 2) * kstep; const char* b2 = last ? nB : cB + (size_t)(t + 2) * kstep;
            const char* a3 = a2 + kstep; const char* b3 = b2 + kstep;
            PG8_LDB(B0, 0, 0); PG8_SCHED; PG8_LDA(At, 0, 0); PG8_STAGE(PG8_SA(1, 1), a1 + hstepA, voffA);
            PG8_WAIT_L(8); PG8_BAR; PG8_WAIT_L(0); PG8_MMA(0, 0, At, B0); PG8_BAR; PG8_SCHED;
            PG8_LDB(B1, 0, 1); PG8_STAGE(PG8_SB(0, 0), b2, voffB);
            PG8_BAR; PG8_WAIT_L(0); PG8_MMA(0, 1, At, B1); PG8_BAR;
            PG8_LDA(At, 0, 1); PG8_STAGE(PG8_SA(0, 0), a2, voffA);
            PG8_BAR; PG8_WAIT_L(0); PG8_MMA(1, 0, At, B0); PG8_BAR; PG8_SCHED;
            PG8_STAGE(PG8_SB(0, 1), b2 + hstepB, voffB);
            PG8_WAIT_V(6); PG8_BAR; PG8_MMA(1, 1, At, B1); PG8_BAR;
            PG8_LDB(B0, 1, 0); PG8_SCHED; PG8_LDA(At, 1, 0); PG8_STAGE(PG8_SA(0, 1), a2 + hstepA, voffA);
            PG8_WAIT_L(8); PG8_BAR; PG8_WAIT_L(0); PG8_MMA(0, 0, At, B0); PG8_BAR; PG8_SCHED;
            PG8_LDB(B1, 1, 1); PG8_STAGE(PG8_SB(1, 0), b3, voffB);
            PG8_BAR; PG8_WAIT_L(0); PG8_MMA(0, 1, At, B1); PG8_BAR;
            PG8_LDA(At, 1, 1); PG8_STAGE(PG8_SA(1, 0), a3, voffA);
            PG8_BAR; PG8_WAIT_L(0); PG8_MMA(1, 0, At, B0); PG8_BAR; PG8_SCHED;
            PG8_STAGE(PG8_SB(1, 1), b3 + hstepB, voffB);
            PG8_WAIT_V(6); PG8_BAR; PG8_MMA(1, 1, At, B1); PG8_BAR;
        }
        E(acc, cur, wr, wc, fr, fq);
        if (!has_next) break;
#pragma unroll
        for (int a = 0; a < 2; ++a)
#pragma unroll
            for (int b = 0; b < 2; ++b)
#pragma unroll
                for (int m = 0; m < 4; ++m)
#pragma unroll
                    for (int n = 0; n < 2; ++n) acc[a][b][m][n] = (f32x4){0.f, 0.f, 0.f, 0.f};
        cur = nxt; cA = nA; cB = nB; ++ui;
    }
    PG8_WAIT_V(0);
    if (wr == 0) PG8_BAR;
    PG8_BAR;
#undef PG8_SA
#undef PG8_SB
#undef PG8_STAGE
#undef PG8_LDA
#undef PG8_LDB
#undef PG8_MMA
#undef PG8_WAIT_V
#undef PG8_WAIT_L
#undef PG8_BAR
#undef PG8_SCHED
}
}

struct EpiHgrnIn {
    static constexpr bool PERM = true;
    bf16_t* Z; const float* lbv; int lbzero;
    template <int MODE>
    __device__ __forceinline__ void run(const f32x4 (&acc)[2][2][4][2], const pg8::Unit& u, int wr, int wc, int fr, int fq) const {
        const int row0 = u.pm * 256 + wr * 64 + fr, col0 = u.pn * 256 + wc * 32 + 8 * fq;
        f32x4 lb[2][2], oml[2][2];
#pragma unroll
        for (int bj = 0; bj < 2; ++bj)
#pragma unroll
            for (int n = 0; n < 2; ++n) {
                lb[bj][n] = (MODE == 0) ? *(const f32x4*)(lbv + col0 + bj * 128 + 4 * n) : (f32x4){0.f, 0.f, 0.f, 0.f};
                oml[bj][n] = (f32x4){1.f, 1.f, 1.f, 1.f} - lb[bj][n];
            }
#pragma unroll
        for (int ai = 0; ai < 2; ++ai)
#pragma unroll
            for (int m = 0; m < 4; ++m) {
                bf16_t* rowp = Z + (size_t)(row0 + ai * 128 + m * 16) * 5120 + col0;
#pragma unroll
                for (int bj = 0; bj < 2; ++bj) {
                    float o[8];
#pragma unroll
                    for (int n = 0; n < 2; ++n)
#pragma unroll
                        for (int j = 0; j < 4; ++j) {
                            const float z = acc[ai][bj][m][n][j]; float r;
                            if (MODE == 0) { const float f = lb[bj][n][j] + oml[bj][n][j] * sigmoidf_(z); r = __builtin_amdgcn_logf(fmaxf(f, 1e-30f)); }
                            else if (MODE == 3) r = -__builtin_amdgcn_logf(1.0f + fminf(__builtin_amdgcn_exp2f(z * -1.44269504f), 1e30f));
                            else if (MODE == 1) r = z;
                            else r = siluf_(z);
                            o[n * 4 + j] = r;
                        }
                    u32x4 w; w.x = pk2(o[0], o[1]); w.y = pk2(o[2], o[3]); w.z = pk2(o[4], o[5]); w.w = pk2(o[6], o[7]);
                    *(u32x4*)(rowp + bj * 128) = w;
                }
            }
    }
    __device__ __forceinline__ void operator()(const f32x4 (&acc)[2][2][4][2], const pg8::Unit& u, int wr, int wc, int fr, int fq) const {
        const int part = u.pn >> 2;
        if (part < 2) { if (lbzero) run<3>(acc, u, wr, wc, fr, fq); else run<0>(acc, u, wr, wc, fr, fq); }
        else if (part == 2) run<1>(acc, u, wr, wc, fr, fq);
        else run<2>(acc, u, wr, wc, fr, fq);
    }
};
struct EpiConvIn {
    static constexpr bool PERM = true;
    bf16_t* Z;
    __device__ __forceinline__ void operator()(const f32x4 (&acc)[2][2][4][2], const pg8::Unit& u, int wr, int wc, int fr, int fq) const {
        const int row0 = u.pm * 256 + wr * 64 + fr;
        if (u.pn < 4) {
            const int col0 = u.pn * 256 + wc * 32 + 8 * fq;
#pragma unroll
            for (int ai = 0; ai < 2; ++ai)
#pragma unroll
                for (int m = 0; m < 4; ++m) {
                    bf16_t* rowp = Z + (size_t)(row0 + ai * 128 + m * 16) * 2048 + col0;
#pragma unroll
                    for (int bj = 0; bj < 2; ++bj) {
                        const f32x4 v0 = acc[ai][bj][m][0], v1 = acc[ai][bj][m][1];
                        u32x4 w; w.x = pk2(v0[0], v0[1]); w.y = pk2(v0[2], v0[3]); w.z = pk2(v1[0], v1[1]); w.w = pk2(v1[2], v1[3]);
                        *(u32x4*)(rowp + bj * 128) = w;
                    }
                }
        } else {
            const int col0 = 1024 + (u.pn - 4) * 128 + wc * 32 + 8 * fq;
#pragma unroll
            for (int ai = 0; ai < 2; ++ai)
#pragma unroll
                for (int m = 0; m < 4; ++m) {
                    bf16_t* rowp = Z + (size_t)(row0 + ai * 128 + m * 16) * 2048 + col0;
                    const f32x4 v0 = acc[ai][0][m][0] * acc[ai][1][m][0], v1 = acc[ai][0][m][1] * acc[ai][1][m][1];
                    u32x4 w; w.x = pk2(v0[0], v0[1]); w.y = pk2(v0[2], v0[3]); w.z = pk2(v1[0], v1[1]); w.w = pk2(v1[2], v1[3]);
                    *(u32x4*)rowp = w;
                }
        }
    }
};
struct EpiRelu2 {
    static constexpr bool PERM = true;
    bf16_t* Z;
    __device__ __forceinline__ void operator()(const f32x4 (&acc)[2][2][4][2], const pg8::Unit& u, int wr, int wc, int fr, int fq) const {
        const int row0 = u.pm * 256 + wr * 64 + fr, col0 = u.pn * 256 + wc * 32 + 8 * fq;
#pragma unroll
        for (int ai = 0; ai < 2; ++ai)
#pragma unroll
            for (int m = 0; m < 4; ++m) {
                bf16_t* rowp = Z + (size_t)(row0 + ai * 128 + m * 16) * 4096 + col0;
#pragma unroll
                for (int bj = 0; bj < 2; ++bj) {
                    float o[8];
#pragma unroll
                    for (int n = 0; n < 2; ++n)
#pragma unroll
                        for (int j = 0; j < 4; ++j) { const float x = acc[ai][bj][m][n][j]; o[n * 4 + j] = fmaxf(x * __builtin_fabsf(x), 0.f); }
                    u32x4 w; w.x = pk2(o[0], o[1]); w.y = pk2(o[2], o[3]); w.z = pk2(o[4], o[5]); w.w = pk2(o[6], o[7]);
                    *(u32x4*)(rowp + bj * 128) = w;
                }
            }
    }
};
struct EpiCtxPartial {
    static constexpr bool PERM = false;
    float* P;
    __device__ __forceinline__ void operator()(const f32x4 (&acc)[2][2][4][2], const pg8::Unit& u, int wr, int wc, int fr, int fq) const {
        const int row0 = (u.pm - 128) * 256 + wr * 64 + fr, col0 = u.pn * 256 + wc * 32 + 4 * fq;
        float* pp0 = P + ((size_t)u.ks * 1024 + row0) * DM + col0;
#pragma unroll
        for (int ai = 0; ai < 2; ++ai)
#pragma unroll
            for (int m = 0; m < 4; ++m) {
                float* pp = pp0 + (size_t)(ai * 128 + m * 16) * DM;
#pragma unroll
                for (int bj = 0; bj < 2; ++bj)
#pragma unroll
                    for (int n = 0; n < 2; ++n) *(f32x4*)(pp + bj * 128 + n * 16) = acc[ai][bj][m][n];
            }
    }
};
struct EpiResid {
    static constexpr bool PERM = false;
    float* X; const float* resL; const float* resC; const float* gate; float* P;
    __device__ __forceinline__ void operator()(const f32x4 (&acc)[2][2][4][2], const pg8::Unit& u, int wr, int wc, int fr, int fq) const {
        if (u.pm >= 128) { EpiCtxPartial EP{P}; EP(acc, u, wr, wc, fr, fq); return; }
        const int row0 = u.pm * 256 + wr * 64 + fr, col0 = u.pn * 256 + wc * 32 + 4 * fq;
        const int bb = u.pm >> 5;
        const float* gp = gate + (size_t)bb * 6144 + col0;
        f32x4 gv[2][2];
#pragma unroll
        for (int bj = 0; bj < 2; ++bj)
#pragma unroll
            for (int n = 0; n < 2; ++n) gv[bj][n] = *(const f32x4*)(gp + bj * 128 + n * 16);
#pragma unroll
        for (int ai = 0; ai < 2; ++ai) {
            f32x4 r[4][2][2];
#pragma unroll
            for (int m = 0; m < 4; ++m) {
                const float* rp = resL + (size_t)(row0 + ai * 128 + m * 16) * DM + col0;
#pragma unroll
                for (int bj = 0; bj < 2; ++bj)
#pragma unroll
                    for (int n = 0; n < 2; ++n) r[m][bj][n] = *(const f32x4*)(rp + bj * 128 + n * 16);
            }
#pragma unroll
            for (int m = 0; m < 4; ++m) {
                float* xp = X + (size_t)(row0 + ai * 128 + m * 16) * DM + col0;
#pragma unroll
                for (int bj = 0; bj < 2; ++bj)
#pragma unroll
                    for (int n = 0; n < 2; ++n) *(f32x4*)(xp + bj * 128 + n * 16) = r[m][bj][n] + gv[bj][n] * acc[ai][bj][m][n];
            }
            asm volatile("" ::: "memory");
        }
    }
};

__device__ __forceinline__ void phase_ada(const Params& p, LAS unsigned char* lds, float* mods, float* lbv) {
    int tid_ = threadIdx.x; asm volatile("" : "+v"(tid_)); const int tid = tid_;
    LAS float* s = (LAS float*)lds;
    LAS float* red = s + 5 * 1024;
    const float* c = p.in[1]; const float* cc = p.in[3];
    for (int i = tid; i < 5 * 1024; i += 512) { const int bb = i >> 10, k = i & 1023; const float v = bb < 4 ? c[bb * 1024 + k] : cc[k]; s[i] = siluf_(v); }
    __syncthreads();
    const int col = tid & 63, ks = tid >> 6;
    for (int item = blockIdx.x; item < 4 * 96; item += gridDim.x) {
        const int l = item / 96, n0 = (item % 96) * 64;
        const float* W = p.in[4] + (size_t)l * 1024 * 6144 + n0 + col;
        float a0 = 0.f, a1 = 0.f, a2 = 0.f, a3 = 0.f, a4 = 0.f;
#pragma unroll 8
        for (int k = ks * 128; k < ks * 128 + 128; ++k) {
            const float w = W[(size_t)k * 6144];
            a0 += s[k] * w; a1 += s[1024 + k] * w; a2 += s[2048 + k] * w; a3 += s[3072 + k] * w; a4 += s[4096 + k] * w;
        }
        red[(ks * 5 + 0) * 64 + col] = a0; red[(ks * 5 + 1) * 64 + col] = a1; red[(ks * 5 + 2) * 64 + col] = a2; red[(ks * 5 + 3) * 64 + col] = a3; red[(ks * 5 + 4) * 64 + col] = a4;
        __syncthreads();
        if (tid < 320) {
            const int bb = tid >> 6; float t = 0.f;
#pragma unroll
            for (int q = 0; q < 8; ++q) t += red[(q * 5 + bb) * 64 + col];
            mods[(size_t)(l * 5 + bb) * 6144 + n0 + col] = t + p.in[5][l * 6144 + n0 + col];
        }
        __syncthreads();
    }
    if (blockIdx.x == 0) {
        const float* hl = p.in[12];
        for (int i = tid; i < 2 * 1024; i += 512) {
            const int d = i >> 10, ch = i & 1023;
            const float a = hl[(d * 2 + 0) * 1024 + ch], b = hl[(d * 2 + 1) * 1024 + ch];
            const float m = fmaxf(a, b), ea = __expf(a - m), eb = __expf(b - m);
            lbv[(0 * 2 + d) * 1024 + ch] = 0.f;
            lbv[(1 * 2 + d) * 1024 + ch] = eb / (ea + eb);
        }
    }
}

__device__ __forceinline__ void cvt_slab(const float* src, int ld, int Kdim, bf16_t* dst, int nslab, int kslab, int mapmode, LAS float* T) {
    int tid_ = threadIdx.x; asm volatile("" : "+v"(tid_)); const int tid = tid_;
    const int n0 = nslab * 128, k0 = kslab * 128;
    int sc0 = n0;
    if (mapmode && n0 >= 1024) { const int t = (n0 - 1024) >> 8, w = (n0 - 1024) & 255; sc0 = (w < 128) ? 1024 + 128 * t + w : 2048 + 128 * t + (w - 128); }
    {
        const int kk = tid >> 5, n4 = (tid & 31) * 4;
        const float* sp = src + (size_t)(k0 + kk) * ld + sc0 + n4;
        f32x4 a[8];
#pragma unroll
        for (int i = 0; i < 8; ++i) a[i] = *(const f32x4*)(sp + (size_t)(i * 16) * ld);
#pragma unroll
        for (int i = 0; i < 8; ++i) { LAS float* tp = T + (kk + i * 16) * 129 + n4; tp[0] = a[i][0]; tp[1] = a[i][1]; tp[2] = a[i][2]; tp[3] = a[i][3]; }
    }
    __syncthreads();
    {
        const int nn = tid >> 2, kq = (tid & 3) * 32;
#pragma unroll
        for (int c = 0; c < 4; ++c) {
            float v[8];
#pragma unroll
            for (int i = 0; i < 8; ++i) v[i] = T[(kq + c * 8 + i) * 129 + nn];
            u32x4 w; w.x = pk2(v[0], v[1]); w.y = pk2(v[2], v[3]); w.z = pk2(v[4], v[5]); w.w = pk2(v[6], v[7]);
            *(u32x4*)(dst + (size_t)(n0 + nn) * Kdim + k0 + kq + c * 8) = w;
        }
    }
    __syncthreads();
}
__device__ __forceinline__ void phase_cvt(const Params& p, LAS unsigned char* lds, int L) {
    const int j = L >> 1; const bool rec = (L & 1) == 0;
    const int Nin = rec ? 5120 : 3072;
    const float* win = rec ? p.in[11] + (size_t)j * 1024 * 5120 : p.in[15] + (size_t)j * 1024 * 3072;
    const float* wout = rec ? p.in[14] + (size_t)j * 1024 * 1024 : p.in[18] + (size_t)j * 1024 * 1024;
    const float* w1 = p.in[9] + (size_t)L * 1024 * 4096;
    const float* w2 = p.in[10] + (size_t)L * 4096 * 1024;
    bf16_t* Win_t = (bf16_t*)(p.ws + WS_WIN); bf16_t* Wout_t = (bf16_t*)(p.ws + WS_WOUT); bf16_t* W1_t = (bf16_t*)(p.ws + WS_W1); bf16_t* W2_t = (bf16_t*)(p.ws + WS_W2);
    const int t0 = (Nin / 128) * 8, t1 = t0 + 64, t2 = t1 + 256, t3 = t2 + 256;
    LAS float* T = (LAS float*)lds;
    for (int it = blockIdx.x; it < t3; it += gridDim.x) {
        if (it < t0) cvt_slab(win, Nin, 1024, Win_t, it >> 3, it & 7, rec ? 0 : 1, T);
        else if (it < t1) { const int q = it - t0; cvt_slab(wout, 1024, 1024, Wout_t, q >> 3, q & 7, 0, T); }
        else if (it < t2) { const int q = it - t1; cvt_slab(w1, 4096, 1024, W1_t, q >> 3, q & 7, 0, T); }
        else { const int q = it - t2; cvt_slab(w2, 1024, 4096, W2_t, q >> 5, q & 31, 0, T); }
    }
}

__device__ __forceinline__ void phase_norm(const float* srcL, const float* srcC, int M, const float* gain, const float* mod, int shoff, int scoff, bf16_t* HA, float* Xcopy  , const float* P  , const float* pgate, float* Xw) {
    int tid_ = threadIdx.x; asm volatile("" : "+v"(tid_));
    const int lane = tid_ & 63, gw = blockIdx.x * 8 + (tid_ >> 6), nw = gridDim.x * 8;
    int colv[4];
#pragma unroll
    for (int i = 0; i < 4; ++i) colv[i] = (i >> 1) * 512 + lane * 8 + (i & 1) * 4;
    const bool xcdmap = (gridDim.x % 8 == 0) && (M >= ML);
#pragma unroll 1
    for (int seg = xcdmap ? 4 : 0; seg < (xcdmap ? 6 : 5); ++seg) {
        int bb, lo, hi, st, step;
        if (seg < 5) { bb = seg; lo = bb < 4 ? bb * SEQ : ML; hi = bb < 4 ? ((bb + 1) * SEQ < M ? (bb + 1) * SEQ : M) : M; st = gw; step = nw; }
        else { const int x = blockIdx.x & 7; bb = x >> 1; lo = 4096 * x; hi = lo + 4096; st = ((int)blockIdx.x >> 3) * 8 + (tid_ >> 6); step = ((int)gridDim.x >> 3) * 8; }
        if (lo + st >= hi) continue;
        const float* mp = mod + (size_t)bb * 6144;
        f32x4 wv[4], sv[4];
#pragma unroll
        for (int i = 0; i < 4; ++i) {
            const f32x4 g = *(const f32x4*)(gain + colv[i]), sc = *(const f32x4*)(mp + scoff + colv[i]);
            wv[i] = g * ((f32x4){1.f, 1.f, 1.f, 1.f} + sc); sv[i] = *(const f32x4*)(mp + shoff + colv[i]);
        }
        for (int r0 = lo + st; r0 < hi; r0 += 4 * step) {
            f32x4 v[4][4];
#pragma unroll
            for (int u = 0; u < 4; ++u) {
                const int r = r0 + u * step;
                if (r < hi) {
                    const float* xr = r < ML ? srcL + (size_t)r * DM : srcC + (size_t)(r - ML) * DM;
#pragma unroll
                    for (int i = 0; i < 4; ++i) v[u][i] = *(const f32x4*)(xr + colv[i]);
                }
            }
#pragma unroll
            for (int u = 0; u < 4; ++u) {
                const int r = r0 + u * step;
                if (r < hi) {
                    if (P != nullptr && r >= ML) {
                        f32x4 pa[4][4], pg[4];
#pragma unroll
                        for (int i = 0; i < 4; ++i) {
                            const float* pp = P + (size_t)(r - ML) * DM + colv[i];
#pragma unroll
                            for (int k = 0; k < 4; ++k) pa[i][k] = *(const f32x4*)(pp + (size_t)(k * 1024) * DM);
                            pg[i] = *(const f32x4*)(pgate + colv[i]);
                        }
#pragma unroll
                        for (int i = 0; i < 4; ++i) v[u][i] += pg[i] * ((pa[i][0] + pa[i][1]) + (pa[i][2] + pa[i][3]));
#pragma unroll
                        for (int i = 0; i < 4; ++i) *(f32x4*)(Xw + (size_t)r * DM + colv[i]) = v[u][i];
                    }
                    float ss = 0.f;
#pragma unroll
                    for (int i = 0; i < 4; ++i) ss += v[u][i][0] * v[u][i][0] + v[u][i][1] * v[u][i][1] + v[u][i][2] * v[u][i][2] + v[u][i][3] * v[u][i][3];
#pragma unroll
                    for (int o = 32; o >= 1; o >>= 1) ss += __shfl_xor(ss, o);
                    const float rstd = rsqrtf(ss * (1.0f / DM) + EPS);
                    if (Xcopy != nullptr && r >= ML) {
#pragma unroll
                        for (int i = 0; i < 4; ++i) *(f32x4*)(Xcopy + (size_t)r * DM + colv[i]) = v[u][i];
                    }
#pragma unroll
                    for (int hh = 0; hh < 2; ++hh) {
                        const f32x4 h0 = (v[u][2 * hh] * rstd) * wv[2 * hh] + sv[2 * hh], h1 = (v[u][2 * hh + 1] * rstd) * wv[2 * hh + 1] + sv[2 * hh + 1];
                        u32x4 w; w.x = pk2(h0[0], h0[1]); w.y = pk2(h0[2], h0[3]); w.z = pk2(h1[0], h1[1]); w.w = pk2(h1[2], h1[3]);
                        *(u32x4*)(HA + (size_t)r * DM + hh * 512 + lane * 8) = w;
                    }
                }
            }
        }
    }
}
__device__ __forceinline__ void phase_final(const float* X, const float* gain, float* out) {
    int tid_ = threadIdx.x; asm volatile("" : "+v"(tid_));
    const int lane = tid_ & 63, gw = blockIdx.x * 8 + (tid_ >> 6), nw = gridDim.x * 8;
    f32x4 gv[4];
#pragma unroll
    for (int i = 0; i < 4; ++i) gv[i] = *(const f32x4*)(gain + i * 256 + lane * 4);
    for (int r0 = gw; r0 < ML; r0 += 2 * nw) {
        f32x4 v[2][4];
#pragma unroll
        for (int u = 0; u < 2; ++u) { const int r = r0 + u * nw; if (r < ML) {
#pragma unroll
            for (int i = 0; i < 4; ++i) v[u][i] = *(const f32x4*)(X + (size_t)r * DM + i * 256 + lane * 4); } }
#pragma unroll
        for (int u = 0; u < 2; ++u) { const int r = r0 + u * nw; if (r < ML) {
            float ss = 0.f;
#pragma unroll
            for (int i = 0; i < 4; ++i) ss += v[u][i][0] * v[u][i][0] + v[u][i][1] * v[u][i][1] + v[u][i][2] * v[u][i][2] + v[u][i][3] * v[u][i][3];
#pragma unroll
            for (int o = 32; o >= 1; o >>= 1) ss += __shfl_xor(ss, o);
            const float rstd = rsqrtf(ss * (1.0f / DM) + EPS);
#pragma unroll
            for (int i = 0; i < 4; ++i) { const int col = i * 256 + lane * 4; *(f32x4*)(out + (size_t)r * DM + col) = v[u][i] * rstd * gv[i]; }
        } }
    }
}

__device__ __forceinline__ void phase_conv(const bf16_t* Z, const float* cw, const float* cb, int axis_rows, int M, bf16_t* HA) {
    int tid_ = threadIdx.x; asm volatile("" : "+v"(tid_));
    const int gt = blockIdx.x * 512 + tid_, nth = gridDim.x * 512;
    const int c8 = (gt & 127) * 8, rstep = nth >> 7;
    float w0[8], w1[8], w2[8], bs[8];
#pragma unroll
    for (int q = 0; q < 8; ++q) { bs[q] = cb[c8 + q]; w0[q] = cw[c8 + q]; w1[q] = cw[1024 + c8 + q]; w2[q] = cw[2048 + c8 + q]; }
    for (int r0 = gt >> 7; r0 < M; r0 += 4 * rstep) {
        u32x4 uc[4], upv[4], unv[4], gb[4];
#pragma unroll
        for (int k = 0; k < 4; ++k) {
            const int r = r0 + k * rstep;
            upv[k] = (u32x4){0u, 0u, 0u, 0u}; unv[k] = (u32x4){0u, 0u, 0u, 0u};
            if (r < M) {
                int dlt; bool hasp, hasn;
                if (r < ML) {
                    const int t = r & (SEQ - 1);
                    if (axis_rows) { dlt = 64; const int gr = t >> 6; hasp = gr > 0; hasn = gr < 127; }
                    else { dlt = 1; const int gc = t & 63; hasp = gc > 0; hasn = gc < 63; }
                } else { dlt = 1; const int t = (r - ML) & (CTXL - 1); hasp = t > 0; hasn = t < CTXL - 1; }
                const bf16_t* up = Z + (size_t)r * 2048 + 1024 + c8;
                uc[k] = *(const u32x4*)up;
                if (hasp) upv[k] = *(const u32x4*)(up - (size_t)dlt * 2048);
                if (hasn) unv[k] = *(const u32x4*)(up + (size_t)dlt * 2048);
                gb[k] = *(const u32x4*)(Z + (size_t)r * 2048 + c8);
            }
        }
#pragma unroll
        for (int k = 0; k < 4; ++k) {
            const int r = r0 + k * rstep;
            if (r < M) {
                float o[8];
#pragma unroll
                for (int q2 = 0; q2 < 4; ++q2) {
                    const unsigned a = upv[k][q2], b = uc[k][q2], c = unv[k][q2], g = gb[k][q2];
                    o[2 * q2] = bflo(g) * (bs[2 * q2] + w0[2 * q2] * bflo(a) + w1[2 * q2] * bflo(b) + w2[2 * q2] * bflo(c));
                    o[2 * q2 + 1] = bfhi(g) * (bs[2 * q2 + 1] + w0[2 * q2 + 1] * bfhi(a) + w1[2 * q2 + 1] * bfhi(b) + w2[2 * q2 + 1] * bfhi(c));
                }
                u32x4 w; w.x = pk2(o[0], o[1]); w.y = pk2(o[2], o[3]); w.z = pk2(o[4], o[5]); w.w = pk2(o[6], o[7]);
                *(u32x4*)(HA + (size_t)r * DM + c8) = w;
            }
        }
    }
}

constexpr int G_QT = 0, G_KT = 17408, G_KTT = 34816, G_VTT = 53248, G_PP = 71680, G_STT = 80896, G_TOT = 115712, G_SSQ = 119808;
constexpr int PQ = 136, PT = 72;

__device__ __forceinline__ f32x4 mfma16(bf16x8 a, bf16x8 b, f32x4 c) { return __builtin_amdgcn_mfma_f32_16x16x32_bf16(a, b, c, 0, 0, 0); }
#define LBAR() do { asm volatile("s_waitcnt lgkmcnt(0)" ::: "memory"); __builtin_amdgcn_s_barrier(); asm volatile("" ::: "memory"); } while (0)

struct GlaPF { unsigned g[8], v[8], q[8]; };
template <bool OUT>
__device__ __forceinline__ void gla_prefetch(GlaPF& pf, const bf16_t* Z, int row0, int gcol  , int h, int tid) {
    const bf16_t* zr = Z + (size_t)(row0 + (tid >> 6) * 8) * 5120 + h * 128 + 2 * (tid & 63);
#pragma unroll
    for (int i = 0; i < 8; ++i) {
        pf.g[i] = *(const unsigned*)(zr + (size_t)i * 5120 + gcol);
        pf.v[i] = *(const unsigned*)(zr + (size_t)i * 5120 + 2048);
        if (OUT) pf.q[i] = *(const unsigned*)(zr + (size_t)i * 5120 + 3072);
    }
}

template <bool OUT, int D>
__device__ __forceinline__ void gla_chunk(LAS unsigned char* lds, bf16_t* Z, int row0, int h, f32x4 (&S)[8], float (&lastsum)[2], const f32x4 (&gnv)[4]  ,
                                          GlaPF& pf, bool has_next, int nrow0, int ngcol, int nh) {
    int tid_ = threadIdx.x; asm volatile("" : "+v"(tid_));
    const int tid = tid_, lane = tid & 63, w = __builtin_amdgcn_readfirstlane(tid >> 6);
    const int cp = lane, tg = w;
    const int l15 = lane & 15, lq = lane >> 4;
    LAS bf16_t* QT = (LAS bf16_t*)(lds + G_QT); LAS bf16_t* KT = (LAS bf16_t*)(lds + G_KT); LAS bf16_t* KTT = (LAS bf16_t*)(lds + G_KTT);
    LAS bf16_t* VTT = (LAS bf16_t*)(lds + G_VTT); LAS bf16_t* PP = (LAS bf16_t*)(lds + G_PP); LAS bf16_t* STT = (LAS bf16_t*)(lds + G_STT);
    LAS float* TOT = (LAS float*)(lds + G_TOT); LAS float* SSQ = (LAS float*)(lds + G_SSQ);
    f32x2 f2[8];
    {
        f32x2 tot2 = (f32x2){0.f, 0.f};
#pragma unroll
        for (int i = 0; i < 8; ++i) { const f32x2 g2 = (f32x2){bflo(pf.g[i]), bfhi(pf.g[i])}; tot2 += g2; f2[i] = (f32x2){__builtin_amdgcn_exp2f(g2.x), __builtin_amdgcn_exp2f(g2.y)}; }
        *(LAS f32x2*)(TOT + tg * 128 + 2 * cp) = tot2;
    }
    LBAR();
    {
        f32x2 pre2 = (f32x2){0.f, 0.f}, ref2 = (f32x2){0.f, 0.f}, all2 = (f32x2){0.f, 0.f};
#pragma unroll
        for (int t = 0; t < 8; ++t) {
            const f32x2 tv = *(const LAS f32x2*)(TOT + t * 128 + 2 * cp);
            all2 += tv;
            const bool inref = (D == 0) ? (t < 4) : (t >= 4);
            if (inref) ref2 += tv;
            const bool inpre = (D == 0) ? (t < tg) : (t > tg);
            pre2 += inpre ? tv : (f32x2){0.f, 0.f};
        }
        if (tg == 0) { lastsum[0] += all2.x; lastsum[1] += all2.y; }
        f32x2 kt[8];
        {
            f32x2 p2 = all2 - pre2 - (*(const LAS f32x2*)(TOT + tg * 128 + 2 * cp));
            if (OUT) { p2 += ref2 - all2; p2.x = fminf(p2.x, 100.f); p2.y = fminf(p2.y, 100.f); }
            f32x2 wq = (f32x2){__builtin_amdgcn_exp2f(p2.x), __builtin_amdgcn_exp2f(p2.y)};
#pragma unroll
            for (int u = 0; u < 8; ++u) {
                const int ii = (D == 0) ? 7 - u : u;
                kt[ii] = ((f32x2){1.0f, 1.0f} - f2[ii]) * wq;
                wq *= f2[ii];
            }
        }
        const f32x2 d2 = pre2 - ref2;
        f32x2 e1 = (f32x2){__builtin_amdgcn_exp2f(d2.x), __builtin_amdgcn_exp2f(d2.y)};
#pragma unroll
        for (int u = 0; OUT && u < 8; ++u) {
            const int ii = (D == 0) ? u : 7 - u;
            e1 *= f2[ii];
            if (OUT) {
                const int t = tg * 8 + ii;
                const f32x2 qt = (f32x2){bflo(pf.q[ii]), bfhi(pf.q[ii])} * e1;
                *(LAS unsigned*)(QT + t * PQ + 2 * cp) = pk2(qt.x, qt.y);
                *(LAS unsigned*)(KT + t * PQ + 2 * cp) = pk2(kt[ii].x, kt[ii].y);
            }
        }
        unsigned kp0[4], kp1[4], vp0[4], vp1[4];
#pragma unroll
        for (int i = 0; i < 8; i += 2) {
            kp0[i >> 1] = pk2(kt[i].x, kt[i + 1].x); kp1[i >> 1] = pk2(kt[i].y, kt[i + 1].y);
            vp0[i >> 1] = (pf.v[i] & 0xFFFFu) | (pf.v[i + 1] << 16); vp1[i >> 1] = (pf.v[i] >> 16) | (pf.v[i + 1] & 0xFFFF0000u);
        }
        *(LAS u32x4*)(KTT + (2 * cp) * PT + tg * 8) = (u32x4){kp0[0], kp0[1], kp0[2], kp0[3]};
        *(LAS u32x4*)(KTT + (2 * cp + 1) * PT + tg * 8) = (u32x4){kp1[0], kp1[1], kp1[2], kp1[3]};
        *(LAS u32x4*)(VTT + (2 * cp) * PT + tg * 8) = (u32x4){vp0[0], vp0[1], vp0[2], vp0[3]};
        *(LAS u32x4*)(VTT + (2 * cp + 1) * PT + tg * 8) = (u32x4){vp1[0], vp1[1], vp1[2], vp1[3]};
    }
    float el[4];
    {
        f32x4 rs = (f32x4){0.f, 0.f, 0.f, 0.f}, ls = (f32x4){0.f, 0.f, 0.f, 0.f};
#pragma unroll
        for (int t = 0; t < 8; ++t) {
            const f32x4 tv = *(const LAS f32x4*)(TOT + t * 128 + 16 * w + lq * 4);
            const bool inref = (D == 0) ? (t < 4) : (t >= 4);
            if (inref) rs += tv; else ls += tv;
        }
        float er[4];
#pragma unroll
        for (int j = 0; j < 4; ++j) {
            if (OUT) { er[j] = __builtin_amdgcn_exp2f(rs[j]); el[j] = __builtin_amdgcn_exp2f(ls[j]); }
            else { er[j] = __builtin_amdgcn_exp2f(rs[j] + ls[j]); el[j] = 1.0f; }
        }
#pragma unroll
        for (int vt = 0; vt < 8; ++vt) {
#pragma unroll
            for (int j = 0; j < 4; ++j) S[vt][j] *= er[j];
            if (OUT) { u32x2 wv; wv.x = pk2(S[vt][0], S[vt][1]); wv.y = pk2(S[vt][2], S[vt][3]);
                *(LAS u32x2*)(STT + (16 * vt + l15) * PQ + 16 * w + lq * 4) = wv; }
        }
    }
    if (has_next) gla_prefetch<OUT>(pf, Z, nrow0, ngcol, nh, tid);
    const int rt = w & 3, vh = (w >> 2) * 4;
    bf16_t* zo = Z + (size_t)(row0 + 16 * rt + l15) * 5120 + h * 128 + 16 * vh + 4 * lq;
    u32x2 ofw[4], gat[4];
    if (OUT && D == 1) {
#pragma unroll
        for (int i = 0; i < 4; ++i) { ofw[i] = *(const u32x2*)(zo + 16 * i); gat[i] = *(const u32x2*)(zo + 4096 + 16 * i); }
    }
    LBAR();
    __builtin_amdgcn_s_setprio(1);
    if (OUT) {
        const int st = w >> 1, ct0 = (w & 1) * 2;
#pragma unroll
        for (int i = 0; i < 2; ++i) {
            const int ct = ct0 + i;
            f32x4 a = (f32x4){0.f, 0.f, 0.f, 0.f};
            const bool zero = (D == 0) ? (st > ct) : (st < ct);
            if (!zero) {
#pragma unroll
                for (int ks = 0; ks < 4; ++ks) {
                    const bf16x8 fa = *(const LAS bf16x8*)(KT + (16 * st + l15) * PQ + ks * 32 + lq * 8);
                    const bf16x8 fb = *(const LAS bf16x8*)(QT + (16 * ct + l15) * PQ + ks * 32 + lq * 8);
                    a = mfma16(fa, fb, a);
                }
                const int cc = 16 * ct + l15;
#pragma unroll
                for (int j = 0; j < 4; ++j) { const int ss = 16 * st + lq * 4 + j; const bool keep = (D == 0) ? (ss <= cc) : (ss >= cc); a[j] = keep ? a[j] : 0.f; }
            }
            u32x2 wv; wv.x = pk2(a[0], a[1]); wv.y = pk2(a[2], a[3]);
            *(LAS u32x2*)(PP + (16 * ct + l15) * PT + 16 * st + lq * 4) = wv;
        }
    }
    {
        bf16x8 fa[2];
#pragma unroll
        for (int ks = 0; ks < 2; ++ks) fa[ks] = *(const LAS bf16x8*)(KTT + (16 * w + l15) * PT + ks * 32 + lq * 8);
#pragma unroll
        for (int vt = 0; vt < 8; ++vt) {
#pragma unroll
            for (int ks = 0; ks < 2; ++ks) {
                const bf16x8 fb = *(const LAS bf16x8*)(VTT + (16 * vt + l15) * PT + ks * 32 + lq * 8);
                S[vt] = mfma16(fa[ks], fb, S[vt]);
            }
            if (OUT) {
#pragma unroll
                for (int j = 0; j < 4; ++j) S[vt][j] *= el[j];
            }
        }
    }
    if (!OUT) __builtin_amdgcn_s_setprio(0);
    if (OUT) {
        f32x4 o[4];
#pragma unroll
        for (int i = 0; i < 4; ++i) o[i] = (f32x4){0.f, 0.f, 0.f, 0.f};
#pragma unroll
        for (int ks = 0; ks < 4; ++ks) {
            const bf16x8 fb = *(const LAS bf16x8*)(QT + (16 * rt + l15) * PQ + ks * 32 + lq * 8);
#pragma unroll
            for (int i = 0; i < 4; ++i) { const bf16x8 fa = *(const LAS bf16x8*)(STT + (16 * (vh + i) + l15) * PQ + ks * 32 + lq * 8); o[i] = mfma16(fa, fb, o[i]); }
        }
        LBAR();
#pragma unroll
        for (int ks = 0; ks < 2; ++ks) {
            const bf16x8 fb = *(const LAS bf16x8*)(PP + (16 * rt + l15) * PT + ks * 32 + lq * 8);
#pragma unroll
            for (int i = 0; i < 4; ++i) { const bf16x8 fa = *(const LAS bf16x8*)(VTT + (16 * (vh + i) + l15) * PT + ks * 32 + lq * 8); o[i] = mfma16(fa, fb, o[i]); }
        }
        __builtin_amdgcn_s_setprio(0);
        if (D == 0) {
#pragma unroll
            for (int i = 0; i < 4; ++i) { u32x2 wv; wv.x = pk2(o[i][0], o[i][1]); wv.y = pk2(o[i][2], o[i][3]); *(u32x2*)(zo + 16 * i) = wv; }
        } else {
            float sq = 0.f;
#pragma unroll
            for (int i = 0; i < 4; ++i) {
                o[i][0] += bflo(ofw[i].x); o[i][1] += bfhi(ofw[i].x); o[i][2] += bflo(ofw[i].y); o[i][3] += bfhi(ofw[i].y);
                sq += o[i][0] * o[i][0] + o[i][1] * o[i][1] + o[i][2] * o[i][2] + o[i][3] * o[i][3];
            }
            sq += __shfl_xor(sq, 16); sq += __shfl_xor(sq, 32);
            if (lq == 0) SSQ[(w >> 2) * 64 + 16 * rt + l15] = sq;
            LBAR();
            const float rstd = rsqrtf((SSQ[16 * rt + l15] + SSQ[64 + 16 * rt + l15]) * (1.0f / 128.0f) + EPS);
#pragma unroll
            for (int i = 0; i < 4; ++i) {
                const f32x4 gn = gnv[i];
                const float y0 = o[i][0] * rstd * gn[0] * bflo(gat[i].x), y1 = o[i][1] * rstd * gn[1] * bfhi(gat[i].x);
                const float y2 = o[i][2] * rstd * gn[2] * bflo(gat[i].y), y3 = o[i][3] * rstd * gn[3] * bfhi(gat[i].y);
                u32x2 wv; wv.x = pk2(y0, y1); wv.y = pk2(y2, y3);
                *(u32x2*)(zo + 1024 + 16 * i) = wv;
            }
        }
    }
}

__device__ __forceinline__ int sc_rowbase(int b, int jsc) { return jsc == 0 ? ML + b * CTXL : b * SEQ + (jsc - 1) * 256; }

__device__ __forceinline__ void phase_gla1(LAS unsigned char* lds, bf16_t* Z, unsigned* Sbuf, float* Dbuf) {
    int tid_ = threadIdx.x; asm volatile("" : "+v"(tid_));
    const int tid = tid_, lane = tid & 63, w = __builtin_amdgcn_readfirstlane(tid >> 6);
    GlaPF pf;
    int task = blockIdx.x;
    if (task < 2048) {
        const int bhd = task >> 5, p = task & 31, b = bhd >> 4, h = (bhd >> 1) & 7, d = bhd & 1;
        const int jsc = (p == 0) ? 0 : (d == 0 ? p : 33 - p);
        gla_prefetch<false>(pf, Z, sc_rowbase(b, jsc) + (d ? 192 : 0), d * 1024, h, tid);
    }
    for (; task < 2048; task += gridDim.x) {
        const int bhd = task >> 5, p = task & 31, b = bhd >> 4, h = (bhd >> 1) & 7, d = bhd & 1;
        const int jsc = (p == 0) ? 0 : (d == 0 ? p : 33 - p);
        const int rb = sc_rowbase(b, jsc);
        const int nt = task + gridDim.x; const bool hn = nt < 2048;
        int nrow = 0, ngc = 0, nh = 0;
        if (hn) { const int nbhd = nt >> 5, np = nt & 31, nb = nbhd >> 4, nd = nbhd & 1; nh = (nbhd >> 1) & 7;
            const int nj = (np == 0) ? 0 : (nd == 0 ? np : 33 - np); nrow = sc_rowbase(nb, nj) + (nd ? 192 : 0); ngc = nd * 1024; }
        f32x4 S[8];
#pragma unroll
        for (int vt = 0; vt < 8; ++vt) S[vt] = (f32x4){0.f, 0.f, 0.f, 0.f};
        float lastsum[2] = {0.f, 0.f};
        const f32x4 gdum[4] = {(f32x4){0.f, 0.f, 0.f, 0.f}, (f32x4){0.f, 0.f, 0.f, 0.f}, (f32x4){0.f, 0.f, 0.f, 0.f}, (f32x4){0.f, 0.f, 0.f, 0.f}};
        if (d == 0) {
#pragma unroll 1
            for (int ci = 0; ci < 4; ++ci) { const bool last = ci == 3; gla_chunk<false, 0>(lds, Z, rb + ci * 64, h, S, lastsum, gdum, pf, last ? hn : true, last ? nrow : rb + (ci + 1) * 64, last ? ngc : 0, last ? nh : h); }
        } else {
#pragma unroll 1
            for (int ci = 3; ci >= 0; --ci) { const bool last = ci == 0; gla_chunk<false, 1>(lds, Z, rb + ci * 64, h, S, lastsum, gdum, pf, last ? hn : true, last ? nrow : rb + (ci - 1) * 64, last ? ngc : 1024, last ? nh : h); }
        }
        unsigned* sp = Sbuf + (size_t)task * 8192;
#pragma unroll
        for (int vt = 0; vt < 8; ++vt)
#pragma unroll
            for (int jp = 0; jp < 2; ++jp) sp[((w * 8 + vt) * 2 + jp) * 64 + lane] = pk2(S[vt][2 * jp], S[vt][2 * jp + 1]);
        if (tid < 64) *(f32x2*)(Dbuf + (size_t)task * 128 + 2 * tid) = (f32x2){__builtin_amdgcn_exp2f(lastsum[0]), __builtin_amdgcn_exp2f(lastsum[1])};
        LBAR();
    }
}
__device__ __forceinline__ void gla3_task(LAS unsigned char* lds, bf16_t* Z, const unsigned* Sbuf, const float* gnorm, int bh, int jsc, GlaPF& pf, bool hn, int nrow, int nh) {
    int tid_ = threadIdx.x; asm volatile("" : "+v"(tid_));
    const int tid = tid_, lane = tid & 63, w = __builtin_amdgcn_readfirstlane(tid >> 6);
    const int b = bh >> 3, h = bh & 7;
    const int rb = sc_rowbase(b, jsc);
    float dummy[2] = {0.f, 0.f};
    f32x4 S[8], Sb[8];
    f32x4 gnv[4];
    { const int lq = lane >> 4, vh = (w >> 2) * 4;
#pragma unroll
      for (int i = 0; i < 4; ++i) gnv[i] = *(const f32x4*)(gnorm + h * 128 + 16 * (vh + i) + 4 * lq); }
    {
        const int pf_ = jsc, pb_ = (jsc == 0) ? 0 : 33 - jsc;
        if (pf_ == 0) {
#pragma unroll
            for (int vt = 0; vt < 8; ++vt) { S[vt] = (f32x4){0.f, 0.f, 0.f, 0.f}; Sb[vt] = (f32x4){0.f, 0.f, 0.f, 0.f}; }
        } else {
            const unsigned* sp = Sbuf + ((size_t)((bh * 2 + 0) * 32 + (pf_ - 1))) * 8192;
            const unsigned* sq = Sbuf + ((size_t)((bh * 2 + 1) * 32 + (pb_ - 1))) * 8192;
#pragma unroll
            for (int vt = 0; vt < 8; ++vt)
#pragma unroll
                for (int jp = 0; jp < 2; ++jp) {
                    const unsigned a = sp[((w * 8 + vt) * 2 + jp) * 64 + lane], b = sq[((w * 8 + vt) * 2 + jp) * 64 + lane];
                    S[vt][2 * jp] = bflo(a); S[vt][2 * jp + 1] = bfhi(a); Sb[vt][2 * jp] = bflo(b); Sb[vt][2 * jp + 1] = bfhi(b);
                }
        }
    }
#pragma unroll 1
    for (int ci = 0; ci < 4; ++ci) { const bool last = ci == 3; gla_chunk<true, 0>(lds, Z, rb + ci * 64, h, S, dummy, gnv, pf, true, last ? rb + 192 : rb + (ci + 1) * 64, last ? 1024 : 0, h); }
#pragma unroll
    for (int vt = 0; vt < 8; ++vt) S[vt] = Sb[vt];
    asm volatile("s_waitcnt vmcnt(0)" ::: "memory");
    __builtin_amdgcn_fence(__ATOMIC_ACQUIRE, "agent");
    LBAR();
#pragma unroll 1
    for (int ci = 3; ci >= 0; --ci) { const bool last = ci == 0; gla_chunk<true, 1>(lds, Z, rb + ci * 64, h, S, dummy, gnv, pf, last ? hn : true, last ? nrow : rb + (ci - 1) * 64, last ? 0 : 1024, last ? nh : h); }
    asm volatile("s_waitcnt vmcnt(0)" ::: "memory");
    LBAR();
}
__device__ __forceinline__ void phase_gla2(LAS unsigned char* lds, bf16_t* Z, unsigned* Sbuf, const float* Dbuf, const float* gnorm, int with_ctx) {
    int tid_ = threadIdx.x; asm volatile("" : "+v"(tid_));
    int bx = blockIdx.x, nb = gridDim.x;
    if (with_ctx && nb > 64) {
        if (bx < 32) { GlaPF pf; gla_prefetch<true>(pf, Z, sc_rowbase(bx >> 3, 0), 0, bx & 7, tid_); gla3_task(lds, Z, Sbuf, gnorm, bx, 0, pf, false, 0, 0); return; }
        bx -= 32; nb -= 32;
    }
    const int gt = bx * 512 + tid_, nth = nb * 512;
    for (int idx = gt; idx < 64 * 2048; idx += nth) {
        const int bhd = idx >> 11, e8 = idx & 2047, e = e8 * 4;
        const int k = 16 * (e >> 10) + ((e & 63) >> 4) * 4 + 2 * ((e >> 6) & 1);
        f32x4 slo = (f32x4){0.f, 0.f, 0.f, 0.f}, shi = (f32x4){0.f, 0.f, 0.f, 0.f};
        u32x4* sp = (u32x4*)(Sbuf + (size_t)bhd * 32 * 8192) + e8;
        const float* dp = Dbuf + (size_t)bhd * 32 * 128 + k;
#pragma unroll 1
        for (int p0 = 0; p0 < 32; p0 += 16) {
            f32x2 dd[16]; u32x4 a[16];
#pragma unroll
            for (int q = 0; q < 16; ++q) { dd[q] = *(const f32x2*)(dp + (p0 + q) * 128); a[q] = sp[(size_t)(p0 + q) * 2048]; }
#pragma unroll
            for (int q = 0; q < 16; ++q) {
                slo = slo * dd[q].x + (f32x4){bflo(a[q].x), bflo(a[q].y), bflo(a[q].z), bflo(a[q].w)};
                shi = shi * dd[q].y + (f32x4){bfhi(a[q].x), bfhi(a[q].y), bfhi(a[q].z), bfhi(a[q].w)};
                u32x4 o; o.x = pk2(slo[0], shi[0]); o.y = pk2(slo[1], shi[1]); o.z = pk2(slo[2], shi[2]); o.w = pk2(slo[3], shi[3]);
                sp[(size_t)(p0 + q) * 2048] = o;
            }
        }
    }
}
__device__ __forceinline__ void phase_gla3(LAS unsigned char* lds, bf16_t* Z, const unsigned* Sbuf, const float* gnorm, int with_ctx) {
    int tid_ = threadIdx.x; asm volatile("" : "+v"(tid_));
    const int tid = tid_;
    const int jlo = (with_ctx && gridDim.x <= 64) ? 0 : 1, nj = 33 - jlo, ntask = 32 * nj;
    GlaPF pf;
    int task = blockIdx.x;
    if (task < ntask) { const int bh = task / nj, jsc = jlo + task % nj; gla_prefetch<true>(pf, Z, sc_rowbase(bh >> 3, jsc), 0, bh & 7, tid); }
    for (; task < ntask; task += gridDim.x) {
        const int bh = task / nj, jsc = jlo + task % nj;
        const int nt = task + gridDim.x; const bool hn = nt < ntask;
        int nrow = 0, nh = 0;
        if (hn) { const int nbh = nt / nj, njsc = jlo + nt % nj; nrow = sc_rowbase(nbh >> 3, njsc); nh = nbh & 7; }
        gla3_task(lds, Z, Sbuf, gnorm, bh, jsc, pf, hn, nrow, nh);
    }
}

#define XB_TMO      128
#define XB_XCNT(j)  (256  + 64 * (j))
#define XB_XSUB(j)  (1280 + 64 * (j))
#define XB_XGEN(j)  (2304 + 64 * (j))
#define XB_TOP      3328
#define XB_TOPGEN   3392
#define XCD_BAR_WORDS 3456
#define XB_SPIN_CAP (1u << 22)
__device__ __forceinline__ unsigned xb_ld(unsigned* p)              { return __hip_atomic_load(p, __ATOMIC_RELAXED, __HIP_MEMORY_SCOPE_AGENT); }
__device__ __forceinline__ unsigned xb_add(unsigned* p, unsigned v) { return __hip_atomic_fetch_add(p, v, __ATOMIC_RELAXED, __HIP_MEMORY_SCOPE_AGENT); }
__device__ __forceinline__ unsigned xb_xcc_id() { return (unsigned)__builtin_amdgcn_s_getreg((3 << 11) | 20) & 0xFu; }
#define XB_SPIN(cond, bar) do { unsigned _sp = 0; while (cond) { __builtin_amdgcn_s_sleep(1); \
    if ((++_sp & 255u) == 0u) { if (xb_ld(&(bar)[XB_TMO])) break; if (_sp > XB_SPIN_CAP) { atomicAdd(&(bar)[XB_TMO], 1u); break; } } } } while (0)
struct XcdBarrier { unsigned* bar; unsigned x; volatile LAS unsigned* st; };
__device__ __forceinline__ XcdBarrier xcd_barrier_post(unsigned* bar, volatile LAS unsigned* st) {
    XcdBarrier b; b.bar = bar; b.x = xb_xcc_id(); b.st = st;
    if (threadIdx.x == 0) (void)xb_add(&bar[XB_XCNT(b.x)], 1u);
    return b;
}
__device__ __forceinline__ void xcd_barrier_complete(unsigned* bar, unsigned x, unsigned& nloc, unsigned& nx) {
    const unsigned G = gridDim.x * gridDim.y * gridDim.z;
    unsigned sum, cnt, mine, sp = 0u;
    for (;;) {
        sum = 0u; cnt = 0u; mine = 0u;
#pragma unroll
        for (unsigned j = 0; j < 16; ++j) { const unsigned c = xb_ld(&bar[XB_XCNT(j)]); sum += c; cnt += (c > 0u) ? 1u : 0u; mine = (j == x) ? c : mine; }
        if (sum == G) break;
        __builtin_amdgcn_s_sleep(1);
        if ((++sp & 255u) == 0u) { if (xb_ld(&bar[XB_TMO])) break; if (sp > XB_SPIN_CAP) { atomicAdd(&bar[XB_TMO], 1u); break; } }
    }
    nloc = mine > 0u ? mine : 1u; nx = cnt > 0u ? cnt : 1u;
}
__device__ __forceinline__ void xcd_barrier(const XcdBarrier& b) {
    asm volatile("s_waitcnt vmcnt(0)" ::: "memory");
    __syncthreads();
    if (threadIdx.x == 0) {
        unsigned* bar = b.bar;
        __builtin_amdgcn_s_waitcnt(0);
        unsigned nloc = b.st[0], nx = b.st[1];
        if (nloc == 0u) { xcd_barrier_complete(bar, b.x, nloc, nx); b.st[0] = nloc; b.st[1] = nx; }
        const unsigned old = xb_add(&bar[XB_XSUB(b.x)], 1u);
        const unsigned gen = old / nloc;
        if (old + 1u == (gen + 1u) * nloc) {
            __builtin_amdgcn_fence(__ATOMIC_RELEASE, "agent");
            asm volatile("s_waitcnt vmcnt(0)" ::: "memory");
            const unsigned og = xb_add(&bar[XB_TOP], 1u);
            const unsigned tg = og / nx;
            if (og + 1u == (tg + 1u) * nx) xb_add(&bar[XB_TOPGEN], 1u);
            else XB_SPIN(xb_ld(&bar[XB_TOPGEN]) == tg, bar);
            __builtin_amdgcn_fence(__ATOMIC_ACQUIRE, "agent");
            xb_add(&bar[XB_XGEN(b.x)], 1u);
            asm volatile("s_waitcnt vmcnt(0)" ::: "memory");
        } else {
            XB_SPIN(xb_ld(&bar[XB_XGEN(b.x)]) == gen, bar);
            __builtin_amdgcn_fence(__ATOMIC_ACQUIRE, "agent");
            asm volatile("s_waitcnt vmcnt(0)" ::: "memory");
        }
    }
    __syncthreads();
}

#ifndef PROBE_MASK
#define PROBE_MASK 0
#endif
#define TS(cat) do { if (PROBE_MASK) { const unsigned long long _t = __builtin_amdgcn_s_memrealtime(); if ((PROBE_MASK >> (cat)) & 1) pdelay += _t - tprev; tprev = _t; } } while (0)

__global__ void __launch_bounds__(512, 2) mega_fwd(Params p) {
    extern __shared__ __attribute__((aligned(16))) unsigned char lds_raw[];
    LAS unsigned char* lds = (LAS unsigned char*)lds_raw;
    cg::grid_group grid = cg::this_grid();
    unsigned char* ws = p.ws;
    float* X = (float*)(ws + WS_X); bf16_t* Z = (bf16_t*)(ws + WS_Z);
    bf16_t* Win_t = (bf16_t*)(ws + WS_WIN); bf16_t* Wout_t = (bf16_t*)(ws + WS_WOUT); bf16_t* W1_t = (bf16_t*)(ws + WS_W1); bf16_t* W2_t = (bf16_t*)(ws + WS_W2);
    float* Dbuf = (float*)(ws + WS_DB); float* mods = (float*)(ws + WS_MOD); float* lbv = (float*)(ws + WS_LB);
    bf16_t* HA = (bf16_t*)p.out;
    unsigned* Sbuf = (unsigned*)p.out;
    const int G = gridDim.x, bx = blockIdx.x;

    volatile LAS unsigned* xst = (volatile LAS unsigned*)(lds + LDS_MAIN);
    if (threadIdx.x == 0) { xst[0] = 0u; xst[1] = 0u; }
    __syncthreads();
    const XcdBarrier xbar = xcd_barrier_post((unsigned*)(ws + WS_BAR), xst);
    unsigned long long tprev = PROBE_MASK ? __builtin_amdgcn_s_memrealtime() : 0ull, pdelay = 0ull;
    phase_ada(p, lds, mods, lbv);
    grid.sync();
    TS(0);

#pragma unroll 1
    for (int L = 0; L < 4; ++L) {
        const bool rec = (L & 1) == 0; const int j = L >> 1;
        const float* modL = mods + (size_t)L * 5 * 6144;
        const int Mmix_in = (L < 3) ? MT : ML;
        const int Mlive = (L < 2) ? MT : ML;
#pragma unroll 1
        for (int s = 0; s < 2; ++s) {
            if (s == 0) phase_cvt(p, lds, L);
            {
                const float* srcL = (L == 0 && s == 0) ? p.in[0] : X;
                const float* srcC = (L == 0 && s == 0) ? p.in[2] : X + (size_t)ML * DM;
                const float* gain = (s == 0 ? p.in[6] : p.in[7]) + L * 1024;
                phase_norm(srcL, srcC, s == 0 ? Mmix_in : Mlive, gain, modL, s == 0 ? 0 : 3 * 1024, s == 0 ? 1024 : 4 * 1024, HA, (L == 0 && s == 0) ? X : nullptr,
                           ((s == 1 && L < 2) || (s == 0 && (L == 1 || L == 2))) ? (const float*)(ws + WS_P) : nullptr,
                           s == 1 ? modL + 4 * 6144 + 2 * 1024 : mods + (size_t)((L > 0 ? L - 1 : 0) * 5 + 4) * 6144 + 5 * 1024, X);
            }
            xcd_barrier(xbar);
            TS(s == 0 ? 1 : 8);
            pg8::Gemm g; const float* gate; const float* resL; const float* resC;
            if (s == 0) {
                if (rec) {
                    { pg8::Gemm gi{HA, Win_t, Mmix_in, 5120, 1024, 1024, 1024}; pg8::StaticOrder S; S.init(gi.M, gi.N, gi.K, G, bx);
                      EpiHgrnIn E{Z, lbv + (size_t)j * 2048, j == 0 ? 1 : 0}; pg8::gemm_phase<EpiHgrnIn, pg8::StaticOrder>(lds, gi, S, E); }
                    xcd_barrier(xbar); TS(2);
                    phase_gla1(lds, Z, Sbuf, Dbuf);
                    xcd_barrier(xbar); TS(3);
                    phase_gla2(lds, Z, Sbuf, Dbuf, p.in[13] + j * 1024, L < 2 ? 1 : 0);
                    xcd_barrier(xbar); TS(4);
                    phase_gla3(lds, Z, Sbuf, p.in[13] + j * 1024, L < 2 ? 1 : 0);
                    xcd_barrier(xbar); TS(5);
                    g = pg8::Gemm{Z + 1024, Wout_t, ML, 1024, 1024, 5120, 1024};
                } else {
                    { pg8::Gemm gi{HA, Win_t, Mmix_in, 3072, 1024, 1024, 1024}; pg8::StaticOrder S; S.init(gi.M, gi.N, gi.K, G, bx);
                      EpiConvIn E{Z}; pg8::gemm_phase<EpiConvIn, pg8::StaticOrder>(lds, gi, S, E); }
                    xcd_barrier(xbar); TS(2);
                    phase_conv(Z, p.in[16] + (size_t)j * 3 * 1024, p.in[17] + j * 1024, j & 1, Mlive, HA);
                    xcd_barrier(xbar); TS(6);
                    g = pg8::Gemm{HA, Wout_t, ML, 1024, 1024, 1024, 1024};
                }
                gate = modL + 2 * 1024;
                resL = (L == 0) ? p.in[0] : X; resC = (L == 0) ? p.in[2] : X + (size_t)ML * DM;
            } else {
                { pg8::Gemm gi{HA, W1_t, Mlive, 4096, 1024, 1024, 1024}; pg8::StaticOrder S; S.init(gi.M, gi.N, gi.K, G, bx);
                  EpiRelu2 E{Z}; pg8::gemm_phase<EpiRelu2, pg8::StaticOrder>(lds, gi, S, E); }
                xcd_barrier(xbar); TS(9);
                g = pg8::Gemm{Z, W2_t, ML, 1024, 4096, 4096, 4096};
                gate = modL + 5 * 1024;
                resL = X; resC = X + (size_t)ML * DM;
            }
            { pg8::StaticOrder S; S.init(g.M, g.N, g.K, G, bx, L < 2 ? 64 : 0); EpiResid E{X, resL, resC, gate, (float*)(ws + WS_P)}; pg8::gemm_phase<EpiResid, pg8::StaticOrder>(lds, g, S, E); }
            xcd_barrier(xbar);
            TS(s == 0 ? 7 : 10);
        }
    }
    phase_final(X, p.in[8], p.out);
    if (PROBE_MASK) {
        TS(11);
        if (bx == 0) { const unsigned long long t0 = __builtin_amdgcn_s_memrealtime(); while (__builtin_amdgcn_s_memrealtime() - t0 < pdelay) __builtin_amdgcn_s_sleep(8); }
    }
}

extern "C" void kernel_launch(void* const* d_in, const int* in_sizes, int n_in, void* d_out, int out_size, void* d_ws, size_t ws_size, hipStream_t stream) {
    static int grid = 0;
    if (grid == 0) {
        if (n_in != 19 || out_size != ML * DM || ws_size < WS_END) { fprintf(stderr, "kernel_launch: unexpected shapes / workspace (n_in %d out %d ws %zu need %zu)\n", n_in, out_size, ws_size, (size_t)WS_END); grid = -1; return; }
        int dev = 0, cus = 0, per_cu = 0;
        if (hipGetDevice(&dev) != hipSuccess || hipDeviceGetAttribute(&cus, hipDeviceAttributeMultiprocessorCount, dev) != hipSuccess) { grid = -1; return; }
        if (hipFuncSetAttribute((const void*)mega_fwd, hipFuncAttributeMaxDynamicSharedMemorySize, LDS_BYTES) != hipSuccess) { fprintf(stderr, "kernel_launch: hipFuncSetAttribute failed\n"); grid = -1; return; }
        if (hipOccupancyMaxActiveBlocksPerMultiprocessor(&per_cu, (const void*)mega_fwd, 512, LDS_BYTES) != hipSuccess || per_cu < 1) { fprintf(stderr, "kernel_launch: occupancy query failed (%d)\n", per_cu); per_cu = 1; (void)hipGetLastError(); }
        grid = cus * per_cu;
    }
    if (grid < 0) return;
    if (hipMemsetAsync((char*)d_ws + WS_BAR, 0, XCD_BAR_WORDS * 4, stream) != hipSuccess) { fprintf(stderr, "kernel_launch: memset failed\n"); return; }
    Params p{};
    for (int i = 0; i < 19; ++i) p.in[i] = (const float*)d_in[i];
    p.out = (float*)d_out; p.ws = (unsigned char*)d_ws;
    void* args[] = {&p};
    hipError_t e = hipLaunchCooperativeKernel((const void*)mega_fwd, dim3(grid), dim3(512), args, LDS_BYTES, stream);
    if (e != hipSuccess) fprintf(stderr, "cooperative launch failed: %s (grid %d)\n", hipGetErrorString(e), grid);
}
```

```cpp
#include <hip/hip_runtime.h>
#include <hip/hip_cooperative_groups.h>
#include <cstdio>
namespace cg = cooperative_groups;

#define LAS __attribute__((address_space(3)))
typedef unsigned short bf16_t;
typedef short bf16x8 __attribute__((ext_vector_type(8)));
typedef float f32x4 __attribute__((ext_vector_type(4)));
typedef unsigned u32x4 __attribute__((ext_vector_type(4)));
typedef unsigned u32x2 __attribute__((ext_vector_type(2)));
typedef float f32x2 __attribute__((ext_vector_type(2)));

constexpr int DM = 1024, NB = 4, SEQ = 8192, CTXL = 256, DFF = 4096;
constexpr int ML = NB * SEQ;
constexpr int MC = NB * CTXL;
constexpr int MT = ML + MC;
constexpr float EPS = 1e-6f;

constexpr size_t WS_X = 0;
constexpr size_t WS_Z = WS_X + (size_t)MT * DM * 4;
constexpr size_t WS_WIN = WS_Z + (size_t)MT * 5120 * 2;
constexpr size_t WS_WOUT = WS_WIN + (size_t)5120 * 1024 * 2;
constexpr size_t WS_W1 = WS_WOUT + (size_t)1024 * 1024 * 2;
constexpr size_t WS_W2 = WS_W1 + (size_t)4096 * 1024 * 2;
constexpr size_t WS_DB = WS_W2 + (size_t)4096 * 1024 * 2;
constexpr size_t WS_MOD = WS_DB + (size_t)2048 * 128 * 4;
constexpr size_t WS_LB = WS_MOD + (size_t)4 * 5 * 6144 * 4;
constexpr size_t WS_BAR = WS_LB + (size_t)2 * 2 * 1024 * 4;
constexpr size_t WS_P = WS_BAR + (size_t)3456 * 4 + 128;
constexpr size_t WS_END = WS_P + (size_t)4 * 1024 * 1024 * 4;

constexpr int LDS_MAIN = 131072;
constexpr int LDS_BYTES = LDS_MAIN + 16;

struct Params { const float* in[19]; float* out; unsigned char* ws; };

__device__ __forceinline__ float bf2f(bf16_t b) { return __uint_as_float(((unsigned)b) << 16); }
__device__ __forceinline__ bf16_t f2bf(float f) { unsigned u = __float_as_uint(f); u += 0x7FFFu + ((u >> 16) & 1u); return (bf16_t)(u >> 16); }
typedef __bf16 bf16v2_t __attribute__((ext_vector_type(2)));
__device__ __forceinline__ unsigned pk2(float lo, float hi) { const f32x2 v = {lo, hi}; const bf16v2_t r = __builtin_convertvector(v, bf16v2_t); return __builtin_bit_cast(unsigned, r); }
__device__ __forceinline__ float bflo(unsigned u) { return __uint_as_float(u << 16); }
__device__ __forceinline__ float bfhi(unsigned u) { return __uint_as_float(u & 0xFFFF0000u); }
__device__ __forceinline__ float sigmoidf_(float z) { return __builtin_amdgcn_rcpf(1.0f + __expf(-z)); }
__device__ __forceinline__ float siluf_(float z) { return z * __builtin_amdgcn_rcpf(1.0f + __expf(-z)); }

namespace pg8 {
constexpr int BM = 256, BK = 64, HALF = 128, HTB = HALF * BK * 2, NXCD = 8, WGM = 8;
__device__ __forceinline__ int lds_byte(int r, int c) { const int st = (r >> 4) * 2 + (c >> 5), rr = r & 15, cc = c & 31, ob = rr * 64 + cc * 2; return st * 1024 + (ob ^ (((ob >> 9) & 1) << 5)); }
__device__ __forceinline__ void stage_rc(int b, int& R, int& C) { const int st = b / 1024, sb = b % 1024, swz = sb ^ (((sb >> 9) & 1) << 5); R = (st >> 1) * 16 + swz / 64; C = (st & 1) * 32 + (swz % 64) / 2; }
__device__ __forceinline__ int perm32(int rho) { const int n = rho >> 4, i = rho & 15; return 8 * (i >> 2) + 4 * n + (i & 3); }

struct Unit { int pm, pn, ks, nt; };
struct Gemm { const bf16_t* A; const bf16_t* Bt; int M, N, K, lda, ldb; };

struct StaticOrder {
    int nM, nN, nwg, G, c, ntk, nctx, ksb;
    __device__ void init(int M, int N, int K, int G_, int c_, int nctx_ = 0) { nM = M / BM; nN = N / BM; nwg = nM * nN; G = G_; c = c_; ntk = K / BK; nctx = nctx_; ksb = (K / 4) * 2; }
    __device__ bool next(int i, Unit& u) const {
        int i2 = i;
        if (c < nctx) {
            if (i == 0) { const int t = c; u.ks = t >> 4; u.pm = 128 + ((t & 15) >> 2); u.pn = t & 3; u.nt = ntk >> 2; return true; }
            i2 = i - 1;
        }
        const long L = (long)i2 * G + c;
        if (L >= nwg) return false;
        int wgid = (int)L; { const int q = nwg / NXCD, r = nwg % NXCD, xcd = wgid % NXCD, off = wgid / NXCD; wgid = (xcd < r ? xcd * (q + 1) : r * (q + 1) + (xcd - r) * q) + off; }
        const int nig = WGM * nN, gid = wgid / nig, fm = gid * WGM, gsz = (nM - fm) < WGM ? (nM - fm) : WGM;
        u.pm = fm + ((wgid % nig) % gsz); u.pn = (wgid % nig) / gsz; u.ks = 0; u.nt = ntk; return true;
    }
};

template <class Epi, class Sched>
__device__ __forceinline__ void gemm_phase(LAS unsigned char* lds, const Gemm g, const Sched& S, const Epi& E) {
    int tid_ = threadIdx.x; asm volatile("" : "+v"(tid_));
    const int tid = tid_, wid = __builtin_amdgcn_readfirstlane(tid >> 6), lane = tid & 63, wr = wid >> 2, wc = wid & 3, fr = lane & 15, fq = lane >> 4;
    const int lda = g.lda, ldb = g.ldb;
    unsigned voffA[2], voffB[2];
#pragma unroll
    for (int i = 0; i < 2; ++i) { int R, C; stage_rc(tid * 16 + i * 8192, R, C); const int Rb = Epi::PERM ? ((R & ~31) + perm32(R & 31)) : R;
        voffA[i] = (unsigned)(R * lda + C) * 2u; voffB[i] = (unsigned)(Rb * ldb + C) * 2u; }
    const size_t kstep = (size_t)(BK * 2);
    const size_t hstepA = (size_t)HALF * lda * 2, hstepB = (size_t)HALF * ldb * 2;
    const size_t ksb = (size_t)S.ksb;
    const size_t tstepA = 2 * hstepA, tstepB = 2 * hstepB;
    const unsigned ldsw = (unsigned)wid * 1024u;
    const int aoff = lds_byte(wr * 64 + fr, fq * 8), boff = lds_byte(wc * 32 + fr, fq * 8);
#define PG8_SA(b, h) (((b) * 2 + (h)) * HTB)
#define PG8_SB(b, h) ((4 + (b) * 2 + (h)) * HTB)
#define PG8_STAGE(bufoff, gbase, voff) do { _Pragma("unroll") for (int _i = 0; _i < 2; ++_i) \
        __builtin_amdgcn_global_load_lds((const unsigned*)((const char*)(gbase) + (voff)[_i]), (LAS unsigned*)(lds + (bufoff) + ldsw + _i * 8192), 16, 0, 0); } while (0)
#define PG8_LDA(dst, b, h) do { _Pragma("unroll") for (int m = 0; m < 4; ++m) _Pragma("unroll") for (int k = 0; k < 2; ++k) dst[m][k] = *(const LAS bf16x8*)(lds + PG8_SA(b, h) + aoff + m * 2048 + k * 1024); } while (0)
#define PG8_LDB(dst, b, h) do { _Pragma("unroll") for (int n = 0; n < 2; ++n) _Pragma("unroll") for (int k = 0; k < 2; ++k) dst[n][k] = *(const LAS bf16x8*)(lds + PG8_SB(b, h) + boff + n * 2048 + k * 1024); } while (0)
#define PG8_MMA(ai, bj, At, Bt) do { __builtin_amdgcn_s_setprio(1); _Pragma("unroll") for (int m = 0; m < 4; ++m) _Pragma("unroll") for (int n = 0; n < 2; ++n) _Pragma("unroll") for (int k = 0; k < 2; ++k) \
        acc[ai][bj][m][n] = __builtin_amdgcn_mfma_f32_16x16x32_bf16(Bt[n][k], At[m][k], acc[ai][bj][m][n], 0, 0, 0); __builtin_amdgcn_s_setprio(0); } while (0)
#define PG8_WAIT_V(n) asm volatile("s_waitcnt vmcnt(" #n ")" ::: "memory")
#define PG8_WAIT_L(n) asm volatile("s_waitcnt lgkmcnt(" #n ")" ::: "memory")
#define PG8_BAR __builtin_amdgcn_s_barrier()
#define PG8_SCHED __builtin_amdgcn_sched_barrier(0)
    Unit cur, nxt; int ui = 0;
    if (!S.next(0, cur)) return;
    f32x4 acc[2][2][4][2];
#pragma unroll
    for (int a = 0; a < 2; ++a)
#pragma unroll
        for (int b = 0; b < 2; ++b)
#pragma unroll
            for (int m = 0; m < 4; ++m)
#pragma unroll
                for (int n = 0; n < 2; ++n) acc[a][b][m][n] = (f32x4){0.f, 0.f, 0.f, 0.f};
    bf16x8 At[4][2], B0[2][2], B1[2][2];
    const char* cA = (const char*)g.A + (size_t)cur.pm * tstepA + (size_t)cur.ks * ksb; const char* cB = (const char*)g.Bt + (size_t)cur.pn * tstepB + (size_t)cur.ks * ksb;
    PG8_STAGE(PG8_SB(0, 0), cB, voffB); PG8_STAGE(PG8_SA(0, 0), cA, voffA); PG8_STAGE(PG8_SB(0, 1), cB + hstepB, voffB); PG8_STAGE(PG8_SA(0, 1), cA + hstepA, voffA);
    if (wr == 1) PG8_BAR;
    PG8_WAIT_V(4); PG8_BAR;
    PG8_STAGE(PG8_SB(1, 0), cB + kstep, voffB); PG8_STAGE(PG8_SA(1, 0), cA + kstep, voffA); PG8_STAGE(PG8_SB(1, 1), cB + hstepB + kstep, voffB);
    PG8_WAIT_V(6); PG8_BAR;
    for (;;) {
        const bool has_next = S.next(ui + 1, nxt);
        const char* nA = has_next ? (const char*)g.A + (size_t)nxt.pm * tstepA + (size_t)nxt.ks * ksb : cA; const char* nB = has_next ? (const char*)g.Bt + (size_t)nxt.pn * tstepB + (size_t)nxt.ks * ksb : cB;
        const int nt = cur.nt;
        for (int t = 0; t < nt; t += 2) {
            const bool last = (t == nt - 2);
            const char* a1 = cA + (size_t)(t + 1) * kstep;
            const char* a2 = last ? nA : cA + (size_t)(t + 2) * kstep; const char* b2 = last ? nB : cB + (size_t)(t + 2) * kstep;
            const char* a3 = a2 + kstep; const char* b3 = b2 + kstep;
            PG8_LDB(B0, 0, 0); PG8_SCHED; PG8_LDA(At, 0, 0); PG8_STAGE(PG8_SA(1, 1), a1 + hstepA, voffA);
            PG8_WAIT_L(8); PG8_BAR; PG8_WAIT_L(0); PG8_MMA(0, 0, At, B0); PG8_BAR; PG8_SCHED;
            PG8_LDB(B1, 0, 1); PG8_STAGE(PG8_SB(0, 0), b2, voffB);
            PG8_BAR; PG8_WAIT_L(0); PG8_MMA(0, 1, At, B1); PG8_BAR;
            PG8_LDA(At, 0, 1); PG8_STAGE(PG8_SA(0, 0), a2, voffA);
            PG8_BAR; PG8_WAIT_L(0); PG8_MMA(1, 0, At, B0); PG8_BAR; PG8_SCHED;
            PG8_STAGE(PG8_SB(0, 1), b2 + hstepB, voffB);
            PG8_WAIT_V(6); PG8_BAR; PG8_MMA(1, 1, At, B1); PG8_BAR;
            PG8_LDB(B0, 1, 0); PG8_SCHED; PG8_LDA(At, 1, 0); PG8_STAGE(PG8_SA(0, 1), a2 + hstepA, voffA);
            PG8_WAIT_L(8); PG8_BAR; PG8_WAIT_L(0); PG8_MMA(0, 0, At, B0); PG8_BAR; PG8_SCHED;
            PG8_LDB(B1, 1, 1); PG8_STAGE(PG8_SB(1, 0), b3, voffB);
            PG8_BAR; PG8_WAIT_L(0); PG8_MMA(0, 1, At, B1); PG8_BAR;
            PG8_LDA(At, 1, 1); PG8_STAGE(PG8_SA(1, 0), a3, voffA);
            PG8_BAR; PG8_WAIT_L(0); PG8_MMA(1, 0, At, B0); PG8_BAR; PG8_SCHED;
            PG8_STAGE(PG8_SB(1, 1), b3 + hstepB, voffB);
            PG8_WAIT_V(6); PG8_BAR; PG8_MMA(1, 1, At, B1); PG8_BAR;
        }
        E(acc, cur, wr, wc, fr, fq);
        if (!has_next) break;
#pragma unroll
        for (int a = 0; a < 2; ++a)
#pragma unroll
            for (int b = 0; b < 2; ++b)
#pragma unroll
                for (int m = 0; m < 4; ++m)
#pragma unroll
                    for (int n = 0; n < 2; ++n) acc[a][b][m][n] = (f32x4){0.f, 0.f, 0.f, 0.f};
        cur = nxt; cA = nA; cB = nB; ++ui;
    }
    PG8_WAIT_V(0);
    if (wr == 0) PG8_BAR;
    PG8_BAR;
#undef PG8_SA
#undef PG8_SB
#undef PG8_STAGE
#undef PG8_LDA
#undef PG8_LDB
#undef PG8_MMA
#undef PG8_WAIT_V
#undef PG8_WAIT_L
#undef PG8_BAR
#undef PG8_SCHED
}
}

struct EpiHgrnIn {
    static constexpr bool PERM = true;
    bf16_t* Z; const float* lbv;
    template <int MODE>
    __device__ __forceinline__ void run(const f32x4 (&acc)[2][2][4][2], const pg8::Unit& u, int wr, int wc, int fr, int fq) const {
        const int row0 = u.pm * 256 + wr * 64 + fr, col0 = u.pn * 256 + wc * 32 + 8 * fq;
        f32x4 lb[2][2], oml[2][2];
#pragma unroll
        for (int bj = 0; bj < 2; ++bj)
#pragma unroll
            for (int n = 0; n < 2; ++n) {
                lb[bj][n] = (MODE == 0) ? *(const f32x4*)(lbv + col0 + bj * 128 + 4 * n) : (f32x4){0.f, 0.f, 0.f, 0.f};
                oml[bj][n] = (f32x4){1.f, 1.f, 1.f, 1.f} - lb[bj][n];
            }
#pragma unroll
        for (int ai = 0; ai < 2; ++ai)
#pragma unroll
            for (int m = 0; m < 4; ++m) {
                bf16_t* rowp = Z + (size_t)(row0 + ai * 128 + m * 16) * 5120 + col0;
#pragma unroll
                for (int bj = 0; bj < 2; ++bj) {
                    float o[8];
#pragma unroll
                    for (int n = 0; n < 2; ++n)
#pragma unroll
                        for (int j = 0; j < 4; ++j) {
                            const float z = acc[ai][bj][m][n][j]; float r;
                            if (MODE == 0) { const float f = lb[bj][n][j] + oml[bj][n][j] * sigmoidf_(z); r = __builtin_amdgcn_logf(fmaxf(f, 1e-30f)); }
                            else if (MODE == 1) r = z;
                            else r = siluf_(z);
                            o[n * 4 + j] = r;
                        }
                    u32x4 w; w.x = pk2(o[0], o[1]); w.y = pk2(o[2], o[3]); w.z = pk2(o[4], o[5]); w.w = pk2(o[6], o[7]);
                    *(u32x4*)(rowp + bj * 128) = w;
                }
            }
    }
    __device__ __forceinline__ void operator()(const f32x4 (&acc)[2][2][4][2], const pg8::Unit& u, int wr, int wc, int fr, int fq) const {
        const int part = u.pn >> 2;
        if (part < 2) run<0>(acc, u, wr, wc, fr, fq);
        else if (part == 2) run<1>(acc, u, wr, wc, fr, fq);
        else run<2>(acc, u, wr, wc, fr, fq);
    }
};
struct EpiConvIn {
    static constexpr bool PERM = true;
    bf16_t* Z;
    __device__ __forceinline__ void operator()(const f32x4 (&acc)[2][2][4][2], const pg8::Unit& u, int wr, int wc, int fr, int fq) const {
        const int row0 = u.pm * 256 + wr * 64 + fr;
        if (u.pn < 4) {
            const int col0 = u.pn * 256 + wc * 32 + 8 * fq;
#pragma unroll
            for (int ai = 0; ai < 2; ++ai)
#pragma unroll
                for (int m = 0; m < 4; ++m) {
                    bf16_t* rowp = Z + (size_t)(row0 + ai * 128 + m * 16) * 2048 + col0;
#pragma unroll
                    for (int bj = 0; bj < 2; ++bj) {
                        const f32x4 v0 = acc[ai][bj][m][0], v1 = acc[ai][bj][m][1];
                        u32x4 w; w.x = pk2(v0[0], v0[1]); w.y = pk2(v0[2], v0[3]); w.z = pk2(v1[0], v1[1]); w.w = pk2(v1[2], v1[3]);
                        *(u32x4*)(rowp + bj * 128) = w;
                    }
                }
        } else {
            const int col0 = 1024 + (u.pn - 4) * 128 + wc * 32 + 8 * fq;
#pragma unroll
            for (int ai = 0; ai < 2; ++ai)
#pragma unroll
                for (int m = 0; m < 4; ++m) {
                    bf16_t* rowp = Z + (size_t)(row0 + ai * 128 + m * 16) * 2048 + col0;
                    const f32x4 v0 = acc[ai][0][m][0] * acc[ai][1][m][0], v1 = acc[ai][0][m][1] * acc[ai][1][m][1];
                    u32x4 w; w.x = pk2(v0[0], v0[1]); w.y = pk2(v0[2], v0[3]); w.z = pk2(v1[0], v1[1]); w.w = pk2(v1[2], v1[3]);
                    *(u32x4*)rowp = w;
                }
        }
    }
};
struct EpiRelu2 {
    static constexpr bool PERM = true;
    bf16_t* Z;
    __device__ __forceinline__ void operator()(const f32x4 (&acc)[2][2][4][2], const pg8::Unit& u, int wr, int wc, int fr, int fq) const {
        const int row0 = u.pm * 256 + wr * 64 + fr, col0 = u.pn * 256 + wc * 32 + 8 * fq;
#pragma unroll
        for (int ai = 0; ai < 2; ++ai)
#pragma unroll
            for (int m = 0; m < 4; ++m) {
                bf16_t* rowp = Z + (size_t)(row0 + ai * 128 + m * 16) * 4096 + col0;
#pragma unroll
                for (int bj = 0; bj < 2; ++bj) {
                    float o[8];
#pragma unroll
                    for (int n = 0; n < 2; ++n)
#pragma unroll
                        for (int j = 0; j < 4; ++j) { const float x = acc[ai][bj][m][n][j]; o[n * 4 + j] = fmaxf(x * __builtin_fabsf(x), 0.f); }
                    u32x4 w; w.x = pk2(o[0], o[1]); w.y = pk2(o[2], o[3]); w.z = pk2(o[4], o[5]); w.w = pk2(o[6], o[7]);
                    *(u32x4*)(rowp + bj * 128) = w;
                }
            }
    }
};
struct EpiCtxPartial {
    static constexpr bool PERM = false;
    float* P;
    __device__ __forceinline__ void operator()(const f32x4 (&acc)[2][2][4][2], const pg8::Unit& u, int wr, int wc, int fr, int fq) const {
        const int row0 = (u.pm - 128) * 256 + wr * 64 + fr, col0 = u.pn * 256 + wc * 32 + 4 * fq;
        float* pp0 = P + ((size_t)u.ks * 1024 + row0) * DM + col0;
#pragma unroll
        for (int ai = 0; ai < 2; ++ai)
#pragma unroll
            for (int m = 0; m < 4; ++m) {
                float* pp = pp0 + (size_t)(ai * 128 + m * 16) * DM;
#pragma unroll
                for (int bj = 0; bj < 2; ++bj)
#pragma unroll
                    for (int n = 0; n < 2; ++n) *(f32x4*)(pp + bj * 128 + n * 16) = acc[ai][bj][m][n];
            }
    }
};
struct EpiResid {
    static constexpr bool PERM = false;
    float* X; const float* resL; const float* resC; const float* gate; float* P;
    __device__ __forceinline__ void operator()(const f32x4 (&acc)[2][2][4][2], const pg8::Unit& u, int wr, int wc, int fr, int fq) const {
        if (u.pm >= 128) { EpiCtxPartial EP{P}; EP(acc, u, wr, wc, fr, fq); return; }
        const int row0 = u.pm * 256 + wr * 64 + fr, col0 = u.pn * 256 + wc * 32 + 4 * fq;
        const int bb = u.pm >> 5;
        const float* gp = gate + (size_t)bb * 6144 + col0;
        f32x4 gv[2][2];
#pragma unroll
        for (int bj = 0; bj < 2; ++bj)
#pragma unroll
            for (int n = 0; n < 2; ++n) gv[bj][n] = *(const f32x4*)(gp + bj * 128 + n * 16);
#pragma unroll
        for (int ai = 0; ai < 2; ++ai) {
            f32x4 r[4][2][2];
#pragma unroll
            for (int m = 0; m < 4; ++m) {
                const float* rp = resL + (size_t)(row0 + ai * 128 + m * 16) * DM + col0;
#pragma unroll
                for (int bj = 0; bj < 2; ++bj)
#pragma unroll
                    for (int n = 0; n < 2; ++n) r[m][bj][n] = *(const f32x4*)(rp + bj * 128 + n * 16);
            }
#pragma unroll
            for (int m = 0; m < 4; ++m) {
                float* xp = X + (size_t)(row0 + ai * 128 + m * 16) * DM + col0;
#pragma unroll
                for (int bj = 0; bj < 2; ++bj)
#pragma unroll
                    for (int n = 0; n < 2; ++n) *(f32x4*)(xp + bj * 128 + n * 16) = r[m][bj][n] + gv[bj][n] * acc[ai][bj][m][n];
            }
            asm volatile("" ::: "memory");
        }
    }
};

__device__ __forceinline__ void phase_ada(const Params& p, LAS unsigned char* lds, float* mods, float* lbv) {
    int tid_ = threadIdx.x; asm volatile("" : "+v"(tid_)); const int tid = tid_;
    LAS float* s = (LAS float*)lds;
    LAS float* red = s + 5 * 1024;
    const float* c = p.in[1]; const float* cc = p.in[3];
    for (int i = tid; i < 5 * 1024; i += 512) { const int bb = i >> 10, k = i & 1023; const float v = bb < 4 ? c[bb * 1024 + k] : cc[k]; s[i] = siluf_(v); }
    __syncthreads();
    const int col = tid & 63, ks = tid >> 6;
    for (int item = blockIdx.x; item < 4 * 96; item += gridDim.x) {
        const int l = item / 96, n0 = (item % 96) * 64;
        const float* W = p.in[4] + (size_t)l * 1024 * 6144 + n0 + col;
        float a0 = 0.f, a1 = 0.f, a2 = 0.f, a3 = 0.f, a4 = 0.f;
#pragma unroll 8
        for (int k = ks * 128; k < ks * 128 + 128; ++k) {
            const float w = W[(size_t)k * 6144];
            a0 += s[k] * w; a1 += s[1024 + k] * w; a2 += s[2048 + k] * w; a3 += s[3072 + k] * w; a4 += s[4096 + k] * w;
        }
        red[(ks * 5 + 0) * 64 + col] = a0; red[(ks * 5 + 1) * 64 + col] = a1; red[(ks * 5 + 2) * 64 + col] = a2; red[(ks * 5 + 3) * 64 + col] = a3; red[(ks * 5 + 4) * 64 + col] = a4;
        __syncthreads();
        if (tid < 320) {
            const int bb = tid >> 6; float t = 0.f;
#pragma unroll
            for (int q = 0; q < 8; ++q) t += red[(q * 5 + bb) * 64 + col];
            mods[(size_t)(l * 5 + bb) * 6144 + n0 + col] = t + p.in[5][l * 6144 + n0 + col];
        }
        __syncthreads();
    }
    if (blockIdx.x == 0) {
        const float* hl = p.in[12];
        for (int i = tid; i < 2 * 1024; i += 512) {
            const int d = i >> 10, ch = i & 1023;
            const float a = hl[(d * 2 + 0) * 1024 + ch], b = hl[(d * 2 + 1) * 1024 + ch];
            const float m = fmaxf(a, b), ea = __expf(a - m), eb = __expf(b - m);
            lbv[(0 * 2 + d) * 1024 + ch] = 0.f;
            lbv[(1 * 2 + d) * 1024 + ch] = eb / (ea + eb);
        }
    }
}

__device__ __forceinline__ void cvt_slab(const float* src, int ld, int Kdim, bf16_t* dst, int nslab, int kslab, int mapmode, LAS float* T) {
    int tid_ = threadIdx.x; asm volatile("" : "+v"(tid_)); const int tid = tid_;
    const int n0 = nslab * 128, k0 = kslab * 128;
    int sc0 = n0;
    if (mapmode && n0 >= 1024) { const int t = (n0 - 1024) >> 8, w = (n0 - 1024) & 255; sc0 = (w < 128) ? 1024 + 128 * t + w : 2048 + 128 * t + (w - 128); }
    {
        const int kk = tid >> 5, n4 = (tid & 31) * 4;
        const float* sp = src + (size_t)(k0 + kk) * ld + sc0 + n4;
        f32x4 a[8];
#pragma unroll
        for (int i = 0; i < 8; ++i) a[i] = *(const f32x4*)(sp + (size_t)(i * 16) * ld);
#pragma unroll
        for (int i = 0; i < 8; ++i) { LAS float* tp = T + (kk + i * 16) * 129 + n4; tp[0] = a[i][0]; tp[1] = a[i][1]; tp[2] = a[i][2]; tp[3] = a[i][3]; }
    }
    __syncthreads();
    {
        const int nn = tid >> 2, kq = (tid & 3) * 32;
#pragma unroll
        for (int c = 0; c < 4; ++c) {
            float v[8];
#pragma unroll
            for (int i = 0; i < 8; ++i) v[i] = T[(kq + c * 8 + i) * 129 + nn];
            u32x4 w; w.x = pk2(v[0], v[1]); w.y = pk2(v[2], v[3]); w.z = pk2(v[4], v[5]); w.w = pk2(v[6], v[7]);
            *(u32x4*)(dst + (size_t)(n0 + nn) * Kdim + k0 + kq + c * 8) = w;
        }
    }
    __syncthreads();
}
__device__ __forceinline__ void phase_cvt(const Params& p, LAS unsigned char* lds, int L) {
    const int j = L >> 1; const bool rec = (L & 1) == 0;
    const int Nin = rec ? 5120 : 3072;
    const float* win = rec ? p.in[11] + (size_t)j * 1024 * 5120 : p.in[15] + (size_t)j * 1024 * 3072;
    const float* wout = rec ? p.in[14] + (size_t)j * 1024 * 1024 : p.in[18] + (size_t)j * 1024 * 1024;
    const float* w1 = p.in[9] + (size_t)L * 1024 * 4096;
    const float* w2 = p.in[10] + (size_t)L * 4096 * 1024;
    bf16_t* Win_t = (bf16_t*)(p.ws + WS_WIN); bf16_t* Wout_t = (bf16_t*)(p.ws + WS_WOUT); bf16_t* W1_t = (bf16_t*)(p.ws + WS_W1); bf16_t* W2_t = (bf16_t*)(p.ws + WS_W2);
    const int t0 = (Nin / 128) * 8, t1 = t0 + 64, t2 = t1 + 256, t3 = t2 + 256;
    LAS float* T = (LAS float*)lds;
    for (int it = blockIdx.x; it < t3; it += gridDim.x) {
        if (it < t0) cvt_slab(win, Nin, 1024, Win_t, it >> 3, it & 7, rec ? 0 : 1, T);
        else if (it < t1) { const int q = it - t0; cvt_slab(wout, 1024, 1024, Wout_t, q >> 3, q & 7, 0, T); }
        else if (it < t2) { const int q = it - t1; cvt_slab(w1, 4096, 1024, W1_t, q >> 3, q & 7, 0, T); }
        else { const int q = it - t2; cvt_slab(w2, 1024, 4096, W2_t, q >> 5, q & 31, 0, T); }
    }
}

__device__ __forceinline__ void phase_norm(const float* srcL, const float* srcC, int M, const float* gain, const float* mod, int shoff, int scoff, bf16_t* HA, float* Xcopy  , const float* P  , const float* pgate, float* Xw) {
    int tid_ = threadIdx.x; asm volatile("" : "+v"(tid_));
    const int lane = tid_ & 63, gw = blockIdx.x * 8 + (tid_ >> 6), nw = gridDim.x * 8;
    int colv[4];
#pragma unroll
    for (int i = 0; i < 4; ++i) colv[i] = (i >> 1) * 512 + lane * 8 + (i & 1) * 4;
    const bool xcdmap = (gridDim.x % 8 == 0) && (M >= ML);
#pragma unroll 1
    for (int seg = xcdmap ? 4 : 0; seg < (xcdmap ? 6 : 5); ++seg) {
        int bb, lo, hi, st, step;
        if (seg < 5) { bb = seg; lo = bb < 4 ? bb * SEQ : ML; hi = bb < 4 ? ((bb + 1) * SEQ < M ? (bb + 1) * SEQ : M) : M; st = gw; step = nw; }
        else { const int x = blockIdx.x & 7; bb = x >> 1; lo = 4096 * x; hi = lo + 4096; st = ((int)blockIdx.x >> 3) * 8 + (tid_ >> 6); step = ((int)gridDim.x >> 3) * 8; }
        if (lo + st >= hi) continue;
        const float* mp = mod + (size_t)bb * 6144;
        f32x4 wv[4], sv[4];
#pragma unroll
        for (int i = 0; i < 4; ++i) {
            const f32x4 g = *(const f32x4*)(gain + colv[i]), sc = *(const f32x4*)(mp + scoff + colv[i]);
            wv[i] = g * ((f32x4){1.f, 1.f, 1.f, 1.f} + sc); sv[i] = *(const f32x4*)(mp + shoff + colv[i]);
        }
        for (int r0 = lo + st; r0 < hi; r0 += 4 * step) {
            f32x4 v[4][4];
#pragma unroll
            for (int u = 0; u < 4; ++u) {
                const int r = r0 + u * step;
                if (r < hi) {
                    const float* xr = r < ML ? srcL + (size_t)r * DM : srcC + (size_t)(r - ML) * DM;
#pragma unroll
                    for (int i = 0; i < 4; ++i) v[u][i] = *(const f32x4*)(xr + colv[i]);
                }
            }
#pragma unroll
            for (int u = 0; u < 4; ++u) {
                const int r = r0 + u * step;
                if (r < hi) {
                    if (P != nullptr && r >= ML) {
                        f32x4 pa[4][4], pg[4];
#pragma unroll
                        for (int i = 0; i < 4; ++i) {
                            const float* pp = P + (size_t)(r - ML) * DM + colv[i];
#pragma unroll
                            for (int k = 0; k < 4; ++k) pa[i][k] = *(const f32x4*)(pp + (size_t)(k * 1024) * DM);
                            pg[i] = *(const f32x4*)(pgate + colv[i]);
                        }
#pragma unroll
                        for (int i = 0; i < 4; ++i) v[u][i] += pg[i] * ((pa[i][0] + pa[i][1]) + (pa[i][2] + pa[i][3]));
#pragma unroll
                        for (int i = 0; i < 4; ++i) *(f32x4*)(Xw + (size_t)r * DM + colv[i]) = v[u][i];
                    }
                    float ss = 0.f;
#pragma unroll
                    for (int i = 0; i < 4; ++i) ss += v[u][i][0] * v[u][i][0] + v[u][i][1] * v[u][i][1] + v[u][i][2] * v[u][i][2] + v[u][i][3] * v[u][i][3];
#pragma unroll
                    for (int o = 32; o >= 1; o >>= 1) ss += __shfl_xor(ss, o);
                    const float rstd = rsqrtf(ss * (1.0f / DM) + EPS);
                    if (Xcopy != nullptr && r >= ML) {
#pragma unroll
                        for (int i = 0; i < 4; ++i) *(f32x4*)(Xcopy + (size_t)r * DM + colv[i]) = v[u][i];
                    }
#pragma unroll
                    for (int hh = 0; hh < 2; ++hh) {
                        const f32x4 h0 = (v[u][2 * hh] * rstd) * wv[2 * hh] + sv[2 * hh], h1 = (v[u][2 * hh + 1] * rstd) * wv[2 * hh + 1] + sv[2 * hh + 1];
                        u32x4 w; w.x = pk2(h0[0], h0[1]); w.y = pk2(h0[2], h0[3]); w.z = pk2(h1[0], h1[1]); w.w = pk2(h1[2], h1[3]);
                        *(u32x4*)(HA + (size_t)r * DM + hh * 512 + lane * 8) = w;
                    }
                }
            }
        }
    }
}
__device__ __forceinline__ void phase_final(const float* X, const float* gain, float* out) {
    int tid_ = threadIdx.x; asm volatile("" : "+v"(tid_));
    const int lane = tid_ & 63, gw = blockIdx.x * 8 + (tid_ >> 6), nw = gridDim.x * 8;
    f32x4 gv[4];
#pragma unroll
    for (int i = 0; i < 4; ++i) gv[i] = *(const f32x4*)(gain + i * 256 + lane * 4);
    for (int r0 = gw; r0 < ML; r0 += 2 * nw) {
        f32x4 v[2][4];
#pragma unroll
        for (int u = 0; u < 2; ++u) { const int r = r0 + u * nw; if (r < ML) {
#pragma unroll
            for (int i = 0; i < 4; ++i) v[u][i] = *(const f32x4*)(X + (size_t)r * DM + i * 256 + lane * 4); } }
#pragma unroll
        for (int u = 0; u < 2; ++u) { const int r = r0 + u * nw; if (r < ML) {
            float ss = 0.f;
#pragma unroll
            for (int i = 0; i < 4; ++i) ss += v[u][i][0] * v[u][i][0] + v[u][i][1] * v[u][i][1] + v[u][i][2] * v[u][i][2] + v[u][i][3] * v[u][i][3];
#pragma unroll
            for (int o = 32; o >= 1; o >>= 1) ss += __shfl_xor(ss, o);
            const float rstd = rsqrtf(ss * (1.0f / DM) + EPS);
#pragma unroll
            for (int i = 0; i < 4; ++i) { const int col = i * 256 + lane * 4; *(f32x4*)(out + (size_t)r * DM + col) = v[u][i] * rstd * gv[i]; }
        } }
    }
}

__device__ __forceinline__ void phase_conv(const bf16_t* Z, const float* cw, const float* cb, int axis_rows, int M, bf16_t* HA) {
    int tid_ = threadIdx.x; asm volatile("" : "+v"(tid_));
    const int gt = blockIdx.x * 512 + tid_, nth = gridDim.x * 512;
    const int c8 = (gt & 127) * 8, rstep = nth >> 7;
    float w0[8], w1[8], w2[8], bs[8];
#pragma unroll
    for (int q = 0; q < 8; ++q) { bs[q] = cb[c8 + q]; w0[q] = cw[c8 + q]; w1[q] = cw[1024 + c8 + q]; w2[q] = cw[2048 + c8 + q]; }
    for (int r0 = gt >> 7; r0 < M; r0 += 4 * rstep) {
        u32x4 uc[4], upv[4], unv[4], gb[4];
#pragma unroll
        for (int k = 0; k < 4; ++k) {
            const int r = r0 + k * rstep;
            upv[k] = (u32x4){0u, 0u, 0u, 0u}; unv[k] = (u32x4){0u, 0u, 0u, 0u};
            if (r < M) {
                int dlt; bool hasp, hasn;
                if (r < ML) {
                    const int t = r & (SEQ - 1);
                    if (axis_rows) { dlt = 64; const int gr = t >> 6; hasp = gr > 0; hasn = gr < 127; }
                    else { dlt = 1; const int gc = t & 63; hasp = gc > 0; hasn = gc < 63; }
                } else { dlt = 1; const int t = (r - ML) & (CTXL - 1); hasp = t > 0; hasn = t < CTXL - 1; }
                const bf16_t* up = Z + (size_t)r * 2048 + 1024 + c8;
                uc[k] = *(const u32x4*)up;
                if (hasp) upv[k] = *(const u32x4*)(up - (size_t)dlt * 2048);
                if (hasn) unv[k] = *(const u32x4*)(up + (size_t)dlt * 2048);
                gb[k] = *(const u32x4*)(Z + (size_t)r * 2048 + c8);
            }
        }
#pragma unroll
        for (int k = 0; k < 4; ++k) {
            const int r = r0 + k * rstep;
            if (r < M) {
                float o[8];
#pragma unroll
                for (int q2 = 0; q2 < 4; ++q2) {
                    const unsigned a = upv[k][q2], b = uc[k][q2], c = unv[k][q2], g = gb[k][q2];
                    o[2 * q2] = bflo(g) * (bs[2 * q2] + w0[2 * q2] * bflo(a) + w1[2 * q2] * bflo(b) + w2[2 * q2] * bflo(c));
                    o[2 * q2 + 1] = bfhi(g) * (bs[2 * q2 + 1] + w0[2 * q2 + 1] * bfhi(a) + w1[2 * q2 + 1] * bfhi(b) + w2[2 * q2 + 1] * bfhi(c));
                }
                u32x4 w; w.x = pk2(o[0], o[1]); w.y = pk2(o[2], o[3]); w.z = pk2(o[4], o[5]); w.w = pk2(o[6], o[7]);
                *(u32x4*)(HA + (size_t)r * DM + c8) = w;
            }
        }
    }
}

constexpr int G_QT = 0, G_KT = 17408, G_KTT = 34816, G_VTT = 53248, G_PP = 71680, G_STT = 80896, G_TOT = 115712, G_SSQ = 119808;
constexpr int PQ = 136, PT = 72;

__device__ __forceinline__ f32x4 mfma16(bf16x8 a, bf16x8 b, f32x4 c) { return __builtin_amdgcn_mfma_f32_16x16x32_bf16(a, b, c, 0, 0, 0); }
#define LBAR() do { asm volatile("s_waitcnt lgkmcnt(0)" ::: "memory"); __builtin_amdgcn_s_barrier(); asm volatile("" ::: "memory"); } while (0)

struct GlaPF { unsigned g[8], v[8], q[8]; };
template <bool OUT>
__device__ __forceinline__ void gla_prefetch(GlaPF& pf, const bf16_t* Z, int row0, int gcol  , int h, int tid) {
    const unsigned zoff = (unsigned)(row0 + (tid >> 6) * 8) * 5120u + (unsigned)(h * 128 + 2 * (tid & 63));
#pragma unroll
    for (int i = 0; i < 8; ++i) {
        pf.g[i] = *(const unsigned*)(Z + (zoff + (unsigned)(i * 5120) + (unsigned)gcol));
        pf.v[i] = *(const unsigned*)(Z + (zoff + (unsigned)(i * 5120 + 2048)));
        if (OUT) pf.q[i] = *(const unsigned*)(Z + (zoff + (unsigned)(i * 5120 + 3072)));
    }
}

template <bool OUT, int D>
__device__ __forceinline__ void gla_chunk(LAS unsigned char* lds, bf16_t* Z, int row0, int h, f32x4 (&S)[8], float (&lastsum)[2], const f32x4 (&gnv)[4]  ,
                                          GlaPF& pf, bool has_next, int nrow0, int ngcol, int nh) {
    int tid_ = threadIdx.x; asm volatile("" : "+v"(tid_));
    const int tid = tid_, lane = tid & 63, w = __builtin_amdgcn_readfirstlane(tid >> 6);
    const int cp = lane, tg = w;
    const int l15 = lane & 15, lq = lane >> 4;
    LAS bf16_t* QT = (LAS bf16_t*)(lds + G_QT); LAS bf16_t* KT = (LAS bf16_t*)(lds + G_KT); LAS bf16_t* KTT = (LAS bf16_t*)(lds + G_KTT);
    LAS bf16_t* VTT = (LAS bf16_t*)(lds + G_VTT); LAS bf16_t* PP = (LAS bf16_t*)(lds + G_PP); LAS bf16_t* STT = (LAS bf16_t*)(lds + G_STT);
    LAS float* TOT = (LAS float*)(lds + G_TOT); LAS float* SSQ = (LAS float*)(lds + G_SSQ);
    f32x2 f2[8];
    {
        f32x2 tot2 = (f32x2){0.f, 0.f};
#pragma unroll
        for (int i = 0; i < 8; ++i) { const f32x2 g2 = (f32x2){bflo(pf.g[i]), bfhi(pf.g[i])}; tot2 += g2; f2[i] = (f32x2){__builtin_amdgcn_exp2f(g2.x), __builtin_amdgcn_exp2f(g2.y)}; }
        *(LAS f32x2*)(TOT + tg * 128 + 2 * cp) = tot2;
    }
    LBAR();
    {
        f32x2 pre2 = (f32x2){0.f, 0.f}, ref2 = (f32x2){0.f, 0.f}, all2 = (f32x2){0.f, 0.f};
#pragma unroll
        for (int t = 0; t < 8; ++t) {
            const f32x2 tv = *(const LAS f32x2*)(TOT + t * 128 + 2 * cp);
            all2 += tv;
            const bool inref = (D == 0) ? (t < 4) : (t >= 4);
            if (inref) ref2 += tv;
            const bool inpre = (D == 0) ? (t < tg) : (t > tg);
            pre2 += inpre ? tv : (f32x2){0.f, 0.f};
        }
        if (tg == 0) { lastsum[0] += all2.x; lastsum[1] += all2.y; }
        f32x2 kt[8];
        {
            f32x2 p2 = all2 - pre2 - (*(const LAS f32x2*)(TOT + tg * 128 + 2 * cp));
            if (OUT) { p2 += ref2 - all2; p2.x = fminf(p2.x, 100.f); p2.y = fminf(p2.y, 100.f); }
            f32x2 wq = (f32x2){__builtin_amdgcn_exp2f(p2.x), __builtin_amdgcn_exp2f(p2.y)};
#pragma unroll
            for (int u = 0; u < 8; ++u) {
                const int ii = (D == 0) ? 7 - u : u;
                kt[ii] = ((f32x2){1.0f, 1.0f} - f2[ii]) * wq;
                wq *= f2[ii];
            }
        }
        const f32x2 d2 = pre2 - ref2;
        f32x2 e1 = (f32x2){__builtin_amdgcn_exp2f(d2.x), __builtin_amdgcn_exp2f(d2.y)};
#pragma unroll
        for (int u = 0; OUT && u < 8; ++u) {
            const int ii = (D == 0) ? u : 7 - u;
            e1 *= f2[ii];
            if (OUT) {
                const int t = tg * 8 + ii;
                const f32x2 qt = (f32x2){bflo(pf.q[ii]), bfhi(pf.q[ii])} * e1;
                *(LAS unsigned*)(QT + t * PQ + 2 * cp) = pk2(qt.x, qt.y);
                *(LAS unsigned*)(KT + t * PQ + 2 * cp) = pk2(kt[ii].x, kt[ii].y);
            }
        }
        unsigned kp0[4], kp1[4], vp0[4], vp1[4];
#pragma unroll
        for (int i = 0; i < 8; i += 2) {
            kp0[i >> 1] = pk2(kt[i].x, kt[i + 1].x); kp1[i >> 1] = pk2(kt[i].y, kt[i + 1].y);
            vp0[i >> 1] = (pf.v[i] & 0xFFFFu) | (pf.v[i + 1] << 16); vp1[i >> 1] = (pf.v[i] >> 16) | (pf.v[i + 1] & 0xFFFF0000u);
        }
        *(LAS u32x4*)(KTT + (2 * cp) * PT + tg * 8) = (u32x4){kp0[0], kp0[1], kp0[2], kp0[3]};
        *(LAS u32x4*)(KTT + (2 * cp + 1) * PT + tg * 8) = (u32x4){kp1[0], kp1[1], kp1[2], kp1[3]};
        *(LAS u32x4*)(VTT + (2 * cp) * PT + tg * 8) = (u32x4){vp0[0], vp0[1], vp0[2], vp0[3]};
        *(LAS u32x4*)(VTT + (2 * cp + 1) * PT + tg * 8) = (u32x4){vp1[0], vp1[1], vp1[2], vp1[3]};
    }
    float el[4];
    {
        f32x4 rs = (f32x4){0.f, 0.f, 0.f, 0.f}, ls = (f32x4){0.f, 0.f, 0.f, 0.f};
#pragma unroll
        for (int t = 0; t < 8; ++t) {
            const f32x4 tv = *(const LAS f32x4*)(TOT + t * 128 + 16 * w + lq * 4);
            const bool inref = (D == 0) ? (t < 4) : (t >= 4);
            if (inref) rs += tv; else ls += tv;
        }
        float er[4];
#pragma unroll
        for (int j = 0; j < 4; ++j) {
            if (OUT) { er[j] = __builtin_amdgcn_exp2f(rs[j]); el[j] = __builtin_amdgcn_exp2f(ls[j]); }
            else { er[j] = __builtin_amdgcn_exp2f(rs[j] + ls[j]); el[j] = 1.0f; }
        }
#pragma unroll
        for (int vt = 0; vt < 8; ++vt) {
#pragma unroll
            for (int j = 0; j < 4; ++j) S[vt][j] *= er[j];
            if (OUT) { u32x2 wv; wv.x = pk2(S[vt][0], S[vt][1]); wv.y = pk2(S[vt][2], S[vt][3]);
                *(LAS u32x2*)(STT + (16 * vt + l15) * PQ + 16 * w + lq * 4) = wv; }
        }
    }
    if (has_next) gla_prefetch<OUT>(pf, Z, nrow0, ngcol, nh, tid);
    const int rt = w & 3, vh = (w >> 2) * 4;
    bf16_t* zo = Z + (size_t)(row0 + 16 * rt + l15) * 5120 + h * 128 + 16 * vh + 4 * lq;
    u32x2 ofw[4], gat[4];
    if (OUT && D == 1) {
#pragma unroll
        for (int i = 0; i < 4; ++i) { ofw[i] = *(const u32x2*)(zo + 16 * i); gat[i] = *(const u32x2*)(zo + 4096 + 16 * i); }
    }
    LBAR();
    __builtin_amdgcn_s_setprio(1);
    if (OUT) {
        const int st = w >> 1, ct0 = (w & 1) * 2;
#pragma unroll
        for (int i = 0; i < 2; ++i) {
            const int ct = ct0 + i;
            f32x4 a = (f32x4){0.f, 0.f, 0.f, 0.f};
            const bool zero = (D == 0) ? (st > ct) : (st < ct);
            if (!zero) {
#pragma unroll
                for (int ks = 0; ks < 4; ++ks) {
                    const bf16x8 fa = *(const LAS bf16x8*)(KT + (16 * st + l15) * PQ + ks * 32 + lq * 8);
                    const bf16x8 fb = *(const LAS bf16x8*)(QT + (16 * ct + l15) * PQ + ks * 32 + lq * 8);
                    a = mfma16(fa, fb, a);
                }
                const int cc = 16 * ct + l15;
#pragma unroll
                for (int j = 0; j < 4; ++j) { const int ss = 16 * st + lq * 4 + j; const bool keep = (D == 0) ? (ss <= cc) : (ss >= cc); a[j] = keep ? a[j] : 0.f; }
            }
            u32x2 wv; wv.x = pk2(a[0], a[1]); wv.y = pk2(a[2], a[3]);
            *(LAS u32x2*)(PP + (16 * ct + l15) * PT + 16 * st + lq * 4) = wv;
        }
    }
    {
        bf16x8 fa[2];
#pragma unroll
        for (int ks = 0; ks < 2; ++ks) fa[ks] = *(const LAS bf16x8*)(KTT + (16 * w + l15) * PT + ks * 32 + lq * 8);
#pragma unroll
        for (int vt = 0; vt < 8; ++vt) {
#pragma unroll
            for (int ks = 0; ks < 2; ++ks) {
                const bf16x8 fb = *(const LAS bf16x8*)(VTT + (16 * vt + l15) * PT + ks * 32 + lq * 8);
                S[vt] = mfma16(fa[ks], fb, S[vt]);
            }
            if (OUT) {
#pragma unroll
                for (int j = 0; j < 4; ++j) S[vt][j] *= el[j];
            }
        }
    }
    if (!OUT) __builtin_amdgcn_s_setprio(0);
    if (OUT) {
        f32x4 o[4];
#pragma unroll
        for (int i = 0; i < 4; ++i) o[i] = (f32x4){0.f, 0.f, 0.f, 0.f};
#pragma unroll
        for (int ks = 0; ks < 4; ++ks) {
            const bf16x8 fb = *(const LAS bf16x8*)(QT + (16 * rt + l15) * PQ + ks * 32 + lq * 8);
#pragma unroll
            for (int i = 0; i < 4; ++i) { const bf16x8 fa = *(const LAS bf16x8*)(STT + (16 * (vh + i) + l15) * PQ + ks * 32 + lq * 8); o[i] = mfma16(fa, fb, o[i]); }
        }
        LBAR();
#pragma unroll
        for (int ks = 0; ks < 2; ++ks) {
            const bf16x8 fb = *(const LAS bf16x8*)(PP + (16 * rt + l15) * PT + ks * 32 + lq * 8);
#pragma unroll
            for (int i = 0; i < 4; ++i) { const bf16x8 fa = *(const LAS bf16x8*)(VTT + (16 * (vh + i) + l15) * PT + ks * 32 + lq * 8); o[i] = mfma16(fa, fb, o[i]); }
        }
        __builtin_amdgcn_s_setprio(0);
        if (D == 0) {
#pragma unroll
            for (int i = 0; i < 4; ++i) { u32x2 wv; wv.x = pk2(o[i][0], o[i][1]); wv.y = pk2(o[i][2], o[i][3]); *(u32x2*)(zo + 16 * i) = wv; }
        } else {
            float sq = 0.f;
#pragma unroll
            for (int i = 0; i < 4; ++i) {
                o[i][0] += bflo(ofw[i].x); o[i][1] += bfhi(ofw[i].x); o[i][2] += bflo(ofw[i].y); o[i][3] += bfhi(ofw[i].y);
                sq += o[i][0] * o[i][0] + o[i][1] * o[i][1] + o[i][2] * o[i][2] + o[i][3] * o[i][3];
            }
            sq += __shfl_xor(sq, 16); sq += __shfl_xor(sq, 32);
            if (lq == 0) SSQ[(w >> 2) * 64 + 16 * rt + l15] = sq;
            LBAR();
            const float rstd = rsqrtf((SSQ[16 * rt + l15] + SSQ[64 + 16 * rt + l15]) * (1.0f / 128.0f) + EPS);
#pragma unroll
            for (int i = 0; i < 4; ++i) {
                const f32x4 gn = gnv[i];
                const float y0 = o[i][0] * rstd * gn[0] * bflo(gat[i].x), y1 = o[i][1] * rstd * gn[1] * bfhi(gat[i].x);
                const float y2 = o[i][2] * rstd * gn[2] * bflo(gat[i].y), y3 = o[i][3] * rstd * gn[3] * bfhi(gat[i].y);
                u32x2 wv; wv.x = pk2(y0, y1); wv.y = pk2(y2, y3);
                *(u32x2*)(zo + 1024 + 16 * i) = wv;
            }
        }
    }
}

__device__ __forceinline__ int sc_rowbase(int b, int jsc) { return jsc == 0 ? ML + b * CTXL : b * SEQ + (jsc - 1) * 256; }

__device__ __forceinline__ void phase_gla1(LAS unsigned char* lds, bf16_t* Z, unsigned* Sbuf, float* Dbuf) {
    int tid_ = threadIdx.x; asm volatile("" : "+v"(tid_));
    const int tid = tid_, lane = tid & 63, w = __builtin_amdgcn_readfirstlane(tid >> 6);
    GlaPF pf;
    int task = blockIdx.x;
    if (task < 2048) {
        const int bhd = task >> 5, p = task & 31, b = bhd >> 4, h = (bhd >> 1) & 7, d = bhd & 1;
        const int jsc = (p == 0) ? 0 : (d == 0 ? p : 33 - p);
        gla_prefetch<false>(pf, Z, sc_rowbase(b, jsc) + (d ? 192 : 0), d * 1024, h, tid);
    }
    for (; task < 2048; task += gridDim.x) {
        const int bhd = task >> 5, p = task & 31, b = bhd >> 4, h = (bhd >> 1) & 7, d = bhd & 1;
        const int jsc = (p == 0) ? 0 : (d == 0 ? p : 33 - p);
        const int rb = sc_rowbase(b, jsc);
        const int nt = task + gridDim.x; const bool hn = nt < 2048;
        int nrow = 0, ngc = 0, nh = 0;
        if (hn) { const int nbhd = nt >> 5, np = nt & 31, nb = nbhd >> 4, nd = nbhd & 1; nh = (nbhd >> 1) & 7;
            const int nj = (np == 0) ? 0 : (nd == 0 ? np : 33 - np); nrow = sc_rowbase(nb, nj) + (nd ? 192 : 0); ngc = nd * 1024; }
        f32x4 S[8];
#pragma unroll
        for (int vt = 0; vt < 8; ++vt) S[vt] = (f32x4){0.f, 0.f, 0.f, 0.f};
        float lastsum[2] = {0.f, 0.f};
        const f32x4 gdum[4] = {(f32x4){0.f, 0.f, 0.f, 0.f}, (f32x4){0.f, 0.f, 0.f, 0.f}, (f32x4){0.f, 0.f, 0.f, 0.f}, (f32x4){0.f, 0.f, 0.f, 0.f}};
        if (d == 0) {
#pragma unroll 1
            for (int ci = 0; ci < 4; ++ci) { const bool last = ci == 3; gla_chunk<false, 0>(lds, Z, rb + ci * 64, h, S, lastsum, gdum, pf, last ? hn : true, last ? nrow : rb + (ci + 1) * 64, last ? ngc : 0, last ? nh : h); }
        } else {
#pragma unroll 1
            for (int ci = 3; ci >= 0; --ci) { const bool last = ci == 0; gla_chunk<false, 1>(lds, Z, rb + ci * 64, h, S, lastsum, gdum, pf, last ? hn : true, last ? nrow : rb + (ci - 1) * 64, last ? ngc : 1024, last ? nh : h); }
        }
        unsigned* sp = Sbuf + (size_t)task * 8192;
#pragma unroll
        for (int vt = 0; vt < 8; ++vt)
#pragma unroll
            for (int jp = 0; jp < 2; ++jp) sp[((w * 8 + vt) * 2 + jp) * 64 + lane] = pk2(S[vt][2 * jp], S[vt][2 * jp + 1]);
        if (tid < 64) *(f32x2*)(Dbuf + (size_t)task * 128 + 2 * tid) = (f32x2){__builtin_amdgcn_exp2f(lastsum[0]), __builtin_amdgcn_exp2f(lastsum[1])};
        LBAR();
    }
}
__device__ __forceinline__ void gla3_task(LAS unsigned char* lds, bf16_t* Z, const unsigned* Sbuf, const float* gnorm, int bh, int jsc, GlaPF& pf, bool hn, int nrow, int nh) {
    int tid_ = threadIdx.x; asm volatile("" : "+v"(tid_));
    const int tid = tid_, lane = tid & 63, w = __builtin_amdgcn_readfirstlane(tid >> 6);
    const int b = bh >> 3, h = bh & 7;
    const int rb = sc_rowbase(b, jsc);
    float dummy[2] = {0.f, 0.f};
    f32x4 S[8], Sb[8];
    f32x4 gnv[4];
    { const int lq = lane >> 4, vh = (w >> 2) * 4;
#pragma unroll
      for (int i = 0; i < 4; ++i) gnv[i] = *(const f32x4*)(gnorm + h * 128 + 16 * (vh + i) + 4 * lq); }
    {
        const int pf_ = jsc, pb_ = (jsc == 0) ? 0 : 33 - jsc;
        if (pf_ == 0) {
#pragma unroll
            for (int vt = 0; vt < 8; ++vt) { S[vt] = (f32x4){0.f, 0.f, 0.f, 0.f}; Sb[vt] = (f32x4){0.f, 0.f, 0.f, 0.f}; }
        } else {
            const unsigned* sp = Sbuf + ((size_t)((bh * 2 + 0) * 32 + (pf_ - 1))) * 8192;
            const unsigned* sq = Sbuf + ((size_t)((bh * 2 + 1) * 32 + (pb_ - 1))) * 8192;
#pragma unroll
            for (int vt = 0; vt < 8; ++vt)
#pragma unroll
                for (int jp = 0; jp < 2; ++jp) {
                    const unsigned a = sp[((w * 8 + vt) * 2 + jp) * 64 + lane], b = sq[((w * 8 + vt) * 2 + jp) * 64 + lane];
                    S[vt][2 * jp] = bflo(a); S[vt][2 * jp + 1] = bfhi(a); Sb[vt][2 * jp] = bflo(b); Sb[vt][2 * jp + 1] = bfhi(b);
                }
        }
    }
#pragma unroll 1
    for (int ci = 0; ci < 4; ++ci) { const bool last = ci == 3; gla_chunk<true, 0>(lds, Z, rb + ci * 64, h, S, dummy, gnv, pf, true, last ? rb + 192 : rb + (ci + 1) * 64, last ? 1024 : 0, h); }
#pragma unroll
    for (int vt = 0; vt < 8; ++vt) S[vt] = Sb[vt];
    asm volatile("s_waitcnt vmcnt(0)" ::: "memory");
    __builtin_amdgcn_fence(__ATOMIC_ACQUIRE, "agent");
    LBAR();
#pragma unroll 1
    for (int ci = 3; ci >= 0; --ci) { const bool last = ci == 0; gla_chunk<true, 1>(lds, Z, rb + ci * 64, h, S, dummy, gnv, pf, last ? hn : true, last ? nrow : rb + (ci - 1) * 64, last ? 0 : 1024, last ? nh : h); }
    asm volatile("s_waitcnt vmcnt(0)" ::: "memory");
    LBAR();
}
__device__ __forceinline__ void phase_gla2(LAS unsigned char* lds, bf16_t* Z, unsigned* Sbuf, const float* Dbuf, const float* gnorm, int with_ctx) {
    int tid_ = threadIdx.x; asm volatile("" : "+v"(tid_));
    int bx = blockIdx.x, nb = gridDim.x;
    if (with_ctx && nb > 64) {
        if (bx < 32) { GlaPF pf; gla_prefetch<true>(pf, Z, sc_rowbase(bx >> 3, 0), 0, bx & 7, tid_); gla3_task(lds, Z, Sbuf, gnorm, bx, 0, pf, false, 0, 0); return; }
        bx -= 32; nb -= 32;
    }
    const int gt = bx * 512 + tid_, nth = nb * 512;
    for (int idx = gt; idx < 64 * 2048; idx += nth) {
        const int bhd = idx >> 11, e8 = idx & 2047, e = e8 * 4;
        const int k = 16 * (e >> 10) + ((e & 63) >> 4) * 4 + 2 * ((e >> 6) & 1);
        f32x4 slo = (f32x4){0.f, 0.f, 0.f, 0.f}, shi = (f32x4){0.f, 0.f, 0.f, 0.f};
        u32x4* sp = (u32x4*)(Sbuf + (size_t)bhd * 32 * 8192) + e8;
        const float* dp = Dbuf + (size_t)bhd * 32 * 128 + k;
#pragma unroll 1
        for (int p0 = 0; p0 < 32; p0 += 8) {
            f32x2 dd[8]; u32x4 a[8];
#pragma unroll
            for (int q = 0; q < 8; ++q) { dd[q] = *(const f32x2*)(dp + (p0 + q) * 128); a[q] = sp[(size_t)(p0 + q) * 2048]; }
#pragma unroll
            for (int q = 0; q < 8; ++q) {
                slo = slo * dd[q].x + (f32x4){bflo(a[q].x), bflo(a[q].y), bflo(a[q].z), bflo(a[q].w)};
                shi = shi * dd[q].y + (f32x4){bfhi(a[q].x), bfhi(a[q].y), bfhi(a[q].z), bfhi(a[q].w)};
                u32x4 o; o.x = pk2(slo[0], shi[0]); o.y = pk2(slo[1], shi[1]); o.z = pk2(slo[2], shi[2]); o.w = pk2(slo[3], shi[3]);
                sp[(size_t)(p0 + q) * 2048] = o;
            }
        }
    }
}
__device__ __forceinline__ void phase_gla3(LAS unsigned char* lds, bf16_t* Z, const unsigned* Sbuf, const float* gnorm, int with_ctx) {
    int tid_ = threadIdx.x; asm volatile("" : "+v"(tid_));
    const int tid = tid_;
    const int jlo = (with_ctx && gridDim.x <= 64) ? 0 : 1, nj = 33 - jlo, ntask = 32 * nj;
    GlaPF pf;
    int task = blockIdx.x;
    if (task < ntask) { const int bh = task / nj, jsc = jlo + task % nj; gla_prefetch<true>(pf, Z, sc_rowbase(bh >> 3, jsc), 0, bh & 7, tid); }
    for (; task < ntask; task += gridDim.x) {
        const int bh = task / nj, jsc = jlo + task % nj;
        const int nt = task + gridDim.x; const bool hn = nt < ntask;
        int nrow = 0, nh = 0;
        if (hn) { const int nbh = nt / nj, njsc = jlo + nt % nj; nrow = sc_rowbase(nbh >> 3, njsc); nh = nbh & 7; }
        gla3_task(lds, Z, Sbuf, gnorm, bh, jsc, pf, hn, nrow, nh);
    }
}

#define XB_TMO      128
#define XB_XCNT(j)  (256  + 64 * (j))
#define XB_XSUB(j)  (1280 + 64 * (j))
#define XB_XGEN(j)  (2304 + 64 * (j))
#define XB_TOP      3328
#define XB_TOPGEN   3392
#define XCD_BAR_WORDS 3456
#define XB_SPIN_CAP (1u << 22)
__device__ __forceinline__ unsigned xb_ld(unsigned* p)              { return __hip_atomic_load(p, __ATOMIC_RELAXED, __HIP_MEMORY_SCOPE_AGENT); }
__device__ __forceinline__ unsigned xb_add(unsigned* p, unsigned v) { return __hip_atomic_fetch_add(p, v, __ATOMIC_RELAXED, __HIP_MEMORY_SCOPE_AGENT); }
__device__ __forceinline__ unsigned xb_xcc_id() { return (unsigned)__builtin_amdgcn_s_getreg((3 << 11) | 20) & 0xFu; }
#define XB_SPIN(cond, bar) do { unsigned _sp = 0; while (cond) { __builtin_amdgcn_s_sleep(1); \
    if ((++_sp & 255u) == 0u) { if (xb_ld(&(bar)[XB_TMO])) break; if (_sp > XB_SPIN_CAP) { atomicAdd(&(bar)[XB_TMO], 1u); break; } } } } while (0)
struct XcdBarrier { unsigned* bar; unsigned x; volatile LAS unsigned* st; };
__device__ __forceinline__ XcdBarrier xcd_barrier_post(unsigned* bar, volatile LAS unsigned* st) {
    XcdBarrier b; b.bar = bar; b.x = xb_xcc_id(); b.st = st;
    if (threadIdx.x == 0) (void)xb_add(&bar[XB_XCNT(b.x)], 1u);
    return b;
}
__device__ __forceinline__ void xcd_barrier_complete(unsigned* bar, unsigned x, unsigned& nloc, unsigned& nx) {
    const unsigned G = gridDim.x * gridDim.y * gridDim.z;
    unsigned sum, cnt, mine, sp = 0u;
    for (;;) {
        sum = 0u; cnt = 0u; mine = 0u;
#pragma unroll
        for (unsigned j = 0; j < 16; ++j) { const unsigned c = xb_ld(&bar[XB_XCNT(j)]); sum += c; cnt += (c > 0u) ? 1u : 0u; mine = (j == x) ? c : mine; }
        if (sum == G) break;
        __builtin_amdgcn_s_sleep(1);
        if ((++sp & 255u) == 0u) { if (xb_ld(&bar[XB_TMO])) break; if (sp > XB_SPIN_CAP) { atomicAdd(&bar[XB_TMO], 1u); break; } }
    }
    nloc = mine > 0u ? mine : 1u; nx = cnt > 0u ? cnt : 1u;
}
__device__ __forceinline__ void xcd_barrier(const XcdBarrier& b) {
    asm volatile("s_waitcnt vmcnt(0)" ::: "memory");
    __syncthreads();
    if (threadIdx.x == 0) {
        unsigned* bar = b.bar;
        __builtin_amdgcn_s_waitcnt(0);
        unsigned nloc = b.st[0], nx = b.st[1];
        if (nloc == 0u) { xcd_barrier_complete(bar, b.x, nloc, nx); b.st[0] = nloc; b.st[1] = nx; }
        const unsigned old = xb_add(&bar[XB_XSUB(b.x)], 1u);
        const unsigned gen = old / nloc;
        if (old + 1u == (gen + 1u) * nloc) {
            __builtin_amdgcn_fence(__ATOMIC_RELEASE, "agent");
            asm volatile("s_waitcnt vmcnt(0)" ::: "memory");
            const unsigned og = xb_add(&bar[XB_TOP], 1u);
            const unsigned tg = og / nx;
            if (og + 1u == (tg + 1u) * nx) xb_add(&bar[XB_TOPGEN], 1u);
            else XB_SPIN(xb_ld(&bar[XB_TOPGEN]) == tg, bar);
            __builtin_amdgcn_fence(__ATOMIC_ACQUIRE, "agent");
            xb_add(&bar[XB_XGEN(b.x)], 1u);
            asm volatile("s_waitcnt vmcnt(0)" ::: "memory");
        } else {
            XB_SPIN(xb_ld(&bar[XB_XGEN(b.x)]) == gen, bar);
            __builtin_amdgcn_fence(__ATOMIC_ACQUIRE, "agent");
            asm volatile("s_waitcnt vmcnt(0)" ::: "memory");
        }
    }
    __syncthreads();
}

#ifndef PROBE_MASK
#define PROBE_MASK 0
#endif
#define TS(cat) do { if (PROBE_MASK) { const unsigned long long _t = __builtin_amdgcn_s_memrealtime(); if ((PROBE_MASK >> (cat)) & 1) pdelay += _t - tprev; tprev = _t; } } while (0)

__global__ void __launch_bounds__(512, 2) mega_fwd(Params p) {
    extern __shared__ __attribute__((aligned(16))) unsigned char lds_raw[];
    LAS unsigned char* lds = (LAS unsigned char*)lds_raw;
    cg::grid_group grid = cg::this_grid();
    unsigned char* ws = p.ws;
    float* X = (float*)(ws + WS_X); bf16_t* Z = (bf16_t*)(ws + WS_Z);
    bf16_t* Win_t = (bf16_t*)(ws + WS_WIN); bf16_t* Wout_t = (bf16_t*)(ws + WS_WOUT); bf16_t* W1_t = (bf16_t*)(ws + WS_W1); bf16_t* W2_t = (bf16_t*)(ws + WS_W2);
    float* Dbuf = (float*)(ws + WS_DB); float* mods = (float*)(ws + WS_MOD); float* lbv = (float*)(ws + WS_LB);
    bf16_t* HA = (bf16_t*)p.out;
    unsigned* Sbuf = (unsigned*)p.out;
    const int G = gridDim.x, bx = blockIdx.x;

    volatile LAS unsigned* xst = (volatile LAS unsigned*)(lds + LDS_MAIN);
    if (threadIdx.x == 0) { xst[0] = 0u; xst[1] = 0u; }
    __syncthreads();
    const XcdBarrier xbar = xcd_barrier_post((unsigned*)(ws + WS_BAR), xst);
    unsigned long long tprev = PROBE_MASK ? __builtin_amdgcn_s_memrealtime() : 0ull, pdelay = 0ull;
    phase_ada(p, lds, mods, lbv);
    grid.sync();
    TS(0);

#pragma unroll 1
    for (int L = 0; L < 4; ++L) {
        const bool rec = (L & 1) == 0; const int j = L >> 1;
        const float* modL = mods + (size_t)L * 5 * 6144;
        const int Mmix_in = (L < 3) ? MT : ML;
        const int Mlive = (L < 2) ? MT : ML;
#pragma unroll 1
        for (int s = 0; s < 2; ++s) {
            if (s == 0) phase_cvt(p, lds, L);
            {
                const float* srcL = (L == 0 && s == 0) ? p.in[0] : X;
                const float* srcC = (L == 0 && s == 0) ? p.in[2] : X + (size_t)ML * DM;
                const float* gain = (s == 0 ? p.in[6] : p.in[7]) + L * 1024;
                phase_norm(srcL, srcC, s == 0 ? Mmix_in : Mlive, gain, modL, s == 0 ? 0 : 3 * 1024, s == 0 ? 1024 : 4 * 1024, HA, (L == 0 && s == 0) ? X : nullptr,
                           ((s == 1 && L < 2) || (s == 0 && (L == 1 || L == 2))) ? (const float*)(ws + WS_P) : nullptr,
                           s == 1 ? modL + 4 * 6144 + 2 * 1024 : mods + (size_t)((L > 0 ? L - 1 : 0) * 5 + 4) * 6144 + 5 * 1024, X);
            }
            xcd_barrier(xbar);
            TS(s == 0 ? 1 : 8);
            pg8::Gemm g; const float* gate; const float* resL; const float* resC;
            if (s == 0) {
                if (rec) {
                    { pg8::Gemm gi{HA, Win_t, Mmix_in, 5120, 1024, 1024, 1024}; pg8::StaticOrder S; S.init(gi.M, gi.N, gi.K, G, bx);
                      EpiHgrnIn E{Z, lbv + (size_t)j * 2048}; pg8::gemm_phase<EpiHgrnIn, pg8::StaticOrder>(lds, gi, S, E); }
                    xcd_barrier(xbar); TS(2);
                    phase_gla1(lds, Z, Sbuf, Dbuf);
                    xcd_barrier(xbar); TS(3);
                    phase_gla2(lds, Z, Sbuf, Dbuf, p.in[13] + j * 1024, L < 2 ? 1 : 0);
                    xcd_barrier(xbar); TS(4);
                    phase_gla3(lds, Z, Sbuf, p.in[13] + j * 1024, L < 2 ? 1 : 0);
                    xcd_barrier(xbar); TS(5);
                    g = pg8::Gemm{Z + 1024, Wout_t, ML, 1024, 1024, 5120, 1024};
                } else {
                    { pg8::Gemm gi{HA, Win_t, Mmix_in, 3072, 1024, 1024, 1024}; pg8::StaticOrder S; S.init(gi.M, gi.N, gi.K, G, bx);
                      EpiConvIn E{Z}; pg8::gemm_phase<EpiConvIn, pg8::StaticOrder>(lds, gi, S, E); }
                    xcd_barrier(xbar); TS(2);
                    phase_conv(Z, p.in[16] + (size_t)j * 3 * 1024, p.in[17] + j * 1024, j & 1, Mlive, HA);
                    xcd_barrier(xbar); TS(6);
                    g = pg8::Gemm{HA, Wout_t, ML, 1024, 1024, 1024, 1024};
                }
                gate = modL + 2 * 1024;
                resL = (L == 0) ? p.in[0] : X; resC = (L == 0) ? p.in[2] : X + (size_t)ML * DM;
            } else {
                { pg8::Gemm gi{HA, W1_t, Mlive, 4096, 1024, 1024, 1024}; pg8::StaticOrder S; S.init(gi.M, gi.N, gi.K, G, bx);
                  EpiRelu2 E{Z}; pg8::gemm_phase<EpiRelu2, pg8::StaticOrder>(lds, gi, S, E); }
                xcd_barrier(xbar); TS(9);
                g = pg8::Gemm{Z, W2_t, ML, 1024, 4096, 4096, 4096};
                gate = modL + 5 * 1024;
                resL = X; resC = X + (size_t)ML * DM;
            }
            { pg8::StaticOrder S; S.init(g.M, g.N, g.K, G, bx, L < 2 ? 64 : 0); EpiResid E{X, resL, resC, gate, (float*)(ws + WS_P)}; pg8::gemm_phase<EpiResid, pg8::StaticOrder>(lds, g, S, E); }
            xcd_barrier(xbar);
            TS(s == 0 ? 7 : 10);
        }
    }
    phase_final(X, p.in[8], p.out);
    if (PROBE_MASK) {
        TS(11);
        if (bx == 0) { const unsigned long long t0 = __builtin_amdgcn_s_memrealtime(); while (__builtin_amdgcn_s_memrealtime() - t0 < pdelay) __builtin_amdgcn_s_sleep(8); }
    }
}

extern "C" void kernel_launch(void* const* d_in, const int* in_sizes, int n_in, void* d_out, int out_size, void* d_ws, size_t ws_size, hipStream_t stream) {
    static int grid = 0;
    if (grid == 0) {
        if (n_in != 19 || out_size != ML * DM || ws_size < WS_END) { fprintf(stderr, "kernel_launch: unexpected shapes / workspace (n_in %d out %d ws %zu need %zu)\n", n_in, out_size, ws_size, (size_t)WS_END); grid = -1; return; }
        int dev = 0, cus = 0, per_cu = 0;
        if (hipGetDevice(&dev) != hipSuccess || hipDeviceGetAttribute(&cus, hipDeviceAttributeMultiprocessorCount, dev) != hipSuccess) { grid = -1; return; }
        if (hipFuncSetAttribute((const void*)mega_fwd, hipFuncAttributeMaxDynamicSharedMemorySize, LDS_BYTES) != hipSuccess) { fprintf(stderr, "kernel_launch: hipFuncSetAttribute failed\n"); grid = -1; return; }
        if (hipOccupancyMaxActiveBlocksPerMultiprocessor(&per_cu, (const void*)mega_fwd, 512, LDS_BYTES) != hipSuccess || per_cu < 1) { fprintf(stderr, "kernel_launch: occupancy query failed (%d)\n", per_cu); per_cu = 1; (void)hipGetLastError(); }
        grid = cus * per_cu;
    }
    if (grid < 0) return;
    if (hipMemsetAsync((char*)d_ws + WS_BAR, 0, XCD_BAR_WORDS * 4, stream) != hipSuccess) { fprintf(stderr, "kernel_launch: memset failed\n"); return; }
    Params p{};
    for (int i = 0; i < 19; ++i) p.in[i] = (const float*)d_in[i];
    p.out = (float*)d_out; p.ws = (unsigned char*)d_ws;
    void* args[] = {&p};
    hipError_t e = hipLaunchCooperativeKernel((const void*)mega_fwd, dim3(grid), dim3(512), args, LDS_BYTES, stream);
    if (e != hipSuccess) fprintf(stderr, "cooperative launch failed: %s (grid %d)\n", hipGetErrorString(e), grid);
}
```
